# Optimizing an MI355X kernel written in HIP

```python
import jax, jax.numpy as jnp
from jax import lax
import numpy as np

D_MODEL = 1024
BATCH = 8
SEQ = 2048
DEPTH = 2
DEC_BATCH = 128
DEC_SEQ = 8
PAST_LEN = 16384
PAGE_SIZE = 128

SSD_HEAD_DIM = 64
SSD_INNER = D_MODEL
SSD_HEADS = SSD_INNER // SSD_HEAD_DIM
SSD_GROUPS = 4
SSD_STATE = 128
SSD_CONV = 4
SSD_CHUNK = 128
D_XBC = SSD_INNER + 2 * SSD_GROUPS * SSD_STATE
D_SC = D_MODEL
SC_CONV = 3
D_FF = 2816
N_MOD = 9
EPS = 1e-6
D_PROJ = SSD_INNER + D_XBC + SSD_HEADS + 3 * D_SC + 2 * D_MODEL

kernel_name = "hybrid_ssd_shortconv_adaln_decoder_step"


def _split(t, sizes):
    idx = np.cumsum(sizes)[:-1].tolist()
    return jnp.split(t, idx, axis=-1)


def rmsnorm(x, g):
    xf = x.astype(jnp.float32)
    r = lax.rsqrt(jnp.mean(xf * xf, axis=-1, keepdims=True) + EPS)
    return (xf * r).astype(x.dtype) * g


def group_rmsnorm(x, g, n_groups):
    shp = x.shape
    xf = x.astype(jnp.float32).reshape(shp[:-1] + (n_groups, shp[-1] // n_groups))
    r = lax.rsqrt(jnp.mean(xf * xf, axis=-1, keepdims=True) + EPS)
    return (xf * r).reshape(shp).astype(x.dtype) * g


def modulate(h, shift, scale):
    return h * (1.0 + scale[:, None, :]) + shift[:, None, :]


def causal_dwconv(u, buf, w):
    k_w = w.shape[0]
    L = u.shape[1]
    ext = jnp.concatenate([buf.astype(u.dtype), u], axis=1)
    y = ext[:, 0:L] * w[0]
    for k in range(1, k_w):
        y = y + ext[:, k:k + L] * w[k]
    return y, ext[:, L:]


def ssd_scan(xh, dt, a, bm, cm, s0):
    bsz, L, H, P = xh.shape
    G, N = bm.shape[2], bm.shape[3]
    R = H // G
    T = SSD_CHUNK if L >= SSD_CHUNK else L
    pad = (-L) % T
    f32 = jnp.float32
    xh, dt, bm, cm = xh.astype(f32), dt.astype(f32), bm.astype(f32), cm.astype(f32)
    if pad:
        pw = ((0, 0), (0, pad), (0, 0))
        xh = jnp.pad(xh, pw + ((0, 0),))
        dt = jnp.pad(dt, pw)
        bm = jnp.pad(bm, pw + ((0, 0),))
        cm = jnp.pad(cm, pw + ((0, 0),))
    nc = (L + pad) // T
    x = xh.reshape(bsz, nc, T, G, R, P)
    dtc = dt.reshape(bsz, nc, T, G, R)
    b_ = bm.reshape(bsz, nc, T, G, N)
    c_ = cm.reshape(bsz, nc, T, G, N)
    xdt = x * dtc[..., None]
    da = jnp.transpose(dtc * a.astype(f32).reshape(G, R), (0, 1, 3, 4, 2))
    acum = jnp.cumsum(da, axis=-1)
    seg = acum[..., :, None] - acum[..., None, :]
    mask = jnp.tril(jnp.ones((T, T), dtype=bool))
    decay = jnp.exp(jnp.where(mask, seg, -jnp.inf))
    cb = jnp.einsum('bclgn,bcsgn->bcgls', c_, b_)
    y_diag = jnp.einsum('bcgls,bcgrls,bcsgrp->bclgrp', cb, decay, xdt)
    decay_states = jnp.exp(acum[..., -1:] - acum)
    states = jnp.einsum('bclgn,bcgrl,bclgrp->bcgrpn', b_, decay_states, xdt)
    chunk_decay = jnp.exp(acum[..., -1])

    def step(s, inp):
        st, dec = inp
        return dec[..., None, None] * s + st, s

    s_final, s_in = lax.scan(step, s0.astype(f32).reshape(bsz, G, R, P, N),
                             (jnp.moveaxis(states, 1, 0), jnp.moveaxis(chunk_decay, 1, 0)))
    s_in = jnp.moveaxis(s_in, 0, 1)
    y_off = jnp.einsum('bclgn,bcgrpn,bcgrl->bclgrp', c_, s_in, jnp.exp(acum))
    y = (y_diag + y_off).reshape(bsz, nc * T, H, P)[:, :L]
    return y, s_final.reshape(bsz, H, P, N)


def swiglu(h, w_gu, w_down):
    g, u = jnp.split(h @ w_gu, 2, axis=-1)
    return (jax.nn.silu(g) * u) @ w_down


def trunk_layer(x, c, s_ssm, buf_xbc, buf_sc,
                w_ada, b_ada, norm_ffn1, norm_mix, norm_ffn2,
                ffn1_w_gu, ffn1_w_down, ffn2_w_gu, ffn2_w_down,
                w_in, ssd_conv_w, ssd_conv_b, ssd_dt_bias, ssd_a_log, ssd_d, ssd_norm,
                w_out_ssd, sc_conv_w, w_out_sc, w_o):
    bsz, L, _ = x.shape
    mod = jax.nn.silu(c) @ w_ada + b_ada
    sh1, sc1, g1, sh2, sc2, g2, sh3, sc3, g3 = jnp.split(mod, N_MOD, axis=-1)

    h = modulate(rmsnorm(x, norm_ffn1), sh1, sc1)
    x = x + 0.5 * g1[:, None, :] * swiglu(h, ffn1_w_gu, ffn1_w_down)

    h = modulate(rmsnorm(x, norm_mix), sh2, sc2)
    proj = h @ w_in
    z, xbc, dt_raw, sc_b, sc_c, sc_h, gate_ssd, gate_sc = _split(
        proj, [SSD_INNER, D_XBC, SSD_HEADS, D_SC, D_SC, D_SC, D_MODEL, D_MODEL])

    xbc_c, new_buf_xbc = causal_dwconv(xbc, buf_xbc, ssd_conv_w)
    xbc_c = jax.nn.silu(xbc_c + ssd_conv_b)
    xs, bs, cs = _split(xbc_c, [SSD_INNER, SSD_GROUPS * SSD_STATE, SSD_GROUPS * SSD_STATE])
    dt = jax.nn.softplus(dt_raw.astype(jnp.float32) + ssd_dt_bias.astype(jnp.float32))
    a = -jnp.exp(ssd_a_log.astype(jnp.float32))
    xh = xs.reshape(bsz, L, SSD_HEADS, SSD_HEAD_DIM)
    y, s_new = ssd_scan(xh, dt, a,
                        bs.reshape(bsz, L, SSD_GROUPS, SSD_STATE),
                        cs.reshape(bsz, L, SSD_GROUPS, SSD_STATE), s_ssm)
    y = y.astype(x.dtype) + xh * ssd_d[:, None]
    y = y.reshape(bsz, L, SSD_INNER) * jax.nn.silu(z)
    y = group_rmsnorm(y, ssd_norm, SSD_GROUPS)
    y_ssd = y @ w_out_ssd

    u, new_buf_sc = causal_dwconv(sc_c * sc_h, buf_sc, sc_conv_w)
    y_sc = (sc_b * u) @ w_out_sc

    merged = jax.nn.sigmoid(gate_ssd) * y_ssd + jax.nn.sigmoid(gate_sc) * y_sc
    x = x + g2[:, None, :] * (merged @ w_o)

    h = modulate(rmsnorm(x, norm_ffn2), sh3, sc3)
    x = x + 0.5 * g3[:, None, :] * swiglu(h, ffn2_w_gu, ffn2_w_down)
    return x, s_new.astype(s_ssm.dtype), new_buf_xbc, new_buf_sc


def setup_inputs(seed: int = 0) -> dict:
    key = jax.random.key(seed)
    ks = iter(jax.random.split(key, 40))
    nrm = lambda shape, s: jax.random.normal(next(ks), shape, jnp.float32) * s
    gain = lambda shape: 1.0 + nrm(shape, 0.02)
    dt0 = jnp.exp(jax.random.uniform(next(ks), (DEPTH, SSD_HEADS), jnp.float32,
                                     np.log(1e-3), np.log(1e-1)))
    a0 = jax.random.uniform(next(ks), (DEPTH, SSD_HEADS), jnp.float32, 1.0, 16.0)
    return {
        "x_prompt": nrm((BATCH, SEQ, D_MODEL), 1.0),
        "x_sample": nrm((DEC_BATCH, DEC_SEQ, D_MODEL), 1.0),
        "c_prompt": nrm((BATCH, D_MODEL), 1.0),
        "c_sample": nrm((DEC_BATCH, D_MODEL), 1.0),
        "state_ssm": nrm((DEPTH, DEC_BATCH, SSD_HEADS, SSD_HEAD_DIM, SSD_STATE), 0.3),
        "state_conv_ssd": nrm((DEPTH, DEC_BATCH, SSD_CONV - 1, D_XBC), 1.0),
        "state_conv_short": nrm((DEPTH, DEC_BATCH, SC_CONV - 1, D_SC), 1.0),
        "w_ada": nrm((DEPTH, D_MODEL, N_MOD * D_MODEL), 0.5 * D_MODEL ** -0.5),
        "b_ada": nrm((DEPTH, N_MOD * D_MODEL), 0.02),
        "norm_ffn1": gain((DEPTH, D_MODEL)),
        "norm_mix": gain((DEPTH, D_MODEL)),
        "norm_ffn2": gain((DEPTH, D_MODEL)),
        "ffn1_w_gu": nrm((DEPTH, D_MODEL, 2 * D_FF), D_MODEL ** -0.5),
        "ffn1_w_down": nrm((DEPTH, D_FF, D_MODEL), D_FF ** -0.5),
        "ffn2_w_gu": nrm((DEPTH, D_MODEL, 2 * D_FF), D_MODEL ** -0.5),
        "ffn2_w_down": nrm((DEPTH, D_FF, D_MODEL), D_FF ** -0.5),
        "w_in": nrm((DEPTH, D_MODEL, D_PROJ), D_MODEL ** -0.5),
        "ssd_conv_w": nrm((DEPTH, SSD_CONV, D_XBC), SSD_CONV ** -0.5),
        "ssd_conv_b": nrm((DEPTH, D_XBC), 0.02),
        "ssd_dt_bias": dt0 + jnp.log(-jnp.expm1(-dt0)),
        "ssd_a_log": jnp.log(a0),
        "ssd_d": gain((DEPTH, SSD_HEADS)),
        "ssd_norm": gain((DEPTH, SSD_INNER)),
        "w_out_ssd": nrm((DEPTH, SSD_INNER, D_MODEL), SSD_INNER ** -0.5),
        "sc_conv_w": nrm((DEPTH, SC_CONV, D_SC), SC_CONV ** -0.5),
        "w_out_sc": nrm((DEPTH, D_SC, D_MODEL), D_SC ** -0.5),
        "w_o": nrm((DEPTH, D_MODEL, D_MODEL), D_MODEL ** -0.5),
        "norm_final": gain((D_MODEL,)),
    }


def reference(x_prompt, x_sample, c_prompt, c_sample, state_ssm, state_conv_ssd,
              state_conv_short, w_ada, b_ada, norm_ffn1, norm_mix, norm_ffn2,
              ffn1_w_gu, ffn1_w_down, ffn2_w_gu, ffn2_w_down, w_in, ssd_conv_w,
              ssd_conv_b, ssd_dt_bias, ssd_a_log, ssd_d, ssd_norm, w_out_ssd,
              sc_conv_w, w_out_sc, w_o, norm_final):
    bp = x_prompt.shape[0]
    dtp = x_prompt.dtype
    xp, xs = x_prompt, x_sample
    ssm_p, cx_p, cs_p, ssm_s, cx_s, cs_s = [], [], [], [], [], []
    for l in range(DEPTH):
        lw = (w_ada[l], b_ada[l], norm_ffn1[l], norm_mix[l], norm_ffn2[l],
              ffn1_w_gu[l], ffn1_w_down[l], ffn2_w_gu[l], ffn2_w_down[l],
              w_in[l], ssd_conv_w[l], ssd_conv_b[l], ssd_dt_bias[l], ssd_a_log[l],
              ssd_d[l], ssd_norm[l], w_out_ssd[l], sc_conv_w[l], w_out_sc[l], w_o[l])
        xp, s1, b1, b2 = trunk_layer(
            xp, c_prompt,
            jnp.zeros((bp, SSD_HEADS, SSD_HEAD_DIM, SSD_STATE), dtp),
            jnp.zeros((bp, SSD_CONV - 1, D_XBC), dtp),
            jnp.zeros((bp, SC_CONV - 1, D_SC), dtp), *lw)
        ssm_p.append(s1); cx_p.append(b1); cs_p.append(b2)
        xs, s1, b1, b2 = trunk_layer(
            xs, c_sample, state_ssm[l], state_conv_ssd[l], state_conv_short[l], *lw)
        ssm_s.append(s1); cx_s.append(b1); cs_s.append(b2)
    y_prompt = rmsnorm(xp, norm_final)
    y_sample = rmsnorm(xs, norm_final)
    return (y_prompt, y_sample,
            jnp.stack(ssm_p), jnp.stack(cx_p), jnp.stack(cs_p),
            jnp.stack(ssm_s), jnp.stack(cx_s), jnp.stack(cs_s))
```

```cpp
#include <hip/hip_runtime.h>
#include <cstdio>
#include <cstdint>
namespace pg8 {
#define PG8_LAS __attribute__((address_space(3)))
typedef unsigned short bf16_t;
typedef short bf16x8 __attribute__((ext_vector_type(8)));
typedef float f32x4 __attribute__((ext_vector_type(4)));
typedef unsigned u32x4 __attribute__((ext_vector_type(4)));
constexpr int BM = 256, BK = 64, HALF = 128, HTB = HALF * BK * 2  , STAGE_BYTES = 8 * HTB, NXCD = 8, WGM = 8;

__host__ __device__ __forceinline__ int lds_byte(int r, int c) { const int st = (r >> 4) * 2 + (c >> 5), rr = r & 15, cc = c & 31, ob = rr * 64 + cc * 2; return st * 1024 + (ob ^ (((ob >> 9) & 1) << 5)); }
__host__ __device__ __forceinline__ void stage_rc(int b, int& R, int& C) { const int st = b / 1024, sb = b % 1024, swz = sb ^ (((sb >> 9) & 1) << 5); R = (st >> 1) * 16 + swz / 64; C = (st & 1) * 32 + (swz % 64) / 2; }
__host__ __device__ __forceinline__ int perm32(int rho) { const int n = rho >> 4, i = rho & 15; return 8 * (i >> 2) + 4 * n + (i & 3); }

struct Unit { int pm, pn; };
struct Gemm { const bf16_t* A; const bf16_t* Bt; int M, N, K; };

struct StaticOrder {
    int nM, nN, nwg, G, c;
    __host__ __device__ void init(int M, int N, int G_, int c_) { nM = M / BM; nN = N / BM; nwg = nM * nN; G = G_; c = c_; }
    __host__ __device__ bool next(int i, Unit& u) const {
        const long L = (long)i * G + c; if (L >= nwg) return false;
        int wgid = (int)L; { const int q = nwg / NXCD, r = nwg % NXCD, xcd = wgid % NXCD, off = wgid / NXCD; wgid = (xcd < r ? xcd * (q + 1) : r * (q + 1) + (xcd - r) * q) + off; }
        const int nig = WGM * nN, gid = wgid / nig, fm = gid * WGM, gsz = (nM - fm) < WGM ? (nM - fm) : WGM;
        u.pm = fm + ((wgid % nig) % gsz); u.pn = (wgid % nig) / gsz; return true;
    }
    __device__ __forceinline__ void a_ready(const Unit&) const {}
    __device__ __forceinline__ void done(const Unit&) const {}
};
__device__ __forceinline__ unsigned cvt_pk_bf16(float lo, float hi) { unsigned r; asm volatile("v_cvt_pk_bf16_f32 %0, %1, %2" : "=v"(r) : "v"(lo), "v"(hi)); return r; }
typedef float f32x2 __attribute__((ext_vector_type(2)));
template <class Epi, class Sched, bool ALIGN_EPI = false, bool SP2 = false>
__device__ __forceinline__ void gemm_phase(PG8_LAS unsigned char* lds, const Gemm g, const Sched& S, const Epi& E) {
    int tid_ = threadIdx.x; asm volatile("" : "+v"(tid_));
    const int tid = tid_, wid = __builtin_amdgcn_readfirstlane(tid >> 6), lane = tid & 63, wr = wid >> 2, wc = wid & 3, fr = lane & 15, fq = lane >> 4;
    const int K = g.K, nt = K / BK;
    unsigned voffA[2], voffB[2];
#pragma unroll
    for (int i = 0; i < 2; ++i) { int R, C; stage_rc(tid * 16 + i * 8192, R, C); const int Rb = Epi::PERM ? ((R & ~31) + perm32(R & 31)) : R;
        voffA[i] = (unsigned)(R * K + C) * 2u; voffB[i] = (unsigned)(Rb * K + C) * 2u; }
    const size_t kstep = (size_t)(BK * 2);
    const size_t hstep = (size_t)HALF * K * 2;
    const size_t tstep = 2 * hstep;
    const unsigned ldsw = (unsigned)wid * 1024u;
    const int aoff = lds_byte(wr * 64 + fr, fq * 8), boff = lds_byte(wc * 32 + fr, fq * 8);
#define PG8_SA(b, h) (((b) * 2 + (h)) * HTB)
#define PG8_SB(b, h) ((4 + (b) * 2 + (h)) * HTB)
#define PG8_STAGE(bufoff, gbase, voff) do { _Pragma("unroll") for (int _i = 0; _i < 2; ++_i) \
        __builtin_amdgcn_global_load_lds((const unsigned*)((const char*)(gbase) + (voff)[_i]), (PG8_LAS unsigned*)(lds + (bufoff) + ldsw + _i * 8192), 16, 0, 0); } while (0)
#define PG8_LDA(dst, b, h) do { _Pragma("unroll") for (int m = 0; m < 4; ++m) _Pragma("unroll") for (int k = 0; k < 2; ++k) dst[m][k] = *(const PG8_LAS bf16x8*)(lds + PG8_SA(b, h) + aoff + m * 2048 + k * 1024); } while (0)
#define PG8_LDB(dst, b, h) do { _Pragma("unroll") for (int n = 0; n < 2; ++n) _Pragma("unroll") for (int k = 0; k < 2; ++k) dst[n][k] = *(const PG8_LAS bf16x8*)(lds + PG8_SB(b, h) + boff + n * 2048 + k * 1024); } while (0)
#define PG8_MMA(ai, bj, At, Bt) do { __builtin_amdgcn_s_setprio(1); _Pragma("unroll") for (int m = 0; m < 4; ++m) _Pragma("unroll") for (int n = 0; n < 2; ++n) _Pragma("unroll") for (int k = 0; k < 2; ++k) \
        acc[ai][bj][m][n] = __builtin_amdgcn_mfma_f32_16x16x32_bf16(Bt[n][k], At[m][k], acc[ai][bj][m][n], 0, 0, 0); __builtin_amdgcn_s_setprio(0); } while (0)
#define PG8_WAIT_V(n) asm volatile("s_waitcnt vmcnt(" #n ")" ::: "memory")
#define PG8_WAIT_L(n) asm volatile("s_waitcnt lgkmcnt(" #n ")" ::: "memory")
#define PG8_BAR __builtin_amdgcn_s_barrier()
#define PG8_SCHED __builtin_amdgcn_sched_barrier(0)
    Unit cur, nxt; int ui = 0;
    if (!S.next(0, cur)) return;
    f32x4 acc[2][2][4][2];
#pragma unroll
    for (int a = 0; a < 2; ++a)
#pragma unroll
        for (int b = 0; b < 2; ++b)
#pragma unroll
            for (int m = 0; m < 4; ++m)
#pragma unroll
                for (int n = 0; n < 2; ++n) acc[a][b][m][n] = (f32x4){0.f, 0.f, 0.f, 0.f};
    bf16x8 At[4][2], B0[2][2], B1[2][2];
    const char* cA = (const char*)g.A + (size_t)cur.pm * tstep; const char* cB = (const char*)g.Bt + (size_t)cur.pn * tstep;
    S.a_ready(cur);
    if constexpr (SP2) {
        PG8_STAGE(PG8_SB(0, 0), cB, voffB); PG8_STAGE(PG8_SB(0, 1), cB + hstep, voffB); PG8_STAGE(PG8_SA(0, 0), cA, voffA); PG8_STAGE(PG8_SA(0, 1), cA + hstep, voffA);
        if (wr == 1) PG8_BAR;
        PG8_WAIT_V(2); PG8_BAR;
        PG8_STAGE(PG8_SB(1, 0), cB + kstep, voffB); PG8_STAGE(PG8_SA(1, 0), cA + kstep, voffA); PG8_STAGE(PG8_SB(1, 1), cB + hstep + kstep, voffB);
        PG8_WAIT_V(6); PG8_BAR;
    } else {
        PG8_STAGE(PG8_SB(0, 0), cB, voffB); PG8_STAGE(PG8_SA(0, 0), cA, voffA); PG8_STAGE(PG8_SB(0, 1), cB + hstep, voffB); PG8_STAGE(PG8_SA(0, 1), cA + hstep, voffA);
        if (wr == 1) PG8_BAR;
        PG8_WAIT_V(4); PG8_BAR;
        PG8_STAGE(PG8_SB(1, 0), cB + kstep, voffB); PG8_STAGE(PG8_SA(1, 0), cA + kstep, voffA); PG8_STAGE(PG8_SB(1, 1), cB + hstep + kstep, voffB);
        PG8_WAIT_V(6); PG8_BAR;
    }
    for (;;) {
        const bool has_next = S.next(ui + 1, nxt);
        const char* nA = has_next ? (const char*)g.A + (size_t)nxt.pm * tstep : cA; const char* nB = has_next ? (const char*)g.Bt + (size_t)nxt.pn * tstep : cB;
        for (int t = 0; t < nt; t += 2) {
            const bool last = (t == nt - 2);
            const char* a1 = cA + (size_t)(t + 1) * kstep;
            const char* a2 = last ? nA : cA + (size_t)(t + 2) * kstep; const char* b2 = last ? nB : cB + (size_t)(t + 2) * kstep;
            const char* a3 = a2 + kstep; const char* b3 = b2 + kstep;
            if (last && has_next) S.a_ready(nxt);
            if constexpr (SP2) {
            PG8_LDB(B0, 0, 0); PG8_LDB(B1, 0, 1); PG8_SCHED; PG8_LDA(At, 0, 0); PG8_STAGE(PG8_SA(1, 1), a1 + hstep, voffA);
            PG8_WAIT_V(8); PG8_WAIT_L(0); PG8_BAR; PG8_MMA(0, 0, At, B0); PG8_MMA(0, 1, At, B1); PG8_BAR; PG8_SCHED;
            PG8_LDA(At, 0, 1); PG8_STAGE(PG8_SB(0, 0), b2, voffB); PG8_STAGE(PG8_SB(0, 1), b2 + hstep, voffB); PG8_STAGE(PG8_SA(0, 0), a2, voffA);
            PG8_WAIT_V(8); PG8_WAIT_L(0); PG8_BAR; PG8_MMA(1, 0, At, B0); PG8_MMA(1, 1, At, B1); PG8_BAR; PG8_SCHED;
            PG8_LDB(B0, 1, 0); PG8_LDB(B1, 1, 1); PG8_SCHED; PG8_LDA(At, 1, 0); PG8_STAGE(PG8_SA(0, 1), a2 + hstep, voffA);
            PG8_WAIT_V(8); PG8_WAIT_L(0); PG8_BAR; PG8_MMA(0, 0, At, B0); PG8_MMA(0, 1, At, B1); PG8_BAR; PG8_SCHED;
            PG8_LDA(At, 1, 1); PG8_STAGE(PG8_SB(1, 0), b3, voffB); PG8_STAGE(PG8_SB(1, 1), b3 + hstep, voffB); PG8_STAGE(PG8_SA(1, 0), a3, voffA);
            PG8_WAIT_V(8); PG8_WAIT_L(0); PG8_BAR; PG8_MMA(1, 0, At, B0); PG8_MMA(1, 1, At, B1); PG8_BAR; PG8_SCHED;
            } else {
            PG8_LDB(B0, 0, 0); PG8_SCHED; PG8_LDA(At, 0, 0); PG8_STAGE(PG8_SA(1, 1), a1 + hstep, voffA);
            PG8_WAIT_L(8); PG8_BAR; PG8_WAIT_L(0); PG8_MMA(0, 0, At, B0); PG8_BAR; PG8_SCHED;
            PG8_LDB(B1, 0, 1); PG8_STAGE(PG8_SB(0, 0), b2, voffB);
            PG8_BAR; PG8_WAIT_L(0); PG8_MMA(0, 1, At, B1); PG8_BAR;
            PG8_LDA(At, 0, 1); PG8_STAGE(PG8_SA(0, 0), a2, voffA);
            PG8_BAR; PG8_WAIT_L(0); PG8_MMA(1, 0, At, B0); PG8_BAR; PG8_SCHED;
            PG8_STAGE(PG8_SB(0, 1), b2 + hstep, voffB);
            PG8_WAIT_V(6); PG8_BAR; PG8_MMA(1, 1, At, B1); PG8_BAR;
            PG8_LDB(B0, 1, 0); PG8_SCHED; PG8_LDA(At, 1, 0); PG8_STAGE(PG8_SA(0, 1), a2 + hstep, voffA);
            PG8_WAIT_L(8); PG8_BAR; PG8_WAIT_L(0); PG8_MMA(0, 0, At, B0); PG8_BAR; PG8_SCHED;
            PG8_LDB(B1, 1, 1); PG8_STAGE(PG8_SB(1, 0), b3, voffB);
            PG8_BAR; PG8_WAIT_L(0); PG8_MMA(0, 1, At, B1); PG8_BAR;
            PG8_LDA(At, 1, 1); PG8_STAGE(PG8_SA(1, 0), a3, voffA);
            PG8_BAR; PG8_WAIT_L(0); PG8_MMA(1, 0, At, B0); PG8_BAR; PG8_SCHED;
            PG8_STAGE(PG8_SB(1, 1), b3 + hstep, voffB);
            PG8_WAIT_V(6); PG8_BAR; PG8_MMA(1, 1, At, B1); PG8_BAR;
            }
        }
        if constexpr (ALIGN_EPI) { if (wr == 0) PG8_BAR; }
        if constexpr (!Epi::AFTER_DRAIN) { E(acc, cur, wr, wc, fr, fq); S.done(cur); }
        if (!has_next) break;
#pragma unroll
        for (int a = 0; a < 2; ++a)
#pragma unroll
            for (int b = 0; b < 2; ++b)
#pragma unroll
                for (int m = 0; m < 4; ++m)
#pragma unroll
                    for (int n = 0; n < 2; ++n) acc[a][b][m][n] = (f32x4){0.f, 0.f, 0.f, 0.f};
        cur = nxt; cA = nA; cB = nB; ++ui;
        if constexpr (ALIGN_EPI) { if (wr == 1) PG8_BAR; }
    }
    PG8_WAIT_V(0);
    if constexpr (!ALIGN_EPI) { if (wr == 0) PG8_BAR; }
    PG8_BAR;
    if constexpr (Epi::AFTER_DRAIN) { E.fused(acc, cur, wr, wc, fr, fq, lds, wid, lane); S.done(cur); }
#undef PG8_SA
#undef PG8_SB
#undef PG8_STAGE
#undef PG8_LDA
#undef PG8_LDB
#undef PG8_MMA
#undef PG8_WAIT_V
#undef PG8_WAIT_L
#undef PG8_BAR
#undef PG8_SCHED
}
}
constexpr int DM = 1024, NB_P = 8, SEQ_P = 2048, NB_S = 128, SEQ_S = 8, DEPTH = 2;
constexpr int MP = NB_P * SEQ_P;
constexpr int MS = NB_S * SEQ_S;
constexpr int M = MP + MS;
constexpr int NSEQ = NB_P + NB_S;
constexpr int DFF = 2816, NMOD = 9 * DM, DPROJ = 8208, DXBC = 2048;
constexpr float EPS = 1e-6f;

__device__ __forceinline__ int mod_row(int m) { return m < MP ? (m >> 11) : NB_P + ((m - MP) >> 3); }
__device__ __forceinline__ float bf_lo(unsigned w) { return __uint_as_float(w << 16); }
__device__ __forceinline__ float bf_hi(unsigned w) { return __uint_as_float(w & 0xffff0000u); }
__device__ __forceinline__ float fast_sigmoid(float x) { return __builtin_amdgcn_rcpf(1.f + __expf(-x)); }
__device__ __forceinline__ float fast_silu(float x) { return x * fast_sigmoid(x); }

namespace pg8 {
struct EpiMod {
    static constexpr bool PERM = false, AFTER_DRAIN = false;
    float* C; const float* bias;
    __device__ __forceinline__ void operator()(const f32x4 (&acc)[2][2][4][2], const Unit& u, int wr, int wc, int fr, int fq) const {
        const int row0 = u.pm * BM + wr * 64 + fr, col0 = u.pn * BM + wc * 32 + 4 * fq;
        f32x4 bv[2][2];
#pragma unroll
        for (int bj = 0; bj < 2; ++bj)
#pragma unroll
            for (int n = 0; n < 2; ++n) bv[bj][n] = *(const f32x4*)(bias + col0 + bj * HALF + n * 16);
#pragma unroll
        for (int ai = 0; ai < 2; ++ai)
#pragma unroll
            for (int m = 0; m < 4; ++m) { const int r = row0 + ai * HALF + m * 16;
                if (r < NSEQ) { float* rowp = C + (size_t)r * NMOD + col0;
#pragma unroll
                    for (int bj = 0; bj < 2; ++bj)
#pragma unroll
                        for (int n = 0; n < 2; ++n) *(f32x4*)(rowp + bj * HALF + n * 16) = acc[ai][bj][m][n] + bv[bj][n]; } }
    }
};
struct EpiSwiglu {
    static constexpr bool PERM = true, AFTER_DRAIN = false;
    bf16_t* O;
    __device__ __forceinline__ void operator()(const f32x4 (&acc)[2][2][4][2], const Unit& u, int wr, int wc, int fr, int fq) const {
        const int row0 = u.pm * BM + wr * 64 + fr, col0 = u.pn * HALF + wc * 32 + 8 * fq;
#pragma unroll
        for (int ai = 0; ai < 2; ++ai)
#pragma unroll
            for (int m = 0; m < 4; ++m) { bf16_t* rowp = O + (size_t)(row0 + ai * HALF + m * 16) * DFF + col0;
                const f32x4 g0 = acc[ai][0][m][0], g1 = acc[ai][0][m][1], u0 = acc[ai][1][m][0], u1 = acc[ai][1][m][1];
                u32x4 w;
                w.x = cvt_pk_bf16(fast_silu(g0[0]) * u0[0], fast_silu(g0[1]) * u0[1]); w.y = cvt_pk_bf16(fast_silu(g0[2]) * u0[2], fast_silu(g0[3]) * u0[3]);
                w.z = cvt_pk_bf16(fast_silu(g1[0]) * u1[0], fast_silu(g1[1]) * u1[1]); w.w = cvt_pk_bf16(fast_silu(g1[2]) * u1[2], fast_silu(g1[3]) * u1[3]);
                *(u32x4*)rowp = w; }
    }
};
struct EpiProj {
    static constexpr bool PERM = true, AFTER_DRAIN = false;
    bf16_t* P;
    __device__ __forceinline__ void operator()(const f32x4 (&acc)[2][2][4][2], const Unit& u, int wr, int wc, int fr, int fq) const {
        const int t = u.pn >> 2; bf16_t* base = P + (size_t)t * M * DM;
        const int row0 = u.pm * BM + wr * 64 + fr, col0 = (u.pn & 3) * BM + wc * 32 + 8 * fq;
        const bool sg = t >= 6;
#pragma unroll
        for (int ai = 0; ai < 2; ++ai)
#pragma unroll
            for (int m = 0; m < 4; ++m) { bf16_t* rowp = base + (size_t)(row0 + ai * HALF + m * 16) * DM + col0;
#pragma unroll
                for (int bj = 0; bj < 2; ++bj) { f32x4 v0 = acc[ai][bj][m][0], v1 = acc[ai][bj][m][1];
                    if (sg) {
#pragma unroll
                        for (int i = 0; i < 4; ++i) { v0[i] = fast_sigmoid(v0[i]); v1[i] = fast_sigmoid(v1[i]); } }
                    u32x4 w; w.x = cvt_pk_bf16(v0[0], v0[1]); w.y = cvt_pk_bf16(v0[2], v0[3]); w.z = cvt_pk_bf16(v1[0], v1[1]); w.w = cvt_pk_bf16(v1[2], v1[3]);
                    *(u32x4*)(rowp + bj * HALF) = w; } }
    }
};
struct EpiResid {
    static constexpr bool PERM = false, AFTER_DRAIN = false;
    float* X; const float* gate; float sc;
    __device__ __forceinline__ void operator()(const f32x4 (&acc)[2][2][4][2], const Unit& u, int wr, int wc, int fr, int fq) const {
        const int col0 = u.pn * BM + wc * 32 + 4 * fq;
#pragma unroll
        for (int ai = 0; ai < 2; ++ai)
#pragma unroll
            for (int m = 0; m < 4; ++m) { const int r = u.pm * BM + ai * HALF + wr * 64 + m * 16 + fr;
                const float* gp = gate + (size_t)mod_row(r) * NMOD + col0; float* xp = X + (size_t)r * DM + col0;
#pragma unroll
                for (int bj = 0; bj < 2; ++bj)
#pragma unroll
                    for (int n = 0; n < 2; ++n) { const int off = bj * HALF + n * 16; const f32x4 g4 = *(const f32x4*)(gp + off); const f32x4 x4 = *(const f32x4*)(xp + off);
                        *(f32x4*)(xp + off) = x4 + (g4 * sc) * acc[ai][bj][m][n]; }
                asm volatile("" ::: "memory"); }
    }
};
template <bool FIRST> struct EpiGate {
    static constexpr bool PERM = true, AFTER_DRAIN = false;
    bf16_t* T; const bf16_t* G;
    __device__ __forceinline__ void operator()(const f32x4 (&acc)[2][2][4][2], const Unit& u, int wr, int wc, int fr, int fq) const {
        const int row0 = u.pm * BM + wr * 64 + fr, col0 = u.pn * BM + wc * 32 + 8 * fq;
#pragma unroll
        for (int ai = 0; ai < 2; ++ai)
#pragma unroll
            for (int m = 0; m < 4; ++m) { const size_t ro = (size_t)(row0 + ai * HALF + m * 16) * DM + col0;
#pragma unroll
                for (int bj = 0; bj < 2; ++bj) { const u32x4 gw = *(const u32x4*)(G + ro + bj * HALF);
                    const f32x4 a0 = acc[ai][bj][m][0], a1 = acc[ai][bj][m][1];
                    float o[8];
                    o[0] = bf_lo(gw.x) * a0[0]; o[1] = bf_hi(gw.x) * a0[1]; o[2] = bf_lo(gw.y) * a0[2]; o[3] = bf_hi(gw.y) * a0[3];
                    o[4] = bf_lo(gw.z) * a1[0]; o[5] = bf_hi(gw.z) * a1[1]; o[6] = bf_lo(gw.w) * a1[2]; o[7] = bf_hi(gw.w) * a1[3];
                    if (!FIRST) { const u32x4 tw = *(const u32x4*)(T + ro + bj * HALF);
                        o[0] += bf_lo(tw.x); o[1] += bf_hi(tw.x); o[2] += bf_lo(tw.y); o[3] += bf_hi(tw.y); o[4] += bf_lo(tw.z); o[5] += bf_hi(tw.z); o[6] += bf_lo(tw.w); o[7] += bf_hi(tw.w); }
                    u32x4 w; w.x = cvt_pk_bf16(o[0], o[1]); w.y = cvt_pk_bf16(o[2], o[3]); w.z = cvt_pk_bf16(o[4], o[5]); w.w = cvt_pk_bf16(o[6], o[7]);
                    *(u32x4*)(T + ro + bj * HALF) = w; } }
    }
};
}

constexpr size_t MiB = 1u << 20;
constexpr size_t WS_CTL = 0, CTL_ZERO_BYTES = 1 * MiB;
constexpr size_t WO_GU1 = 0, WO_D1 = WO_GU1 + (size_t)2 * DFF * DM, WO_IN = WO_D1 + (size_t)DFF * DM, WO_SSD = WO_IN + (size_t)DPROJ * DM,
                 WO_SC = WO_SSD + (size_t)DM * DM, WO_O = WO_SC + (size_t)DM * DM, WO_GU2 = WO_O + (size_t)DM * DM, WO_D2 = WO_GU2 + (size_t)2 * DFF * DM,
                 W_LAYER_ELEMS = WO_D2 + (size_t)DFF * DM;
constexpr size_t WS_WT = 1 * MiB;
constexpr size_t WS_MOD = 112 * MiB;
constexpr size_t WS_DT = 122 * MiB;
constexpr size_t WS_CA = 124 * MiB;
constexpr size_t WS_H = 125 * MiB;
constexpr size_t WS_S = 159 * MiB;
constexpr size_t WS_P = 223 * MiB;
constexpr size_t WS_END = 495 * MiB;
static_assert(WS_WT + 2 * W_LAYER_ELEMS * 2 <= WS_MOD && WS_MOD + (size_t)2 * NSEQ * NMOD * 4 <= WS_DT && WS_DT + (size_t)M * 16 * 4 <= WS_CA && WS_H + (size_t)M * DM * 2 <= WS_S && WS_P + (size_t)8 * M * DM * 2 <= WS_END, "d_ws map");
constexpr size_t PT = (size_t)M * DM;
enum ProjT { PT_Z = 0, PT_XS = 1, PT_BC = 2, PT_SCB = 3, PT_SCC = 4, PT_SCH = 5, PT_GSSD = 6, PT_GSC = 7 };
constexpr int CW_BAR = 4096;

constexpr int NWAVES = 8;
constexpr int RING_OFF = 0, RING_BYTES = 131072;
constexpr int LDSCTL_OFF = RING_BYTES, MISC_OFF = LDSCTL_OFF + 320;
constexpr int LDS_BYTES = 147456;

#define GAS __attribute__((address_space(1)))
#define LAS __attribute__((address_space(3)))
typedef unsigned short bf16;
typedef unsigned v4u __attribute__((ext_vector_type(4)));
typedef float f32x4 __attribute__((ext_vector_type(4)));
typedef short bf16x8 __attribute__((ext_vector_type(8)));
typedef GAS unsigned gu32;
typedef GAS unsigned long long gu64;
#define RLX_AGENT __ATOMIC_RELAXED, __HIP_MEMORY_SCOPE_AGENT
#define LDS_WAIT() asm volatile("s_waitcnt lgkmcnt(0)" ::: "memory")
#define VM_WAIT() asm volatile("s_waitcnt vmcnt(0)" ::: "memory")
__device__ __forceinline__ unsigned long long rt() { return __builtin_amdgcn_s_memrealtime(); }
__device__ __forceinline__ unsigned f2bf(float f) { unsigned u = __builtin_bit_cast(unsigned, f); return (u + 0x7fffu + ((u >> 16) & 1u)) >> 16; }
__device__ __forceinline__ unsigned pk2(float lo, float hi) { return f2bf(lo) | (f2bf(hi) << 16); }

#define XB_TMO      128
#define XB_XCNT(j)  (256  + 64 * (j))
#define XB_XSUB(j)  (1280 + 64 * (j))
#define XB_XGEN(j)  (2304 + 64 * (j))
#define XB_TOP      3328
#define XB_TOPGEN   3392
#define XCD_BAR_WORDS 3456
#define XB_SPIN_CAP (1u << 18)

__device__ __forceinline__ unsigned xb_ld(unsigned* p)              { return __hip_atomic_load(p, __ATOMIC_RELAXED, __HIP_MEMORY_SCOPE_AGENT); }
__device__ __forceinline__ unsigned xb_add(unsigned* p, unsigned v) { return __hip_atomic_fetch_add(p, v, __ATOMIC_RELAXED, __HIP_MEMORY_SCOPE_AGENT); }
__device__ __forceinline__ unsigned xb_xcc_id() { return (unsigned)__builtin_amdgcn_s_getreg((3 << 11) | 20) & 0xFu; }
#define XB_SPIN(cond, bar) do { unsigned _sp = 0; while (cond) { __builtin_amdgcn_s_sleep(1); \
    if ((++_sp & 255u) == 0u) { if (xb_ld(&(bar)[XB_TMO])) break; if (_sp > XB_SPIN_CAP) { atomicAdd(&(bar)[XB_TMO], 1u); break; } } } } while (0)

struct XcdBarrier {
    unsigned* bar; unsigned x;
    volatile LAS unsigned* st;
};

__device__ __forceinline__ XcdBarrier xcd_barrier_post(unsigned* bar, volatile LAS unsigned* st) {
    XcdBarrier b; b.bar = bar; b.x = xb_xcc_id(); b.st = st;
    if (threadIdx.x == 0) (void)xb_add(&bar[XB_XCNT(b.x)], 1u);
    return b;
}
__device__ __forceinline__ void xcd_barrier_complete(unsigned* bar, unsigned x, unsigned& nloc, unsigned& nx) {
    const unsigned G = gridDim.x * gridDim.y * gridDim.z;
    unsigned sum, cnt, mine, sp = 0u;
    for (;;) {
        sum = 0u; cnt = 0u; mine = 0u;
#pragma unroll
        for (unsigned j = 0; j < 16; ++j) { const unsigned c = xb_ld(&bar[XB_XCNT(j)]); sum += c; cnt += (c > 0u) ? 1u : 0u; mine = (j == x) ? c : mine; }
        if (sum == G) break;
        __builtin_amdgcn_s_sleep(1);
        if ((++sp & 255u) == 0u) { if (xb_ld(&bar[XB_TMO])) break; if (sp > XB_SPIN_CAP) { atomicAdd(&bar[XB_TMO], 1u); break; } }
    }
    nloc = mine > 0u ? mine : 1u; nx = cnt > 0u ? cnt : 1u;
}

__device__ __forceinline__ void xcd_barrier(const XcdBarrier& b) {
    asm volatile("s_waitcnt vmcnt(0)" ::: "memory");
    __syncthreads();
    if (threadIdx.x == 0) {
        const unsigned myx = xb_xcc_id();
        unsigned* bar = b.bar; asm volatile("" : "+s"(bar));
        __builtin_amdgcn_s_waitcnt(0);
        unsigned nloc = b.st[0], nx = b.st[1];
        if (nloc == 0u) { xcd_barrier_complete(bar, myx, nloc, nx); b.st[0] = nloc; b.st[1] = nx; }
        const unsigned old = xb_add(&bar[XB_XSUB(myx)], 1u);
        const unsigned gen = old / nloc;
        if (old + 1u == (gen + 1u) * nloc) {
            __builtin_amdgcn_fence(__ATOMIC_RELEASE, "agent");
            asm volatile("s_waitcnt vmcnt(0)" ::: "memory");
            const unsigned og = xb_add(&bar[XB_TOP], 1u);
            const unsigned tg = og / nx;
            if (og + 1u == (tg + 1u) * nx) xb_add(&bar[XB_TOPGEN], 1u);
            else XB_SPIN(xb_ld(&bar[XB_TOPGEN]) == tg, bar);
            __builtin_amdgcn_fence(__ATOMIC_ACQUIRE, "agent");
            xb_add(&bar[XB_XGEN(myx)], 1u);
            asm volatile("s_waitcnt vmcnt(0)" ::: "memory");
        } else {
            XB_SPIN(xb_ld(&bar[XB_XGEN(myx)]) == gen, bar);
            __builtin_amdgcn_fence(__ATOMIC_ACQUIRE, "agent");
            asm volatile("s_waitcnt vmcnt(0)" ::: "memory");
        }
    }
    __syncthreads();
}

struct Frame {
    LAS unsigned char* lds;
    volatile LAS unsigned* MISC;
    gu32* ctl;
    int tid, lane, wave;
    int vcu, G;
    float* out;
    unsigned char* ws;
};
typedef const unsigned char __attribute__((address_space(4)))* kptr_t;
__device__ __forceinline__ const float* in_ptr(int i) {
    kptr_t kp = (kptr_t)__builtin_amdgcn_kernarg_segment_ptr();
    asm volatile("" : "+s"(kp));
    return *(const float* const __attribute__((address_space(4)))*)(kp + 8 * i);
}
__device__ __forceinline__ bf16* wt_ptr(const Frame& F, int layer, size_t off) { return (bf16*)(F.ws + WS_WT) + (size_t)layer * W_LAYER_ELEMS + off; }
__device__ __forceinline__ bf16* proj_ptr(const Frame& F, int t) { return (bf16*)(F.ws + WS_P) + (size_t)t * PT; }
__device__ __forceinline__ float* mod_ptr(const Frame& F, int layer, int chunk) { return (float*)(F.ws + WS_MOD) + (size_t)layer * NSEQ * NMOD + (size_t)chunk * DM; }

__device__ __forceinline__ void frame_refresh(Frame& F) {
    int t = threadIdx.x; asm volatile("" : "+v"(t));
    F.tid = t; F.lane = t & 63; F.wave = __builtin_amdgcn_readfirstlane(t >> 6);
    int bx = blockIdx.x; asm volatile("" : "+s"(bx));
    F.G = gridDim.x; F.vcu = (F.G % 8 == 0) ? (bx % 8) * (F.G / 8) + bx / 8 : bx;
    kptr_t kp = (kptr_t)__builtin_amdgcn_kernarg_segment_ptr(); asm volatile("" : "+s"(kp));
    F.out = *(float* const __attribute__((address_space(4)))*)(kp + 224); F.ws = *(unsigned char* const __attribute__((address_space(4)))*)(kp + 232);
}
__device__ __forceinline__ float wave_sum(float v) {
#pragma unroll
    for (int o = 1; o < 64; o <<= 1) v += __shfl_xor(v, o);
    return v;
}
__device__ __forceinline__ float bf2f(bf16 b) { return __uint_as_float((unsigned)b << 16); }

template <int MAP> __device__ __forceinline__ int dest_row(int c) {
    if (MAP == 1) { return c < DFF ? (((c >> 7) << 8) + (c & 127)) : ((((c - DFF) >> 7) << 8) + 128 + ((c - DFF) & 127)); }
    if (MAP == 2) { return c < 3072 ? c : (c < 3088 ? 8192 + (c - 3072) : c - 16); }
    return c;
}
template <int MAP> __device__ __forceinline__ void p0_transpose_item(const float* W, int K, int N, bf16* WT, LAS float* scr, int item, int lane) {
    const int nblk = (N + 31) / 32, kb = item / nblk, nb = item % nblk, k0 = 64 * kb, n0 = 32 * nb;
    const int nn = n0 + (lane & 31); const bool nok = nn < N;
#pragma unroll 8
    for (int i = 0; i < 32; ++i) { const int kk = 2 * i + (lane >> 5); scr[kk * 33 + (lane & 31)] = nok ? W[(size_t)(k0 + kk) * N + nn] : 0.f; }
    LDS_WAIT(); asm volatile("" ::: "memory");
    const int c = lane & 7;
#pragma unroll
    for (int j = 0; j < 4; ++j) { const int nl = (lane >> 3) + 8 * j; const LAS float* s = scr + (8 * c) * 33 + nl;
        v4u o; o.x = pk2(s[0 * 33], s[1 * 33]); o.y = pk2(s[2 * 33], s[3 * 33]); o.z = pk2(s[4 * 33], s[5 * 33]); o.w = pk2(s[6 * 33], s[7 * 33]);
        if (n0 + nl < N) *(GAS v4u*)(WT + (size_t)dest_row<MAP>(n0 + nl) * K + k0 + 8 * c) = o; }
    LDS_WAIT(); asm volatile("" ::: "memory");
}
template <int MAP> __device__ __forceinline__ void p0_transpose(Frame& F, const float* W, int K, int N, bf16* WT, int& rot) {
    LAS float* scr = (LAS float*)(F.lds + RING_OFF + F.wave * 16384);
    const int NGW = F.G * NWAVES; const int gw = (F.vcu * NWAVES + F.wave + NGW - rot) % NGW;
    const int nitems = (K / 64) * ((N + 31) / 32);
    for (int it = gw; it < nitems; it += NGW) p0_transpose_item<MAP>(W, K, N, WT, scr, it, F.lane);
    rot = (rot + nitems) % NGW;
}
__device__ __forceinline__ void p0_prologue(Frame& F) {
    frame_refresh(F);
    int rot = 0;
    for (int l = 0; l < DEPTH; ++l) p0_transpose<0>(F, in_ptr(7) + (size_t)l * DM * NMOD, DM, NMOD, (bf16*)(F.ws + WS_P) + (size_t)l * NMOD * DM, rot);
    for (int l = 0; l < DEPTH; ++l) {
        p0_transpose<1>(F, in_ptr(12) + (size_t)l * DM * 2 * DFF, DM, 2 * DFF, wt_ptr(F, l, WO_GU1), rot);
        p0_transpose<0>(F, in_ptr(13) + (size_t)l * DFF * DM, DFF, DM, wt_ptr(F, l, WO_D1), rot);
        p0_transpose<2>(F, in_ptr(16) + (size_t)l * DM * DPROJ, DM, DPROJ, wt_ptr(F, l, WO_IN), rot);
        p0_transpose<0>(F, in_ptr(23) + (size_t)l * DM * DM, DM, DM, wt_ptr(F, l, WO_SSD), rot);
        p0_transpose<0>(F, in_ptr(25) + (size_t)l * DM * DM, DM, DM, wt_ptr(F, l, WO_SC), rot);
        p0_transpose<0>(F, in_ptr(26) + (size_t)l * DM * DM, DM, DM, wt_ptr(F, l, WO_O), rot);
        p0_transpose<1>(F, in_ptr(14) + (size_t)l * DM * 2 * DFF, DM, 2 * DFF, wt_ptr(F, l, WO_GU2), rot);
        p0_transpose<0>(F, in_ptr(15) + (size_t)l * DFF * DM, DFF, DM, wt_ptr(F, l, WO_D2), rot);
    }
    const int gt = F.vcu * (NWAVES * 64) + F.tid, NT = F.G * NWAVES * 64;
    { const f32x4* xp = (const f32x4*)in_ptr(0); const f32x4* xs = (const f32x4*)in_ptr(1); f32x4* o = (f32x4*)F.out;
      const int np = MP * DM / 4, ns = MS * DM / 4;
      for (int i = gt; i < np + ns; i += NT) o[i] = i < np ? xp[i] : xs[i - np]; }
    { bf16* ca = (bf16*)(F.ws + WS_CA);
      for (int i = gt; i < 256 * DM; i += NT) { const int r = i >> 10, c = i & 1023; float v = 0.f;
          if (r < NB_P) v = in_ptr(2)[r * DM + c]; else if (r < NSEQ) v = in_ptr(3)[(r - NB_P) * DM + c];
          ca[i] = (bf16)f2bf(r < NSEQ ? v / (1.f + __expf(-v)) : 0.f); } }
}

__device__ __forceinline__ void norm_phase(Frame& F, const float* gain, const float* shift, const float* scale  ) {
    frame_refresh(F);
    const int gw = F.vcu * NWAVES + F.wave, NGW = F.G * NWAVES;
    const float* X = F.out; bf16* H = (bf16*)(F.ws + WS_H);
    f32x4 gv[4];
#pragma unroll
    for (int j = 0; j < 4; ++j) gv[j] = ((const f32x4*)gain)[F.lane + 64 * j];
    for (int m = gw; m < M; m += NGW) {
        const f32x4* xr = (const f32x4*)(X + (size_t)m * DM) + F.lane;
        const int br = mod_row(m);
        const f32x4* sh = (const f32x4*)(shift + (size_t)br * NMOD) + F.lane; const f32x4* sc = (const f32x4*)(scale + (size_t)br * NMOD) + F.lane;
        f32x4 v[4]; float s = 0.f;
#pragma unroll
        for (int j = 0; j < 4; ++j) { v[j] = xr[64 * j]; s += (v[j].x * v[j].x + v[j].y * v[j].y) + (v[j].z * v[j].z + v[j].w * v[j].w); }
        const float r = 1.f / sqrtf(wave_sum(s) * (1.f / DM) + EPS);
        unsigned long long* o8 = (unsigned long long*)(H + (size_t)m * DM) + F.lane;
#pragma unroll
        for (int j = 0; j < 4; ++j) { const f32x4 a = sh[64 * j], b = sc[64 * j]; const f32x4 h = (v[j] * r) * gv[j] * (b + 1.f) + a;
            o8[64 * j] = (unsigned long long)pk2(h.x, h.y) | ((unsigned long long)pk2(h.z, h.w) << 32); }
    }
}
__device__ __forceinline__ void final_norm_phase(Frame& F) {
    frame_refresh(F);
    const int gw = F.vcu * NWAVES + F.wave, NGW = F.G * NWAVES;
    f32x4 gv[4];
#pragma unroll
    for (int j = 0; j < 4; ++j) gv[j] = ((const f32x4*)in_ptr(27))[F.lane + 64 * j];
    for (int m = gw; m < M; m += NGW) {
        f32x4* xr = (f32x4*)(F.out + (size_t)m * DM) + F.lane;
        f32x4 v[4]; float s = 0.f;
#pragma unroll
        for (int j = 0; j < 4; ++j) { v[j] = xr[64 * j]; s += (v[j].x * v[j].x + v[j].y * v[j].y) + (v[j].z * v[j].z + v[j].w * v[j].w); }
        const float r = 1.f / sqrtf(wave_sum(s) * (1.f / DM) + EPS);
#pragma unroll
        for (int j = 0; j < 4; ++j) xr[64 * j] = (v[j] * r) * gv[j];
    }
}

__device__ __forceinline__ void dt_phase(Frame& F, int layer) {
    frame_refresh(F);
    const int gw = F.vcu * NWAVES + F.wave, NGW = F.G * NWAVES;
    const bf16* H = (const bf16*)(F.ws + WS_H); const bf16* Wd = wt_ptr(F, layer, WO_IN) + (size_t)8192 * DM;
    float* DT = (float*)(F.ws + WS_DT);
    const int fr = F.lane & 15, fq = F.lane >> 4;
    const float bias = in_ptr(19)[layer * 16 + fr];
    for (int it = gw; it < M / 16; it += NGW) {
        const bf16* ap = H + (size_t)(it * 16 + fr) * DM + 8 * fq; const bf16* bp = Wd + (size_t)fr * DM + 8 * fq;
        f32x4 acc = {0.f, 0.f, 0.f, 0.f};
#pragma unroll 8
        for (int kk = 0; kk < DM / 32; ++kk) { const bf16x8 a = *(const bf16x8*)(ap + kk * 32), b = *(const bf16x8*)(bp + kk * 32);
            acc = __builtin_amdgcn_mfma_f32_16x16x32_bf16(a, b, acc, 0, 0, 0); }
#pragma unroll
        for (int r = 0; r < 4; ++r) { const float x = acc[r] + bias; const float sp = x > 20.f ? x : log1pf(__expf(x)); DT[(size_t)(it * 16 + 4 * fq + r) * 16 + fr] = sp; }
    }
}

__device__ __forceinline__ void shortconv_phase(Frame& F, int layer) {
    frame_refresh(F);
    const int gt = F.vcu * (NWAVES * 64) + F.tid, NT = F.G * NWAVES * 64;
    bf16* SB = proj_ptr(F, PT_SCB); const bf16* SC = proj_ptr(F, PT_SCC); const bf16* SH = proj_ptr(F, PT_SCH);
    const float* cw = in_ptr(24) + (size_t)layer * 3 * DM;
    const float* st = in_ptr(6) + (size_t)layer * NB_S * 2 * DM;
    float* o_p = F.out + (size_t)M * DM + (size_t)DEPTH * NB_P * 16 * 64 * 128 + (size_t)DEPTH * NB_P * 3 * DXBC + (size_t)layer * NB_P * 2 * DM;
    float* o_s = F.out + (size_t)M * DM + (size_t)DEPTH * NB_P * 16 * 64 * 128 + (size_t)DEPTH * NB_P * 3 * DXBC + (size_t)DEPTH * NB_P * 2 * DM
                 + (size_t)DEPTH * NB_S * 16 * 64 * 128 + (size_t)DEPTH * NB_S * 3 * DXBC + (size_t)layer * NB_S * 2 * DM;
    for (int idx = gt; idx < M * (DM / 8); idx += NT) {
        const int m = idx >> 7, j0 = (idx & 127) * 8;
        const bool prm = m < MP; const int t = prm ? (m & (SEQ_P - 1)) : ((m - MP) & (SEQ_S - 1)); const int sq = prm ? (m >> 11) : ((m - MP) >> 3); const int L = prm ? SEQ_P : SEQ_S;
        const size_t ro = (size_t)m * DM + j0;
        const v4u c0 = *(const v4u*)(SC + ro), h0 = *(const v4u*)(SH + ro), bb = *(const v4u*)(SB + ro);
        float cur[8], p1[8], p2[8], bv[8];
        cur[0] = bf_lo(c0.x) * bf_lo(h0.x); cur[1] = bf_hi(c0.x) * bf_hi(h0.x); cur[2] = bf_lo(c0.y) * bf_lo(h0.y); cur[3] = bf_hi(c0.y) * bf_hi(h0.y);
        cur[4] = bf_lo(c0.z) * bf_lo(h0.z); cur[5] = bf_hi(c0.z) * bf_hi(h0.z); cur[6] = bf_lo(c0.w) * bf_lo(h0.w); cur[7] = bf_hi(c0.w) * bf_hi(h0.w);
        bv[0] = bf_lo(bb.x); bv[1] = bf_hi(bb.x); bv[2] = bf_lo(bb.y); bv[3] = bf_hi(bb.y); bv[4] = bf_lo(bb.z); bv[5] = bf_hi(bb.z); bv[6] = bf_lo(bb.w); bv[7] = bf_hi(bb.w);
        if (t >= 1) { const v4u c1 = *(const v4u*)(SC + ro - DM), h1 = *(const v4u*)(SH + ro - DM);
            p1[0] = bf_lo(c1.x) * bf_lo(h1.x); p1[1] = bf_hi(c1.x) * bf_hi(h1.x); p1[2] = bf_lo(c1.y) * bf_lo(h1.y); p1[3] = bf_hi(c1.y) * bf_hi(h1.y);
            p1[4] = bf_lo(c1.z) * bf_lo(h1.z); p1[5] = bf_hi(c1.z) * bf_hi(h1.z); p1[6] = bf_lo(c1.w) * bf_lo(h1.w); p1[7] = bf_hi(c1.w) * bf_hi(h1.w);
        } else {
#pragma unroll
            for (int i = 0; i < 8; ++i) p1[i] = prm ? 0.f : st[((size_t)sq * 2 + 1) * DM + j0 + i]; }
        if (t >= 2) { const v4u c2 = *(const v4u*)(SC + ro - 2 * DM), h2 = *(const v4u*)(SH + ro - 2 * DM);
            p2[0] = bf_lo(c2.x) * bf_lo(h2.x); p2[1] = bf_hi(c2.x) * bf_hi(h2.x); p2[2] = bf_lo(c2.y) * bf_lo(h2.y); p2[3] = bf_hi(c2.y) * bf_hi(h2.y);
            p2[4] = bf_lo(c2.z) * bf_lo(h2.z); p2[5] = bf_hi(c2.z) * bf_hi(h2.z); p2[6] = bf_lo(c2.w) * bf_lo(h2.w); p2[7] = bf_hi(c2.w) * bf_hi(h2.w);
        } else {
#pragma unroll
            for (int i = 0; i < 8; ++i) p2[i] = prm ? 0.f : st[((size_t)sq * 2 + t) * DM + j0 + i]; }
        float o[8];
#pragma unroll
        for (int i = 0; i < 8; ++i) o[i] = bv[i] * (cw[j0 + i] * p2[i] + cw[DM + j0 + i] * p1[i] + cw[2 * DM + j0 + i] * cur[i]);
        v4u w; w.x = pk2(o[0], o[1]); w.y = pk2(o[2], o[3]); w.z = pk2(o[4], o[5]); w.w = pk2(o[6], o[7]);
        *(v4u*)(SB + ro) = w;
        if (t >= L - 2) { float* op = (prm ? o_p : o_s) + ((size_t)sq * 2 + (t - (L - 2))) * DM + j0;
            *(f32x4*)op = (f32x4){cur[0], cur[1], cur[2], cur[3]}; *(f32x4*)(op + 4) = (f32x4){cur[4], cur[5], cur[6], cur[7]}; }
    }
}

__device__ __forceinline__ void ssd_unit(Frame& F, int layer, int seq, int g) {
    const int tid = F.tid, lane = F.lane, wave = F.wave;
    const bool prm = seq < NB_P; const int L = prm ? SEQ_P : SEQ_S; const int sq = prm ? seq : seq - NB_P;
    const size_t mbase = prm ? (size_t)seq * SEQ_P : (size_t)MP + (size_t)sq * SEQ_S;
    LAS float* cv = (LAS float*)(F.lds); LAS float* ybuf = (LAS float*)(F.lds + 16384); LAS float* dts = (LAS float*)(F.lds + 24576); LAS float* dAs = (LAS float*)(F.lds + 24704);
    const bf16* src; int col, chan;
    if (tid < 256) { src = proj_ptr(F, PT_XS); col = g * 256 + tid; chan = col; }
    else if (tid < 384) { src = proj_ptr(F, PT_BC); col = g * 128 + (tid - 256); chan = 1024 + col; }
    else { src = proj_ptr(F, PT_BC); col = 512 + g * 128 + (tid - 384); chan = 1024 + col; }
    const float* cwp = in_ptr(17) + (size_t)layer * 4 * DXBC + chan;
    const float cw0 = cwp[0], cw1 = cwp[DXBC], cw2 = cwp[2 * DXBC], cw3 = cwp[3 * DXBC], cb = in_ptr(18)[(size_t)layer * DXBC + chan];
    float w0 = 0.f, w1 = 0.f, w2 = 0.f;
    if (!prm) { const float* cs = in_ptr(5) + ((size_t)layer * NB_S + sq) * 3 * DXBC + chan; w0 = cs[0]; w1 = cs[DXBC]; w2 = cs[2 * DXBC]; }
    const int hh = tid >> 7, i7 = tid & 127, nseg = i7 & 7, pg = i7 >> 3, head = g * 4 + hh;
    float s[4][16];
    float* nst = F.out + (size_t)M * DM + (prm ? (size_t)0 : (size_t)DEPTH * NB_P * 16 * 8192 + (size_t)DEPTH * NB_P * 3 * DXBC + (size_t)DEPTH * NB_P * 2 * DM)
                 + (((size_t)layer * (prm ? NB_P : NB_S) + sq) * 16 + head) * 8192;
    if (prm) {
#pragma unroll
        for (int r = 0; r < 4; ++r)
#pragma unroll
            for (int i = 0; i < 16; ++i) s[r][i] = 0.f;
    } else { const float* sp = in_ptr(4) + (((size_t)layer * NB_S + sq) * 16 + head) * 8192;
#pragma unroll
        for (int r = 0; r < 4; ++r)
#pragma unroll
            for (int q = 0; q < 4; ++q) { const f32x4 v = *(const f32x4*)(sp + (size_t)(pg + 16 * r) * 128 + 16 * nseg + 4 * q); s[r][4 * q] = v.x; s[r][4 * q + 1] = v.y; s[r][4 * q + 2] = v.z; s[r][4 * q + 3] = v.w; } }
    const float* DT = (const float*)(F.ws + WS_DT);
    bf16* Z = proj_ptr(F, PT_Z);
    const int ech = lane * 4;
    const float Dh = in_ptr(21)[layer * 16 + g * 4 + (ech >> 6)];
    const f32x4 nw = *(const f32x4*)(in_ptr(22) + (size_t)layer * DM + g * 256 + ech);
    float a_neg = 0.f;
    if (tid < 32) a_neg = -__expf(in_ptr(20)[layer * 16 + g * 4 + (tid & 3)]);
    float pre[8];
#pragma unroll
    for (int j = 0; j < 8; ++j) pre[j] = bf2f(src[(mbase + j) * DM + col]);
    for (int t0 = 0; t0 < L; t0 += 8) {
        const unsigned long long zw = *(const unsigned long long*)(Z + (mbase + t0 + wave) * DM + g * 256 + ech);
        float dtv_l = 0.f; if (tid < 32) dtv_l = DT[(mbase + t0 + (tid >> 2)) * 16 + g * 4 + (tid & 3)];
#pragma unroll
        for (int j = 0; j < 8; ++j) { const float v = cw0 * w0 + cw1 * w1 + cw2 * w2 + cw3 * pre[j] + cb; w0 = w1; w1 = w2; w2 = pre[j]; cv[j * 512 + tid] = fast_silu(v); }
        if (t0 + 8 < L) {
#pragma unroll
            for (int j = 0; j < 8; ++j) pre[j] = bf2f(src[(mbase + t0 + 8 + j) * DM + col]); }
        if (tid < 32) { dts[tid] = dtv_l; dAs[tid] = __expf(dtv_l * a_neg); }
        __syncthreads();
#pragma unroll 1
        for (int j = 0; j < 8; ++j) {
            const float dtv = dts[j * 4 + hh], dA = dAs[j * 4 + hh];
            float Bv[16], Cv[16];
#pragma unroll
            for (int q = 0; q < 4; ++q) { const f32x4 b4 = *(const LAS f32x4*)(cv + j * 512 + 256 + 16 * nseg + 4 * q), c4 = *(const LAS f32x4*)(cv + j * 512 + 384 + 16 * nseg + 4 * q);
                Bv[4 * q] = b4.x; Bv[4 * q + 1] = b4.y; Bv[4 * q + 2] = b4.z; Bv[4 * q + 3] = b4.w; Cv[4 * q] = c4.x; Cv[4 * q + 1] = c4.y; Cv[4 * q + 2] = c4.z; Cv[4 * q + 3] = c4.w; }
#pragma unroll
            for (int r = 0; r < 4; ++r) { const float xv = cv[j * 512 + hh * 64 + pg + 16 * r]; const float coef = dtv * xv; float acc = 0.f;
#pragma unroll
                for (int i = 0; i < 16; ++i) { s[r][i] = dA * s[r][i] + coef * Bv[i]; acc += Cv[i] * s[r][i]; }
                acc += __shfl_xor(acc, 1); acc += __shfl_xor(acc, 2); acc += __shfl_xor(acc, 4);
                if (nseg == 0) ybuf[j * 256 + hh * 64 + pg + 16 * r] = acc; }
        }
        __syncthreads();
        {
            const f32x4 y4 = *(const LAS f32x4*)(ybuf + wave * 256 + ech), x4 = *(const LAS f32x4*)(cv + wave * 512 + ech);
            const unsigned zl = (unsigned)zw, zh = (unsigned)(zw >> 32);
            f32x4 y;
            y.x = (y4.x + x4.x * Dh) * fast_silu(bf_lo(zl)); y.y = (y4.y + x4.y * Dh) * fast_silu(bf_hi(zl));
            y.z = (y4.z + x4.z * Dh) * fast_silu(bf_lo(zh)); y.w = (y4.w + x4.w * Dh) * fast_silu(bf_hi(zh));
            const float ss = wave_sum((y.x * y.x + y.y * y.y) + (y.z * y.z + y.w * y.w));
            const float r = 1.f / sqrtf(ss * (1.f / 256.f) + EPS);
            const f32x4 o = (y * r) * nw;
            *(unsigned long long*)(Z + (mbase + t0 + wave) * DM + g * 256 + ech) = (unsigned long long)pk2(o.x, o.y) | ((unsigned long long)pk2(o.z, o.w) << 32);
        }
        __syncthreads();
    }
#pragma unroll
    for (int r = 0; r < 4; ++r)
#pragma unroll
        for (int q = 0; q < 4; ++q) *(f32x4*)(nst + (size_t)(pg + 16 * r) * 128 + 16 * nseg + 4 * q) = (f32x4){s[r][4 * q], s[r][4 * q + 1], s[r][4 * q + 2], s[r][4 * q + 3]};
    { float* oc = F.out + (size_t)M * DM + (size_t)DEPTH * NB_P * 16 * 8192
                  + (prm ? (size_t)0 : (size_t)DEPTH * NB_P * 3 * DXBC + (size_t)DEPTH * NB_P * 2 * DM + (size_t)DEPTH * NB_S * 16 * 8192)
                  + ((size_t)layer * (prm ? NB_P : NB_S) + sq) * 3 * DXBC + chan;
      oc[0] = w0; oc[DXBC] = w1; oc[2 * DXBC] = w2; }
}
__device__ __forceinline__ void ssd_phase(Frame& F, int layer) {
    frame_refresh(F);
    const int v = F.vcu;
    if (v < 32) { ssd_unit(F, layer, v >> 2, v & 3); }
    else { for (int u = v - 32; u < NB_S * 4; u += F.G - 32) ssd_unit(F, layer, NB_P + (u >> 2), u & 3); }
}

struct Args { const float* in[28]; float* out; unsigned char* ws; };
__global__ void __launch_bounds__(NWAVES * 64, 2) mega_fwd(Args args) {
    extern __shared__ __attribute__((aligned(16))) unsigned char lds[];
    Frame F;
    F.lds = (LAS unsigned char*)lds;
    F.MISC = (volatile LAS unsigned*)(F.lds + MISC_OFF);
    F.tid = threadIdx.x; F.lane = F.tid & 63; F.wave = __builtin_amdgcn_readfirstlane(F.tid >> 6);
    F.G = gridDim.x; { const int bx = blockIdx.x; F.vcu = (F.G % 8 == 0) ? (bx % 8) * (F.G / 8) + bx / 8 : bx; }
    F.out = args.out; F.ws = args.ws;
    F.ctl = (gu32*)(F.ws + WS_CTL);
    for (int u = F.tid; u < (LDS_BYTES - LDSCTL_OFF) / 4; u += NWAVES * 64) ((LAS unsigned*)(F.lds + LDSCTL_OFF))[u] = 0u;
    __syncthreads();
    XcdBarrier bar = xcd_barrier_post((unsigned*)(F.ctl + CW_BAR), F.MISC + 8);
#define GRID_BAR() xcd_barrier(bar)
#ifndef PH_MASK
#define PH_MASK 0xffff
#endif
#define PH(k) (((PH_MASK) >> (k)) & 1)
#define Hb ((bf16*)(F.ws + WS_H))
#define Tb ((bf16*)(F.ws + WS_S))
#define ACT ((bf16*)(F.ws + WS_P))

    if (PH(0)) p0_prologue(F);
    GRID_BAR();
    if (PH(1)) for (int l = 0; l < DEPTH; ++l) {
        frame_refresh(F);
        pg8::Gemm g{(const bf16*)(F.ws + WS_CA), (const bf16*)(F.ws + WS_P) + (size_t)l * NMOD * DM, 256, NMOD, DM};
        pg8::StaticOrder S; S.init(256, NMOD, F.G, ((int)blockIdx.x + F.G - 36 * l) % F.G);
        pg8::EpiMod E{(float*)(F.ws + WS_MOD) + (size_t)l * NSEQ * NMOD, in_ptr(8) + (size_t)l * NMOD};
        pg8::gemm_phase<pg8::EpiMod, pg8::StaticOrder, true, true>(F.lds + RING_OFF, g, S, E);
    }
    GRID_BAR();
    for (int l = 0; l < DEPTH; ++l) {
        if (PH(2)) norm_phase(F, in_ptr(9) + (size_t)l * DM, mod_ptr(F, l, 0), mod_ptr(F, l, 1));
        GRID_BAR();
        if (PH(3)) { frame_refresh(F); pg8::Gemm g{Hb, wt_ptr(F, l, WO_GU1), M, 2 * DFF, DM}; pg8::StaticOrder S; S.init(M, 2 * DFF, F.G, (int)blockIdx.x);
          pg8::EpiSwiglu E{ACT}; pg8::gemm_phase<pg8::EpiSwiglu, pg8::StaticOrder, true, true>(F.lds + RING_OFF, g, S, E); }
        GRID_BAR();
        if (PH(4)) { frame_refresh(F); pg8::Gemm g{ACT, wt_ptr(F, l, WO_D1), M, DM, DFF}; pg8::StaticOrder S; S.init(M, DM, F.G, (int)blockIdx.x);
          pg8::EpiResid E{F.out, mod_ptr(F, l, 2), 0.5f}; pg8::gemm_phase<pg8::EpiResid, pg8::StaticOrder, true, true>(F.lds + RING_OFF, g, S, E); }
        GRID_BAR();
        if (PH(2)) norm_phase(F, in_ptr(10) + (size_t)l * DM, mod_ptr(F, l, 3), mod_ptr(F, l, 4));
        GRID_BAR();
        if (PH(5)) dt_phase(F, l);
        if (PH(6)) { frame_refresh(F); pg8::Gemm g{Hb, wt_ptr(F, l, WO_IN), M, 8192, DM}; pg8::StaticOrder S; S.init(M, 8192, F.G, (int)blockIdx.x);
          pg8::EpiProj E{(bf16*)(F.ws + WS_P)}; pg8::gemm_phase<pg8::EpiProj, pg8::StaticOrder, true, true>(F.lds + RING_OFF, g, S, E); }
        GRID_BAR();
        if (PH(7)) shortconv_phase(F, l);
        __syncthreads();
        if (PH(8)) ssd_phase(F, l);
        GRID_BAR();
        if (PH(9)) { frame_refresh(F); pg8::Gemm g{proj_ptr(F, PT_Z), wt_ptr(F, l, WO_SSD), M, DM, DM}; pg8::StaticOrder S; S.init(M, DM, F.G, (int)blockIdx.x);
          pg8::EpiGate<true> E{Tb, proj_ptr(F, PT_GSSD)}; pg8::gemm_phase<pg8::EpiGate<true>, pg8::StaticOrder, true, true>(F.lds + RING_OFF, g, S, E); }
        GRID_BAR();
        if (PH(10)) { frame_refresh(F); pg8::Gemm g{proj_ptr(F, PT_SCB), wt_ptr(F, l, WO_SC), M, DM, DM}; pg8::StaticOrder S; S.init(M, DM, F.G, (int)blockIdx.x);
          pg8::EpiGate<false> E{Tb, proj_ptr(F, PT_GSC)}; pg8::gemm_phase<pg8::EpiGate<false>, pg8::StaticOrder, true, true>(F.lds + RING_OFF, g, S, E); }
        GRID_BAR();
        if (PH(11)) { frame_refresh(F); pg8::Gemm g{Tb, wt_ptr(F, l, WO_O), M, DM, DM}; pg8::StaticOrder S; S.init(M, DM, F.G, (int)blockIdx.x);
          pg8::EpiResid E{F.out, mod_ptr(F, l, 5), 1.0f}; pg8::gemm_phase<pg8::EpiResid, pg8::StaticOrder, true, true>(F.lds + RING_OFF, g, S, E); }
        GRID_BAR();
        if (PH(2)) norm_phase(F, in_ptr(11) + (size_t)l * DM, mod_ptr(F, l, 6), mod_ptr(F, l, 7));
        GRID_BAR();
        if (PH(3)) { frame_refresh(F); pg8::Gemm g{Hb, wt_ptr(F, l, WO_GU2), M, 2 * DFF, DM}; pg8::StaticOrder S; S.init(M, 2 * DFF, F.G, (int)blockIdx.x);
          pg8::EpiSwiglu E{ACT}; pg8::gemm_phase<pg8::EpiSwiglu, pg8::StaticOrder, true, true>(F.lds + RING_OFF, g, S, E); }
        GRID_BAR();
        if (PH(4)) { frame_refresh(F); pg8::Gemm g{ACT, wt_ptr(F, l, WO_D2), M, DM, DFF}; pg8::StaticOrder S; S.init(M, DM, F.G, (int)blockIdx.x);
          pg8::EpiResid E{F.out, mod_ptr(F, l, 8), 0.5f}; pg8::gemm_phase<pg8::EpiResid, pg8::StaticOrder, true, true>(F.lds + RING_OFF, g, S, E); }
        GRID_BAR();
    }
    if (PH(12)) final_norm_phase(F);
#undef GRID_BAR
}

extern "C" void kernel_launch(void* const* d_in, const int* in_sizes, int n_in, void* d_out, int out_size, void* d_ws, size_t ws_size, hipStream_t stream) {
    static int grid = 0;
    if (grid == 0) {
        if (n_in != 28 || ws_size < WS_END) { fprintf(stderr, "kernel_launch: built for 28 inputs and >= %zu bytes of workspace; got n_in %d, ws %zu; nothing launched\n", (size_t)WS_END, n_in, ws_size); grid = -1; return; }
        int dev = 0, cus = 0, per_cu = 0;
        if (hipGetDevice(&dev) != hipSuccess || hipDeviceGetAttribute(&cus, hipDeviceAttributeMultiprocessorCount, dev) != hipSuccess) { grid = -1; return; }
        if (hipFuncSetAttribute((const void*)mega_fwd, hipFuncAttributeMaxDynamicSharedMemorySize, LDS_BYTES) != hipSuccess) { fprintf(stderr, "kernel_launch: hipFuncSetAttribute failed\n"); grid = -1; return; }
        if (hipOccupancyMaxActiveBlocksPerMultiprocessor(&per_cu, (const void*)mega_fwd, NWAVES * 64, LDS_BYTES) != hipSuccess || per_cu < 1)
            fprintf(stderr, "kernel_launch: note: occupancy query reports %d workgroups per CU\n", per_cu);
        (void)hipGetLastError();
        grid = cus;
    }
    if (grid < 0) return;
    if (hipMemsetAsync((char*)d_ws + WS_CTL, 0, CTL_ZERO_BYTES, stream) != hipSuccess) { fprintf(stderr, "kernel_launch: hipMemsetAsync failed\n"); return; }
    Args a{};
    for (int i = 0; i < 28; ++i) a.in[i] = (const float*)d_in[i];
    a.out = (float*)d_out; a.ws = (unsigned char*)d_ws;
    hipLaunchKernelGGL(mega_fwd, dim3(grid), dim3(NWAVES * 64), LDS_BYTES, stream, a);
}
```

```cpp
#include <hip/hip_runtime.h>
#include <cstdio>
#include <cstdint>
namespace pg8 {
#define PG8_LAS __attribute__((address_space(3)))
typedef unsigned short bf16_t;
typedef short bf16x8 __attribute__((ext_vector_type(8)));
typedef float f32x4 __attribute__((ext_vector_type(4)));
typedef unsigned u32x4 __attribute__((ext_vector_type(4)));
constexpr int BM = 256, BK = 64, HALF = 128, HTB = HALF * BK * 2  , STAGE_BYTES = 8 * HTB, NXCD = 8, WGM = 4;

__host__ __device__ __forceinline__ int lds_byte(int r, int c) { const int st = (r >> 4) * 2 + (c >> 5), rr = r & 15, cc = c & 31, ob = rr * 64 + cc * 2; return st * 1024 + (ob ^ (((ob >> 9) & 1) << 5)); }
__host__ __device__ __forceinline__ void stage_rc(int b, int& R, int& C) { const int st = b / 1024, sb = b % 1024, swz = sb ^ (((sb >> 9) & 1) << 5); R = (st >> 1) * 16 + swz / 64; C = (st & 1) * 32 + (swz % 64) / 2; }
__host__ __device__ __forceinline__ int perm32(int rho) { const int n = rho >> 4, i = rho & 15; return 8 * (i >> 2) + 4 * n + (i & 3); }

struct Unit { int pm, pn, kind = 0; };
struct Gemm { const bf16_t* A; const bf16_t* Bt; int M, N, K; const bf16_t* A2 = nullptr; const bf16_t* Bt2 = nullptr; };

struct StaticOrder {
    __device__ __forceinline__ int krot(const Unit&) const { return 0; }
    __device__ __forceinline__ void k_ready(const Unit&, int) const {}
    int nM, nN, nwg, G, c;
    __host__ __device__ void init(int M, int N, int G_, int c_) { nM = M / BM; nN = N / BM; nwg = nM * nN; G = G_; c = c_; }
    __host__ __device__ bool next(int i, Unit& u) const {
        const long L = (long)i * G + c; if (L >= nwg) return false;
        int wgid = (int)L; { const int q = nwg / NXCD, r = nwg % NXCD, xcd = wgid % NXCD, off = wgid / NXCD; wgid = (xcd < r ? xcd * (q + 1) : r * (q + 1) + (xcd - r) * q) + off; }
        const int nig = WGM * nN, gid = wgid / nig, fm = gid * WGM, gsz = (nM - fm) < WGM ? (nM - fm) : WGM;
        u.pm = fm + ((wgid % nig) % gsz); u.pn = (wgid % nig) / gsz; return true;
    }
    __device__ __forceinline__ void a_ready(const Unit&) const {}
    __device__ __forceinline__ void done(const Unit&) const {}
};
struct RotWaitOrder {
    static constexpr bool PAIRED = false;
    StaticOrder P; const unsigned* top; unsigned target;
    __host__ __device__ void init(int M, int N, int G_, int c_) { P.init(M, N, G_, c_); }
    __host__ __device__ bool next(int i, Unit& u) const { return P.next(i, u); }
    __device__ __forceinline__ int krot(const Unit& u) const { return 4 * u.pn; }
    __device__ __forceinline__ void k_ready(const Unit&, int t) const {
        if (t != 2) return;
        if (threadIdx.x < 64) { unsigned sp = 0;
            while ((unsigned)__builtin_amdgcn_readfirstlane(__hip_atomic_load(top, __ATOMIC_RELAXED, __HIP_MEMORY_SCOPE_AGENT)) < target && ++sp < (1u << 22)) __builtin_amdgcn_s_sleep(2);
            __builtin_amdgcn_fence(__ATOMIC_ACQUIRE, "agent");
            asm volatile("s_waitcnt vmcnt(0)" ::: "memory"); }
        asm volatile("" ::: "memory"); __builtin_amdgcn_s_barrier(); asm volatile("" ::: "memory");
    }
    __device__ __forceinline__ void a_ready(const Unit&) const {}
    __device__ __forceinline__ void done(const Unit&) const {}
};
struct PairOrder {
    __device__ __forceinline__ int krot(const Unit&) const { return 0; }
    __device__ __forceinline__ void k_ready(const Unit&, int) const {}
    StaticOrder P;
    __host__ __device__ void init(int M, int N, int G_, int c_) { P.init(M, N, G_, c_); }
    __host__ __device__ bool next(int i, Unit& u) const { if (!P.next(i >> 1, u)) return false; u.kind = i & 1; return true; }
    __device__ __forceinline__ void a_ready(const Unit&) const {}
    __device__ __forceinline__ void done(const Unit&) const {}
};
struct PairOrderW {
    __device__ __forceinline__ int krot(const Unit&) const { return 0; }
    __device__ __forceinline__ void k_ready(const Unit&, int) const {}
    StaticOrder P; const unsigned* top; unsigned target;
    __host__ __device__ void init(int M, int N, int G_, int c_) { P.init(M, N, G_, c_); }
    __host__ __device__ bool next(int i, Unit& u) const { if (!P.next(i >> 1, u)) return false; u.kind = i & 1; return true; }
    __device__ __forceinline__ void a_ready(const Unit& u) const {
        if (u.kind == 0) return;
        if (threadIdx.x < 64) { unsigned sp = 0;
            while ((unsigned)__builtin_amdgcn_readfirstlane(__hip_atomic_load(top, __ATOMIC_RELAXED, __HIP_MEMORY_SCOPE_AGENT)) < target && ++sp < (1u << 22)) __builtin_amdgcn_s_sleep(2);
            __builtin_amdgcn_fence(__ATOMIC_ACQUIRE, "agent");
            asm volatile("s_waitcnt vmcnt(0)" ::: "memory"); }
        asm volatile("" ::: "memory"); __builtin_amdgcn_s_barrier(); asm volatile("" ::: "memory");
    }
    __device__ __forceinline__ void done(const Unit&) const {}
};
__device__ __forceinline__ unsigned cvt_pk_bf16(float lo, float hi) { unsigned r; asm volatile("v_cvt_pk_bf16_f32 %0, %1, %2" : "=v"(r) : "v"(lo), "v"(hi)); return r; }
typedef float f32x2 __attribute__((ext_vector_type(2)));
template <class Epi, class Sched, bool ALIGN_EPI = false, bool SP2 = false, bool XROWS = false, int XROW0 = 0>
__device__ __forceinline__ void gemm_phase(PG8_LAS unsigned char* lds, const Gemm g, const Sched& S, const Epi& E) {
    static_assert(!XROWS || SP2, "extra rows: SP2 schedule");
    int tid_ = threadIdx.x; asm volatile("" : "+v"(tid_));
    const int tid = tid_, wid = __builtin_amdgcn_readfirstlane(tid >> 6), lane = tid & 63, wr = wid >> 2, wc = wid & 3, fr = lane & 15, fq = lane >> 4;
    const int K = g.K, nt = K / BK;
    unsigned voffA[2], voffB[2];
#pragma unroll
    for (int i = 0; i < 2; ++i) { int R, C; stage_rc(tid * 16 + i * 8192, R, C); const int Rb = Epi::PERM ? ((R & ~31) + perm32(R & 31)) : R;
        voffA[i] = (unsigned)(R * K + C) * 2u; voffB[i] = (unsigned)(Rb * K + C) * 2u; }
    unsigned voffX = 0;
    if constexpr (XROWS) { const int xr = 2 * wid + (lane >> 5), xs = (lane & 31) >> 2, xc = xs ^ (xr & 7); voffX = (unsigned)(xr * K) * 2u + (unsigned)(xc * 16 + (lane & 3) * 4); }
    const size_t kstep = (size_t)(BK * 2);
    const size_t hstep = (size_t)HALF * K * 2;
    const size_t tstep = 2 * hstep;
    const unsigned ldsw = (unsigned)wid * 1024u;
    const int aoff = lds_byte(wr * 64 + fr, fq * 8), boff = lds_byte(wc * 32 + fr, fq * 8);
#define PG8_SA(b, h) (((b) * 2 + (h)) * HTB)
#define PG8_SB(b, h) ((4 + (b) * 2 + (h)) * HTB)
#define PG8_STAGE(bufoff, gbase, voff) do { _Pragma("unroll") for (int _i = 0; _i < 2; ++_i) \
        __builtin_amdgcn_global_load_lds((const unsigned*)((const char*)(gbase) + (voff)[_i]), (PG8_LAS unsigned*)(lds + (bufoff) + ldsw + _i * 8192), 16, 0, 0); } while (0)
#define PG8_LDA(dst, b, h) do { _Pragma("unroll") for (int m = 0; m < 4; ++m) _Pragma("unroll") for (int k = 0; k < 2; ++k) dst[m][k] = *(const PG8_LAS bf16x8*)(lds + PG8_SA(b, h) + aoff + m * 2048 + k * 1024); } while (0)
#define PG8_LDB(dst, b, h) do { _Pragma("unroll") for (int n = 0; n < 2; ++n) _Pragma("unroll") for (int k = 0; k < 2; ++k) dst[n][k] = *(const PG8_LAS bf16x8*)(lds + PG8_SB(b, h) + boff + n * 2048 + k * 1024); } while (0)
#define PG8_MMA(ai, bj, At, Bt) do { __builtin_amdgcn_s_setprio(1); _Pragma("unroll") for (int m = 0; m < 4; ++m) _Pragma("unroll") for (int n = 0; n < 2; ++n) _Pragma("unroll") for (int k = 0; k < 2; ++k) \
        acc[ai][bj][m][n] = __builtin_amdgcn_mfma_f32_16x16x32_bf16(Bt[n][k], At[m][k], acc[ai][bj][m][n], 0, 0, 0); __builtin_amdgcn_s_setprio(0); } while (0)
#define PG8_XS(b) (STAGE_BYTES + (b) * 2048)
#define PG8_STAGEX(b, gbase) do { if constexpr (XROWS) __builtin_amdgcn_global_load_lds((const unsigned*)((const char*)(gbase) + voffX), (PG8_LAS unsigned*)(lds + PG8_XS(b) + wid * 256), 4, 0, 0); } while (0)
#define PG8_LDX(b) do { if constexpr (XROWS) { _Pragma("unroll") for (int k = 0; k < 2; ++k) Ax[k] = *(const PG8_LAS bf16x8*)(lds + PG8_XS(b) + fr * 128 + (((k * 4 + fq) ^ (fr & 7)) * 16)); } } while (0)
#define PG8_MMAX() do { if constexpr (XROWS) { if (wr == 0) { _Pragma("unroll") for (int n = 0; n < 2; ++n) _Pragma("unroll") for (int k = 0; k < 2; ++k) accx[n] = __builtin_amdgcn_mfma_f32_16x16x32_bf16(B0[n][k], Ax[k], accx[n], 0, 0, 0); } \
        else { _Pragma("unroll") for (int n = 0; n < 2; ++n) _Pragma("unroll") for (int k = 0; k < 2; ++k) accx[n] = __builtin_amdgcn_mfma_f32_16x16x32_bf16(B1[n][k], Ax[k], accx[n], 0, 0, 0); } } } while (0)
#define PG8_WAIT_V2() do { if constexpr (XROWS) asm volatile("s_waitcnt vmcnt(9)" ::: "memory"); else asm volatile("s_waitcnt vmcnt(8)" ::: "memory"); } while (0)
#define PG8_WAIT_V(n) asm volatile("s_waitcnt vmcnt(" #n ")" ::: "memory")
#define PG8_WAIT_L(n) asm volatile("s_waitcnt lgkmcnt(" #n ")" ::: "memory")
#define PG8_BAR __builtin_amdgcn_s_barrier()
#define PG8_SCHED __builtin_amdgcn_sched_barrier(0)
    Unit cur, nxt; int ui = 0;
    if (!S.next(0, cur)) return;
    f32x4 acc[2][2][4][2];
#pragma unroll
    for (int a = 0; a < 2; ++a)
#pragma unroll
        for (int b = 0; b < 2; ++b)
#pragma unroll
            for (int m = 0; m < 4; ++m)
#pragma unroll
                for (int n = 0; n < 2; ++n) acc[a][b][m][n] = (f32x4){0.f, 0.f, 0.f, 0.f};
    bf16x8 At[4][2], B0[2][2], B1[2][2], Ax[2];
    f32x4 accx[2] = {(f32x4){0.f, 0.f, 0.f, 0.f}, (f32x4){0.f, 0.f, 0.f, 0.f}};
    const char* cA = (const char*)(cur.kind ? g.A2 : g.A) + (size_t)cur.pm * tstep; const char* cB = (const char*)(cur.kind ? g.Bt2 : g.Bt) + (size_t)cur.pn * tstep;
    const char* cX = (const char*)(cur.kind ? g.A2 : g.A) + ((size_t)XROW0 + 16 * (size_t)cur.pm) * (size_t)K * 2;
    int kr = S.krot(cur);
    const char* pA = cA + (size_t)kr * kstep; const char* pB = cB + (size_t)kr * kstep; const char* pX = cX + (size_t)kr * kstep;
    S.a_ready(cur);
    if constexpr (SP2) {
        PG8_STAGEX(0, pX); PG8_STAGE(PG8_SB(0, 0), pB, voffB); PG8_STAGE(PG8_SB(0, 1), pB + hstep, voffB); PG8_STAGE(PG8_SA(0, 0), pA, voffA); PG8_STAGE(PG8_SA(0, 1), pA + hstep, voffA);
        if (wr == 1) PG8_BAR;
        PG8_WAIT_V(2); PG8_BAR;
        PG8_STAGEX(1, pX + kstep); PG8_STAGE(PG8_SB(1, 0), pB + kstep, voffB); PG8_STAGE(PG8_SA(1, 0), pA + kstep, voffA); PG8_STAGE(PG8_SB(1, 1), pB + hstep + kstep, voffB);
        PG8_WAIT_V(6); PG8_BAR;
    } else {
        PG8_STAGE(PG8_SB(0, 0), cB, voffB); PG8_STAGE(PG8_SA(0, 0), cA, voffA); PG8_STAGE(PG8_SB(0, 1), cB + hstep, voffB); PG8_STAGE(PG8_SA(0, 1), cA + hstep, voffA);
        if (wr == 1) PG8_BAR;
        PG8_WAIT_V(4); PG8_BAR;
        PG8_STAGE(PG8_SB(1, 0), cB + kstep, voffB); PG8_STAGE(PG8_SA(1, 0), cA + kstep, voffA); PG8_STAGE(PG8_SB(1, 1), cB + hstep + kstep, voffB);
        PG8_WAIT_V(6); PG8_BAR;
    }
    for (;;) {
        const bool has_next = S.next(ui + 1, nxt);
        const char* nA = has_next ? (const char*)(nxt.kind ? g.A2 : g.A) + (size_t)nxt.pm * tstep : cA; const char* nB = has_next ? (const char*)(nxt.kind ? g.Bt2 : g.Bt) + (size_t)nxt.pn * tstep : cB;
        const char* nX = cX;
        if constexpr (XROWS && !Epi::AFTER_DRAIN) { if (has_next) nX = (const char*)(nxt.kind ? g.A2 : g.A) + ((size_t)XROW0 + 16 * (size_t)nxt.pm) * (size_t)K * 2; }
        for (int t = 0; t < nt; t += 2) {
            const bool last = (t == nt - 2);
            const int k1 = kr ? (((t + kr) & (nt - 1)) + 1) : (t + 1), k2 = kr ? ((t + 2 + kr) & (nt - 1)) : (t + 2);
            S.k_ready(cur, t);
            const char* a1 = cA + (size_t)k1 * kstep;
            const char* a2 = last ? nA : cA + (size_t)k2 * kstep; const char* b2 = last ? nB : cB + (size_t)k2 * kstep;
            const char* a3 = a2 + kstep; const char* b3 = b2 + kstep;
            const char* x2 = last ? nX : cX + (size_t)k2 * kstep; const char* x3 = x2 + kstep;
            if (last && has_next) S.a_ready(nxt);
            if (last) E.prefetch(cur, wr, wc, fr, fq);
            if constexpr (SP2) {
            PG8_LDB(B0, 0, 0); PG8_LDB(B1, 0, 1); PG8_SCHED; PG8_LDA(At, 0, 0); PG8_LDX(0); PG8_STAGE(PG8_SA(1, 1), a1 + hstep, voffA);
            PG8_WAIT_V(8); PG8_WAIT_L(0); PG8_BAR; PG8_MMA(0, 0, At, B0); PG8_MMA(0, 1, At, B1); PG8_MMAX(); PG8_BAR; PG8_SCHED;
            PG8_LDA(At, 0, 1); PG8_STAGEX(0, x2); PG8_STAGE(PG8_SB(0, 0), b2, voffB); PG8_STAGE(PG8_SB(0, 1), b2 + hstep, voffB); PG8_STAGE(PG8_SA(0, 0), a2, voffA);
            PG8_WAIT_V2(); PG8_WAIT_L(0); PG8_BAR; PG8_MMA(1, 0, At, B0); PG8_MMA(1, 1, At, B1); PG8_BAR; PG8_SCHED;
            PG8_LDB(B0, 1, 0); PG8_LDB(B1, 1, 1); PG8_SCHED; PG8_LDA(At, 1, 0); PG8_LDX(1); PG8_STAGE(PG8_SA(0, 1), a2 + hstep, voffA);
            PG8_WAIT_V(8); PG8_WAIT_L(0); PG8_BAR; PG8_MMA(0, 0, At, B0); PG8_MMA(0, 1, At, B1); PG8_MMAX(); PG8_BAR; PG8_SCHED;
            PG8_LDA(At, 1, 1); PG8_STAGEX(1, x3); PG8_STAGE(PG8_SB(1, 0), b3, voffB); PG8_STAGE(PG8_SB(1, 1), b3 + hstep, voffB); PG8_STAGE(PG8_SA(1, 0), a3, voffA);
            PG8_WAIT_V2(); PG8_WAIT_L(0); PG8_BAR; PG8_MMA(1, 0, At, B0); PG8_MMA(1, 1, At, B1); PG8_BAR; PG8_SCHED;
            } else {
            PG8_LDB(B0, 0, 0); PG8_SCHED; PG8_LDA(At, 0, 0); PG8_STAGE(PG8_SA(1, 1), a1 + hstep, voffA);
            PG8_WAIT_L(8); PG8_BAR; PG8_WAIT_L(0); PG8_MMA(0, 0, At, B0); PG8_BAR; PG8_SCHED;
            PG8_LDB(B1, 0, 1); PG8_STAGE(PG8_SB(0, 0), b2, voffB);
            PG8_BAR; PG8_WAIT_L(0); PG8_MMA(0, 1, At, B1); PG8_BAR;
            PG8_LDA(At, 0, 1); PG8_STAGE(PG8_SA(0, 0), a2, voffA);
            PG8_BAR; PG8_WAIT_L(0); PG8_MMA(1, 0, At, B0); PG8_BAR; PG8_SCHED;
            PG8_STAGE(PG8_SB(0, 1), b2 + hstep, voffB);
            PG8_WAIT_V(6); PG8_BAR; PG8_MMA(1, 1, At, B1); PG8_BAR;
            PG8_LDB(B0, 1, 0); PG8_SCHED; PG8_LDA(At, 1, 0); PG8_STAGE(PG8_SA(0, 1), a2 + hstep, voffA);
            PG8_WAIT_L(8); PG8_BAR; PG8_WAIT_L(0); PG8_MMA(0, 0, At, B0); PG8_BAR; PG8_SCHED;
            PG8_LDB(B1, 1, 1); PG8_STAGE(PG8_SB(1, 0), b3, voffB);
            PG8_BAR; PG8_WAIT_L(0); PG8_MMA(0, 1, At, B1); PG8_BAR;
            PG8_LDA(At, 1, 1); PG8_STAGE(PG8_SA(1, 0), a3, voffA);
            PG8_BAR; PG8_WAIT_L(0); PG8_MMA(1, 0, At, B0); PG8_BAR; PG8_SCHED;
            PG8_STAGE(PG8_SB(1, 1), b3 + hstep, voffB);
            PG8_WAIT_V(6); PG8_BAR; PG8_MMA(1, 1, At, B1); PG8_BAR;
            }
        }
        if constexpr (ALIGN_EPI) { if (wr == 0) PG8_BAR; }
        if constexpr (!Epi::AFTER_DRAIN) { int fr_ = fr, fq_ = fq; asm volatile("" : "+v"(fr_), "+v"(fq_));
            if constexpr (Epi::CHAIN) E.template chain<XROWS>(acc, accx, cur, wr, wc, fr_, fq_); else { E(acc, cur, wr, wc, fr_, fq_); if constexpr (XROWS) E.xrows(accx, cur, wr, wc, fr_, fq_); }
            S.done(cur); }
        if (!has_next) break;
        if (!(Epi::CHAIN && cur.kind == 0)) {
#pragma unroll
        for (int a = 0; a < 2; ++a)
#pragma unroll
            for (int b = 0; b < 2; ++b)
#pragma unroll
                for (int m = 0; m < 4; ++m)
#pragma unroll
                    for (int n = 0; n < 2; ++n) acc[a][b][m][n] = (f32x4){0.f, 0.f, 0.f, 0.f};
        accx[0] = (f32x4){0.f, 0.f, 0.f, 0.f}; accx[1] = (f32x4){0.f, 0.f, 0.f, 0.f};
        }
        cur = nxt; cA = nA; cB = nB; cX = nX; ++ui; kr = S.krot(cur);
        if constexpr (ALIGN_EPI) { if (wr == 1) PG8_BAR; }
    }
    PG8_WAIT_V(0);
    if constexpr (!ALIGN_EPI) { if (wr == 0) PG8_BAR; }
    PG8_BAR;
    if constexpr (Epi::AFTER_DRAIN) { E.template fused<XROWS>(acc, accx, cur, wr, wc, fr, fq, lds, wid, lane); S.done(cur); }
#undef PG8_SA
#undef PG8_SB
#undef PG8_STAGE
#undef PG8_LDA
#undef PG8_LDB
#undef PG8_MMA
#undef PG8_WAIT_V
#undef PG8_WAIT_V2
#undef PG8_XS
#undef PG8_STAGEX
#undef PG8_LDX
#undef PG8_MMAX
#undef PG8_WAIT_L
#undef PG8_BAR
#undef PG8_SCHED
}
}
constexpr int DM = 1024, NB_P = 8, SEQ_P = 2048, NB_S = 128, SEQ_S = 8, DEPTH = 2;
constexpr int MP = NB_P * SEQ_P;
constexpr int MS = NB_S * SEQ_S;
constexpr int M = MP + MS;
constexpr int NSEQ = NB_P + NB_S;
constexpr int DFF = 2816, NMOD = 9 * DM, DPROJ = 8208, DXBC = 2048;
constexpr float EPS = 1e-6f;

__device__ __forceinline__ int mod_row(int m) { return m < MP ? (m >> 11) : NB_P + ((m - MP) >> 3); }
__device__ __forceinline__ float bf_lo(unsigned w) { return __uint_as_float(w << 16); }
__device__ __forceinline__ float bf_hi(unsigned w) { return __uint_as_float(w & 0xffff0000u); }
__device__ __forceinline__ float fast_sigmoid(float x) { return __builtin_amdgcn_rcpf(1.f + __expf(-x)); }
__device__ __forceinline__ float fast_silu(float x) { return x * fast_sigmoid(x); }

__device__ __forceinline__ __amdgpu_buffer_rsrc_t wt_rsrc(void* base) { return __builtin_amdgcn_make_buffer_rsrc(base, 0, 0x7ffffff0, 0x00020000); }
#ifdef USE_WT
#define WT_STORE16(rs, base, byteoff, val) __builtin_amdgcn_raw_buffer_store_b128((val), (rs), (int)(byteoff), 0, 16)
#else
#define WT_STORE16(rs, base, byteoff, val) (*(pg8::u32x4*)((char*)(base) + (byteoff)) = (val))
#endif
namespace pg8 {
struct EpiMod {
    static constexpr bool CHAIN = false, PERM = false, AFTER_DRAIN = false;
    __device__ __forceinline__ void prefetch(const Unit&, int, int, int, int) const {}
    float* C; const float* bias; float* GS; const float* GN;
    __device__ __forceinline__ void operator()(const f32x4 (&acc)[2][2][4][2], const Unit& u, int wr, int wc, int fr, int fq) const {
        const int row0 = u.pm * BM + wr * 64 + fr, col0 = u.pn * BM + wc * 32 + 4 * fq;
        const int ch = u.pn >> 2, jn = ch / 3, kind = ch - 3 * jn, cc0 = (u.pn & 3) * BM + wc * 32 + 4 * fq;
        const float* gn = GN + jn * DM;
        f32x4 bv[2][2], gv[2][2];
#pragma unroll
        for (int bj = 0; bj < 2; ++bj)
#pragma unroll
            for (int n = 0; n < 2; ++n) { bv[bj][n] = *(const f32x4*)(bias + col0 + bj * HALF + n * 16); gv[bj][n] = *(const f32x4*)(gn + cc0 + bj * HALF + n * 16); }
#pragma unroll
        for (int ai = 0; ai < 2; ++ai)
#pragma unroll
            for (int m = 0; m < 4; ++m) { const int r = row0 + ai * HALF + m * 16;
                if (r < NSEQ) { float* rowp = C + (size_t)r * NMOD + col0;
#pragma unroll
                    for (int bj = 0; bj < 2; ++bj)
#pragma unroll
                        for (int n = 0; n < 2; ++n) { const f32x4 v = acc[ai][bj][m][n] + bv[bj][n]; const int cc = cc0 + bj * HALF + n * 16;
                            if (kind == 1) *(f32x4*)(GS + ((size_t)jn * NSEQ + r) * DM + cc) = gv[bj][n] * (v + 1.f);
                            else *(f32x4*)(rowp + bj * HALF + n * 16) = v; } } }
    }
};
struct EpiSwiglu {
    static constexpr bool CHAIN = false, PERM = true, AFTER_DRAIN = false;
    __device__ __forceinline__ void prefetch(const Unit&, int, int, int, int) const {}
    bf16_t* O;
    __device__ __forceinline__ void operator()(const f32x4 (&acc)[2][2][4][2], const Unit& u, int wr, int wc, int fr, int fq) const {
        const int row0 = u.pm * BM + wr * 64 + fr, col0 = u.pn * HALF + wc * 32 + 8 * fq;
#pragma unroll
        for (int ai = 0; ai < 2; ++ai)
#pragma unroll
            for (int m = 0; m < 4; ++m) { bf16_t* rowp = O + (size_t)(row0 + ai * HALF + m * 16) * DFF + col0;
                const f32x4 g0 = acc[ai][0][m][0], g1 = acc[ai][0][m][1], u0 = acc[ai][1][m][0], u1 = acc[ai][1][m][1];
                u32x4 w;
                w.x = cvt_pk_bf16(fast_silu(g0[0]) * u0[0], fast_silu(g0[1]) * u0[1]); w.y = cvt_pk_bf16(fast_silu(g0[2]) * u0[2], fast_silu(g0[3]) * u0[3]);
                w.z = cvt_pk_bf16(fast_silu(g1[0]) * u1[0], fast_silu(g1[1]) * u1[1]); w.w = cvt_pk_bf16(fast_silu(g1[2]) * u1[2], fast_silu(g1[3]) * u1[3]);
                *(u32x4*)rowp = w; }
    }
};
struct EpiProj {
    static constexpr bool CHAIN = false, PERM = true, AFTER_DRAIN = false;
    __device__ __forceinline__ void prefetch(const Unit&, int, int, int, int) const {}
    bf16_t* P; int pn0 = 0;
    __device__ __forceinline__ void operator()(const f32x4 (&acc)[2][2][4][2], const Unit& u, int wr, int wc, int fr, int fq) const {
        const int pn = u.pn + pn0, t = pn >> 2; bf16_t* base = P + (size_t)t * M * DM;
        const int row0 = u.pm * BM + wr * 64 + fr, col0 = (pn & 3) * BM + wc * 32 + 8 * fq;
        const bool sg = t >= 6;
        if (t == 4 || t == 5) {
            bf16_t* pb = P + (size_t)4 * M * DM + (pn - 16) * HALF + wc * 32 + 8 * fq;
#pragma unroll
            for (int ai = 0; ai < 2; ++ai)
#pragma unroll
                for (int m = 0; m < 4; ++m) { const f32x4 c0 = acc[ai][0][m][0] * acc[ai][1][m][0], c1 = acc[ai][0][m][1] * acc[ai][1][m][1];
                    u32x4 w; w.x = cvt_pk_bf16(c0[0], c0[1]); w.y = cvt_pk_bf16(c0[2], c0[3]); w.z = cvt_pk_bf16(c1[0], c1[1]); w.w = cvt_pk_bf16(c1[2], c1[3]);
                    *(u32x4*)(pb + (size_t)(row0 + ai * HALF + m * 16) * DM) = w; }
            return; }
#pragma unroll
        for (int ai = 0; ai < 2; ++ai)
#pragma unroll
            for (int m = 0; m < 4; ++m) { bf16_t* rowp = base + (size_t)(row0 + ai * HALF + m * 16) * DM + col0;
#pragma unroll
                for (int bj = 0; bj < 2; ++bj) { f32x4 v0 = acc[ai][bj][m][0], v1 = acc[ai][bj][m][1];
                    if (sg) {
#pragma unroll
                        for (int i = 0; i < 4; ++i) { v0[i] = fast_sigmoid(v0[i]); v1[i] = fast_sigmoid(v1[i]); } }
                    u32x4 w; w.x = cvt_pk_bf16(v0[0], v0[1]); w.y = cvt_pk_bf16(v0[2], v0[3]); w.z = cvt_pk_bf16(v1[0], v1[1]); w.w = cvt_pk_bf16(v1[2], v1[3]);
                    *(u32x4*)(rowp + bj * HALF) = w; } }
    }
};
template <bool HALFSC, bool XF32> struct EpiResidLN {
    static constexpr bool CHAIN = false, PERM = true, AFTER_DRAIN = true;
    __device__ __forceinline__ void prefetch(const Unit&, int, int, int, int) const {}
    const void* Xin; bf16_t* X; const float* gate;
    const float* XinS = nullptr;
    bf16_t* H; const float* GS; const float* SH; float* SSQ; unsigned* cnt;
    template <bool XR> __device__ __forceinline__ void fused(f32x4 (&acc)[2][2][4][2], f32x4 (&accx)[2], const Unit& u, int wr, int wc, int fr, int fq, PG8_LAS unsigned char*, int, int) const {
        constexpr float sc = HALFSC ? 0.5f : 1.0f;
        const int col0 = u.pn * BM + wc * 32 + 8 * fq, mr = mod_row(u.pm * BM), rbase = u.pm * BM + wr * 64 + fr;
        f32x4 g4[2][2];
#pragma unroll
        for (int bj = 0; bj < 2; ++bj)
#pragma unroll
            for (int n = 0; n < 2; ++n) g4[bj][n] = *(const f32x4*)(gate + (size_t)mr * NMOD + col0 + bj * HALF + n * 4) * sc;
        float ssr[8];
        f32x4 xc[2][2], xnx[2][2]; u32x4 xr[2], xrn[2];
        if constexpr (XF32) {
#pragma unroll
            for (int bj = 0; bj < 2; ++bj)
#pragma unroll
                for (int n = 0; n < 2; ++n) xc[bj][n] = *(const f32x4*)((const float*)Xin + (size_t)rbase * DM + col0 + bj * HALF + n * 4);
        } else {
#pragma unroll
            for (int bj = 0; bj < 2; ++bj) xr[bj] = *(const u32x4*)((const bf16_t*)Xin + (size_t)rbase * DM + col0 + bj * HALF);
        }
        const int ms = MP + 16 * u.pm + fr, mrs = mod_row(ms), cx = u.pn * BM + wr * HALF + wc * 32 + 8 * fq;
        if constexpr (XR) {
            const f32x4 xg0 = *(const f32x4*)(gate + (size_t)mrs * NMOD + cx) * sc, xg1 = *(const f32x4*)(gate + (size_t)mrs * NMOD + cx + 4) * sc;
            f32x4 x0, x1;
            if constexpr (XF32) { const float* xp = XinS + (size_t)(ms - MP) * DM + cx; x0 = *(const f32x4*)xp; x1 = *(const f32x4*)(xp + 4); }
            else { const u32x4 xw = *(const u32x4*)((const bf16_t*)Xin + (size_t)ms * DM + cx); x0 = (f32x4){bf_lo(xw.x), bf_hi(xw.x), bf_lo(xw.y), bf_hi(xw.y)}; x1 = (f32x4){bf_lo(xw.z), bf_hi(xw.z), bf_lo(xw.w), bf_hi(xw.w)}; }
            const f32x4 a = x0 + xg0 * accx[0], b = x1 + xg1 * accx[1]; accx[0] = a; accx[1] = b;
            u32x4 w; w.x = cvt_pk_bf16(a[0], a[1]); w.y = cvt_pk_bf16(a[2], a[3]); w.z = cvt_pk_bf16(b[0], b[1]); w.w = cvt_pk_bf16(b[2], b[3]);
            *(u32x4*)(X + (size_t)ms * DM + cx) = w;
            float ss = ((a[0] * a[0] + a[1] * a[1]) + (a[2] * a[2] + a[3] * a[3])) + ((b[0] * b[0] + b[1] * b[1]) + (b[2] * b[2] + b[3] * b[3]));
            ss += __shfl_xor(ss, 16); ss += __shfl_xor(ss, 32);
            if (fq == 0) atomicAdd(SSQ + ms, ss);
        }
#pragma unroll
        for (int q = 0; q < 8; ++q) { const int ai = q >> 2, m = q & 3; const int r = rbase + ai * HALF + m * 16;
            if (q < 7) { const int rn = rbase + ((q + 1) >> 2) * HALF + ((q + 1) & 3) * 16;
                if constexpr (XF32) {
#pragma unroll
                    for (int bj = 0; bj < 2; ++bj)
#pragma unroll
                        for (int n = 0; n < 2; ++n) xnx[bj][n] = *(const f32x4*)((const float*)Xin + (size_t)rn * DM + col0 + bj * HALF + n * 4);
                } else {
#pragma unroll
                    for (int bj = 0; bj < 2; ++bj) xrn[bj] = *(const u32x4*)((const bf16_t*)Xin + (size_t)rn * DM + col0 + bj * HALF);
                } }
            if constexpr (!XF32) {
#pragma unroll
                for (int bj = 0; bj < 2; ++bj) { xc[bj][0] = (f32x4){bf_lo(xr[bj].x), bf_hi(xr[bj].x), bf_lo(xr[bj].y), bf_hi(xr[bj].y)}; xc[bj][1] = (f32x4){bf_lo(xr[bj].z), bf_hi(xr[bj].z), bf_lo(xr[bj].w), bf_hi(xr[bj].w)}; } }
            float ss = 0.f;
#pragma unroll
            for (int bj = 0; bj < 2; ++bj) {
#pragma unroll
                for (int n = 0; n < 2; ++n) { const f32x4 xn = xc[bj][n] + g4[bj][n] * acc[ai][bj][m][n]; acc[ai][bj][m][n] = xn;
                    ss += (xn[0] * xn[0] + xn[1] * xn[1]) + (xn[2] * xn[2] + xn[3] * xn[3]); }
                const f32x4 a = acc[ai][bj][m][0], b = acc[ai][bj][m][1];
                u32x4 w; w.x = cvt_pk_bf16(a[0], a[1]); w.y = cvt_pk_bf16(a[2], a[3]); w.z = cvt_pk_bf16(b[0], b[1]); w.w = cvt_pk_bf16(b[2], b[3]);
                *(u32x4*)(X + (size_t)r * DM + col0 + bj * HALF) = w; }
            ss += __shfl_xor(ss, 16); ss += __shfl_xor(ss, 32); ssr[q] = ss;
            if constexpr (XF32) {
#pragma unroll
                for (int bj = 0; bj < 2; ++bj)
#pragma unroll
                    for (int n = 0; n < 2; ++n) xc[bj][n] = xnx[bj][n];
            } else { xr[0] = xrn[0]; xr[1] = xrn[1]; } }
        if (fq == 0) {
#pragma unroll
            for (int q = 0; q < 8; ++q) atomicAdd(SSQ + rbase + (q >> 2) * HALF + (q & 3) * 16, ssr[q]); }
        f32x4 gs[2][2], sh[2][2];
#pragma unroll
        for (int bj = 0; bj < 2; ++bj)
#pragma unroll
            for (int n = 0; n < 2; ++n) { gs[bj][n] = *(const f32x4*)(GS + (size_t)mr * DM + col0 + bj * HALF + n * 4); sh[bj][n] = *(const f32x4*)(SH + (size_t)mr * NMOD + col0 + bj * HALF + n * 4); }
        asm volatile("s_waitcnt vmcnt(0)" ::: "memory");
        __syncthreads();
        if (threadIdx.x == 0) { unsigned* c = cnt + 64 * u.pm;
            __hip_atomic_fetch_add(c, 1u, __ATOMIC_RELAXED, __HIP_MEMORY_SCOPE_AGENT);
            unsigned sp = 0; while (__hip_atomic_load(c, __ATOMIC_RELAXED, __HIP_MEMORY_SCOPE_AGENT) < 4u && ++sp < (1u << 22)) __builtin_amdgcn_s_sleep(1); }
        __syncthreads();
        float totq[8];
#pragma unroll
        for (int q = 0; q < 8; ++q) totq[q] = __hip_atomic_load(SSQ + rbase + (q >> 2) * HALF + (q & 3) * 16, __ATOMIC_RELAXED, __HIP_MEMORY_SCOPE_AGENT);
        if constexpr (XR) {
            const float tot = __hip_atomic_load(SSQ + ms, __ATOMIC_RELAXED, __HIP_MEMORY_SCOPE_AGENT);
            const float rinv = 1.f / sqrtf(tot * (1.f / DM) + EPS);
            const f32x4 a = (accx[0] * rinv) * *(const f32x4*)(GS + (size_t)mrs * DM + cx) + *(const f32x4*)(SH + (size_t)mrs * NMOD + cx), b = (accx[1] * rinv) * *(const f32x4*)(GS + (size_t)mrs * DM + cx + 4) + *(const f32x4*)(SH + (size_t)mrs * NMOD + cx + 4);
            u32x4 w; w.x = cvt_pk_bf16(a[0], a[1]); w.y = cvt_pk_bf16(a[2], a[3]); w.z = cvt_pk_bf16(b[0], b[1]); w.w = cvt_pk_bf16(b[2], b[3]);
            *(u32x4*)(H + (size_t)ms * DM + cx) = w; }
#pragma unroll
        for (int q = 0; q < 8; ++q) { const int ai = q >> 2, m = q & 3; const int r = rbase + ai * HALF + m * 16;
            const float rinv = 1.f / sqrtf(totq[q] * (1.f / DM) + EPS);
#pragma unroll
            for (int bj = 0; bj < 2; ++bj) { const f32x4 a = (acc[ai][bj][m][0] * rinv) * gs[bj][0] + sh[bj][0], b = (acc[ai][bj][m][1] * rinv) * gs[bj][1] + sh[bj][1];
                u32x4 w; w.x = cvt_pk_bf16(a[0], a[1]); w.y = cvt_pk_bf16(a[2], a[3]); w.z = cvt_pk_bf16(b[0], b[1]); w.w = cvt_pk_bf16(b[2], b[3]);
                *(u32x4*)(H + (size_t)r * DM + col0 + bj * HALF) = w; } }
    }
};
template <bool FIRST> struct EpiGate {
    static constexpr bool CHAIN = false, PERM = true, AFTER_DRAIN = false;
    __device__ __forceinline__ void prefetch(const Unit&, int, int, int, int) const {}
    bf16_t* T; const bf16_t* G;
    __device__ __forceinline__ void operator()(const f32x4 (&acc)[2][2][4][2], const Unit& u, int wr, int wc, int fr, int fq) const {
        const int row0 = u.pm * BM + wr * 64 + fr, col0 = u.pn * BM + wc * 32 + 8 * fq;
        u32x4 gc[2], tc[2], gn[2], tn[2];
#pragma unroll
        for (int bj = 0; bj < 2; ++bj) { const size_t ro = (size_t)row0 * DM + col0 + bj * HALF; gc[bj] = *(const u32x4*)(G + ro); if (!FIRST) tc[bj] = *(const u32x4*)(T + ro); }
#pragma unroll
        for (int q = 0; q < 8; ++q) { const int ai = q >> 2, m = q & 3; const size_t ro = (size_t)(row0 + ai * HALF + m * 16) * DM + col0;
            if (q < 7) { const size_t rn = (size_t)(row0 + ((q + 1) >> 2) * HALF + ((q + 1) & 3) * 16) * DM + col0;
#pragma unroll
                for (int bj = 0; bj < 2; ++bj) { gn[bj] = *(const u32x4*)(G + rn + bj * HALF); if (!FIRST) tn[bj] = *(const u32x4*)(T + rn + bj * HALF); } }
#pragma unroll
            for (int bj = 0; bj < 2; ++bj) { const u32x4 gw = gc[bj];
                const f32x4 a0 = acc[ai][bj][m][0], a1 = acc[ai][bj][m][1];
                float o[8];
                o[0] = bf_lo(gw.x) * a0[0]; o[1] = bf_hi(gw.x) * a0[1]; o[2] = bf_lo(gw.y) * a0[2]; o[3] = bf_hi(gw.y) * a0[3];
                o[4] = bf_lo(gw.z) * a1[0]; o[5] = bf_hi(gw.z) * a1[1]; o[6] = bf_lo(gw.w) * a1[2]; o[7] = bf_hi(gw.w) * a1[3];
                if (!FIRST) { const u32x4 tw = tc[bj];
                    o[0] += bf_lo(tw.x); o[1] += bf_hi(tw.x); o[2] += bf_lo(tw.y); o[3] += bf_hi(tw.y); o[4] += bf_lo(tw.z); o[5] += bf_hi(tw.z); o[6] += bf_lo(tw.w); o[7] += bf_hi(tw.w); }
                u32x4 w; w.x = cvt_pk_bf16(o[0], o[1]); w.y = cvt_pk_bf16(o[2], o[3]); w.z = cvt_pk_bf16(o[4], o[5]); w.w = cvt_pk_bf16(o[6], o[7]);
                *(u32x4*)(T + ro + bj * HALF) = w; }
#pragma unroll
            for (int bj = 0; bj < 2; ++bj) { gc[bj] = gn[bj]; if (!FIRST) tc[bj] = tn[bj]; } }
    }
};
struct EpiGate2 {
    static constexpr bool CHAIN = true, PERM = true, AFTER_DRAIN = false;
    __device__ __forceinline__ void prefetch(const Unit&, int, int, int, int) const {}
    bf16_t* T; const bf16_t* G1; const bf16_t* G2;
    template <bool XR> __device__ __forceinline__ void chain(f32x4 (&acc)[2][2][4][2], f32x4 (&accx)[2], const Unit& u, int wr, int wc, int fr, int fq) const {
        if (u.kind != 0) { EpiGate<true> e{T, G2}; e(acc, u, wr, wc, fr, fq); }
        else {
        const int row0 = u.pm * BM + wr * 64 + fr, col0 = u.pn * BM + wc * 32 + 8 * fq;
#pragma unroll
        for (int q = 0; q < 8; ++q) { const int ai = q >> 2, m = q & 3; const size_t ro = (size_t)(row0 + ai * HALF + m * 16) * DM + col0;
#pragma unroll
            for (int bj = 0; bj < 2; ++bj) { const u32x4 a = *(const u32x4*)(G1 + ro + bj * HALF), b = *(const u32x4*)(G2 + ro + bj * HALF);
                f32x4 r0, r1;
                r0[0] = bf_lo(a.x) * __builtin_amdgcn_rcpf(fmaxf(bf_lo(b.x), 1e-30f)); r0[1] = bf_hi(a.x) * __builtin_amdgcn_rcpf(fmaxf(bf_hi(b.x), 1e-30f));
                r0[2] = bf_lo(a.y) * __builtin_amdgcn_rcpf(fmaxf(bf_lo(b.y), 1e-30f)); r0[3] = bf_hi(a.y) * __builtin_amdgcn_rcpf(fmaxf(bf_hi(b.y), 1e-30f));
                r1[0] = bf_lo(a.z) * __builtin_amdgcn_rcpf(fmaxf(bf_lo(b.z), 1e-30f)); r1[1] = bf_hi(a.z) * __builtin_amdgcn_rcpf(fmaxf(bf_hi(b.z), 1e-30f));
                r1[2] = bf_lo(a.w) * __builtin_amdgcn_rcpf(fmaxf(bf_lo(b.w), 1e-30f)); r1[3] = bf_hi(a.w) * __builtin_amdgcn_rcpf(fmaxf(bf_hi(b.w), 1e-30f));
                acc[ai][bj][m][0] = acc[ai][bj][m][0] * r0; acc[ai][bj][m][1] = acc[ai][bj][m][1] * r1; } }
        }
        __builtin_amdgcn_sched_barrier(0);
        if constexpr (XR) {
            const size_t xo = (size_t)(MP + 16 * u.pm + fr) * DM + u.pn * BM + wr * HALF + wc * 32 + 8 * fq;
            const u32x4 b = *(const u32x4*)(G2 + xo);
            const f32x4 g0 = {bf_lo(b.x), bf_hi(b.x), bf_lo(b.y), bf_hi(b.y)}, g1 = {bf_lo(b.z), bf_hi(b.z), bf_lo(b.w), bf_hi(b.w)};
            if (u.kind == 0) { const u32x4 a = *(const u32x4*)(G1 + xo);
                const f32x4 a0 = {bf_lo(a.x), bf_hi(a.x), bf_lo(a.y), bf_hi(a.y)}, a1 = {bf_lo(a.z), bf_hi(a.z), bf_lo(a.w), bf_hi(a.w)};
#pragma unroll
                for (int i = 0; i < 4; ++i) { accx[0][i] *= a0[i] * __builtin_amdgcn_rcpf(fmaxf(g0[i], 1e-30f)); accx[1][i] *= a1[i] * __builtin_amdgcn_rcpf(fmaxf(g1[i], 1e-30f)); } }
            else { const f32x4 o0 = accx[0] * g0, o1 = accx[1] * g1;
                u32x4 w; w.x = cvt_pk_bf16(o0[0], o0[1]); w.y = cvt_pk_bf16(o0[2], o0[3]); w.z = cvt_pk_bf16(o1[0], o1[1]); w.w = cvt_pk_bf16(o1[2], o1[3]);
                *(u32x4*)(T + xo) = w; } }
    }
};
struct EpiFinal {
    static constexpr bool CHAIN = false, PERM = true, AFTER_DRAIN = true;
    __device__ __forceinline__ void prefetch(const Unit&, int, int, int, int) const {}
    const bf16_t* Xin; float* Y; const float* gate; const float* gfin; float* SSF; unsigned* cnt;
    template <bool XR> __device__ __forceinline__ void fused(f32x4 (&acc)[2][2][4][2], f32x4 (&accx)[2], const Unit& u, int wr, int wc, int fr, int fq, PG8_LAS unsigned char*, int, int) const {
        const int col0 = u.pn * BM + wc * 32 + 8 * fq, mr = mod_row(u.pm * BM), rbase = u.pm * BM + wr * 64 + fr;
        f32x4 g4[2][2];
#pragma unroll
        for (int bj = 0; bj < 2; ++bj)
#pragma unroll
            for (int n = 0; n < 2; ++n) g4[bj][n] = *(const f32x4*)(gate + (size_t)mr * NMOD + col0 + bj * HALF + n * 4) * 0.5f;
        float ssr[8];
#pragma unroll
        for (int q = 0; q < 8; ++q) { const int ai = q >> 2, m = q & 3; const int r = rbase + ai * HALF + m * 16; float ss = 0.f;
#pragma unroll
            for (int bj = 0; bj < 2; ++bj) { const u32x4 xw = *(const u32x4*)(Xin + (size_t)r * DM + col0 + bj * HALF);
                const f32x4 x0 = (f32x4){bf_lo(xw.x), bf_hi(xw.x), bf_lo(xw.y), bf_hi(xw.y)}, x1 = (f32x4){bf_lo(xw.z), bf_hi(xw.z), bf_lo(xw.w), bf_hi(xw.w)};
                const f32x4 n0 = x0 + g4[bj][0] * acc[ai][bj][m][0], n1 = x1 + g4[bj][1] * acc[ai][bj][m][1]; acc[ai][bj][m][0] = n0; acc[ai][bj][m][1] = n1;
                ss += ((n0[0] * n0[0] + n0[1] * n0[1]) + (n0[2] * n0[2] + n0[3] * n0[3])) + ((n1[0] * n1[0] + n1[1] * n1[1]) + (n1[2] * n1[2] + n1[3] * n1[3])); }
            ss += __shfl_xor(ss, 16); ss += __shfl_xor(ss, 32); ssr[q] = ss; }
        if (fq == 0) {
#pragma unroll
            for (int q = 0; q < 8; ++q) atomicAdd(SSF + rbase + (q >> 2) * HALF + (q & 3) * 16, ssr[q]); }
        const int ms = MP + 16 * u.pm + fr, cx = u.pn * BM + wr * HALF + wc * 32 + 8 * fq;
        if constexpr (XR) { const int mrs = mod_row(ms);
            const f32x4 xg0 = *(const f32x4*)(gate + (size_t)mrs * NMOD + cx) * 0.5f, xg1 = *(const f32x4*)(gate + (size_t)mrs * NMOD + cx + 4) * 0.5f;
            const u32x4 xw = *(const u32x4*)(Xin + (size_t)ms * DM + cx);
            const f32x4 x0 = (f32x4){bf_lo(xw.x), bf_hi(xw.x), bf_lo(xw.y), bf_hi(xw.y)}, x1 = (f32x4){bf_lo(xw.z), bf_hi(xw.z), bf_lo(xw.w), bf_hi(xw.w)};
            const f32x4 a = x0 + xg0 * accx[0], b = x1 + xg1 * accx[1]; accx[0] = a; accx[1] = b;
            float ss = ((a[0] * a[0] + a[1] * a[1]) + (a[2] * a[2] + a[3] * a[3])) + ((b[0] * b[0] + b[1] * b[1]) + (b[2] * b[2] + b[3] * b[3]));
            ss += __shfl_xor(ss, 16); ss += __shfl_xor(ss, 32);
            if (fq == 0) atomicAdd(SSF + ms, ss); }
        asm volatile("s_waitcnt vmcnt(0)" ::: "memory");
        __syncthreads();
        if (threadIdx.x == 0) { unsigned* c = cnt + 64 * u.pm;
            __hip_atomic_fetch_add(c, 1u, __ATOMIC_RELAXED, __HIP_MEMORY_SCOPE_AGENT);
            unsigned sp = 0; while (__hip_atomic_load(c, __ATOMIC_RELAXED, __HIP_MEMORY_SCOPE_AGENT) < 4u && ++sp < (1u << 22)) __builtin_amdgcn_s_sleep(1); }
        __syncthreads();
        f32x4 gf[2][2];
#pragma unroll
        for (int bj = 0; bj < 2; ++bj)
#pragma unroll
            for (int n = 0; n < 2; ++n) gf[bj][n] = *(const f32x4*)(gfin + col0 + bj * HALF + n * 4);
        float totq[8];
#pragma unroll
        for (int q = 0; q < 8; ++q) totq[q] = __hip_atomic_load(SSF + rbase + (q >> 2) * HALF + (q & 3) * 16, __ATOMIC_RELAXED, __HIP_MEMORY_SCOPE_AGENT);
        if constexpr (XR) {
            const float tot = __hip_atomic_load(SSF + ms, __ATOMIC_RELAXED, __HIP_MEMORY_SCOPE_AGENT);
            const float rinv = 1.f / sqrtf(tot * (1.f / DM) + EPS);
            *(f32x4*)(Y + (size_t)ms * DM + cx) = (accx[0] * rinv) * *(const f32x4*)(gfin + cx); *(f32x4*)(Y + (size_t)ms * DM + cx + 4) = (accx[1] * rinv) * *(const f32x4*)(gfin + cx + 4); }
#pragma unroll
        for (int q = 0; q < 8; ++q) { const int ai = q >> 2, m = q & 3; const int r = rbase + ai * HALF + m * 16;
            const float rinv = 1.f / sqrtf(totq[q] * (1.f / DM) + EPS);
#pragma unroll
            for (int bj = 0; bj < 2; ++bj)
#pragma unroll
                for (int n = 0; n < 2; ++n) *(f32x4*)(Y + (size_t)r * DM + col0 + bj * HALF + n * 4) = (acc[ai][bj][m][n] * rinv) * gf[bj][n]; }
    }
};
}

constexpr size_t MiB = 1u << 20;
constexpr size_t WS_CTL = 0, CTL_ZERO_BYTES = 1 * MiB;
constexpr size_t WO_GU1 = 0, WO_D1 = WO_GU1 + (size_t)2 * DFF * DM, WO_IN = WO_D1 + (size_t)DFF * DM, WO_SSD = WO_IN + (size_t)DPROJ * DM,
                 WO_SC = WO_SSD + (size_t)DM * DM, WO_O = WO_SC + (size_t)DM * DM, WO_GU2 = WO_O + (size_t)DM * DM, WO_D2 = WO_GU2 + (size_t)2 * DFF * DM,
                 W_LAYER_ELEMS = WO_D2 + (size_t)DFF * DM;
constexpr size_t WS_WT = 1 * MiB;
constexpr size_t WS_MOD = 112 * MiB;
constexpr size_t WS_DT = 122 * MiB;
constexpr size_t WS_CA = 124 * MiB;
constexpr size_t WS_SHA = WS_CA + MiB / 2;
constexpr size_t WS_GS = WS_SHA + 3 * MiB;
constexpr size_t WS_SWDT = WS_GS + 3 * MiB + MiB / 4;
constexpr size_t WS_GN = WS_SWDT + 32768;
constexpr size_t WS_H = 131 * MiB;
constexpr size_t WS_S = 165 * MiB;
constexpr size_t WS_CD = WS_DT + (size_t)M * 16 * 4;
constexpr size_t WS_P = 229 * MiB;
constexpr size_t WS_SW = 501 * MiB;
constexpr size_t SW_LAYER = (size_t)NSEQ * (5632 + 8192 + 5632);
constexpr size_t WS_END = WS_SW + 2 * SW_LAYER * 2;
static_assert(WS_END <= 512 * MiB, "workspace budget");
static_assert(WS_WT + 2 * W_LAYER_ELEMS * 2 <= WS_MOD && WS_MOD + (size_t)2 * NSEQ * NMOD * 4 <= WS_DT && WS_CD + 8192 <= WS_CA && WS_SWDT + 2 * NSEQ * 16 * 4 <= WS_GN && WS_GN + 6 * DM * 4 <= WS_H && WS_H + (size_t)M * DM * 2 <= WS_S && WS_S + 64 * MiB <= WS_P && WS_P + (size_t)8 * M * DM * 2 <= WS_SW, "d_ws map");
constexpr size_t CTL_SS = 65536;
constexpr size_t CTL_FCNT = CTL_SS + (size_t)7 * M * 4;
static_assert(CTL_FCNT % 256 == 0 && CTL_FCNT + 7 * 80 * 256 <= CTL_ZERO_BYTES, "sumsq rows and counters inside the per-call memset");
constexpr size_t PT = (size_t)M * DM;
enum ProjT { PT_Z = 0, PT_XS = 1, PT_BC = 2, PT_SCB = 3, PT_SCC = 4, PT_SCH = 5, PT_GSSD = 6, PT_GSC = 7 };
constexpr int CW_BAR = 4096;

constexpr int NWAVES = 8;
constexpr int GRID = 256;
constexpr int RING_OFF = 0, RING_BYTES = 131072;
constexpr int SIDE_OFF = RING_BYTES;
constexpr int LDS_BYTES = 163840;
constexpr int LDSCTL_OFF = LDS_BYTES - 512, MISC_OFF = LDSCTL_OFF + 320;

#define GAS __attribute__((address_space(1)))
#define LAS __attribute__((address_space(3)))
typedef unsigned short bf16;
typedef unsigned v4u __attribute__((ext_vector_type(4)));
typedef float f32x4 __attribute__((ext_vector_type(4)));
typedef short bf16x8 __attribute__((ext_vector_type(8)));
typedef GAS unsigned gu32;
typedef GAS unsigned long long gu64;
#define RLX_AGENT __ATOMIC_RELAXED, __HIP_MEMORY_SCOPE_AGENT
#define LDS_WAIT() asm volatile("s_waitcnt lgkmcnt(0)" ::: "memory")
#define VM_WAIT() asm volatile("s_waitcnt vmcnt(0)" ::: "memory")
__device__ __forceinline__ unsigned long long rt() { return __builtin_amdgcn_s_memrealtime(); }
__device__ __forceinline__ unsigned f2bf(float f) { unsigned u = __builtin_bit_cast(unsigned, f); return (u + 0x7fffu + ((u >> 16) & 1u)) >> 16; }
__device__ __forceinline__ unsigned pk2(float lo, float hi) { return f2bf(lo) | (f2bf(hi) << 16); }

#define XB_TMO      128
#define XB_XCNT(j)  (256  + 64 * (j))
#define XB_XSUB(j)  (1280 + 64 * (j))
#define XB_XGEN(j)  (2304 + 64 * (j))
#define XB_TOP      3328
#define XB_TOPGEN   3392
#define XCD_BAR_WORDS 3456
#define XB_SPIN_CAP (1u << 18)

__device__ __forceinline__ unsigned xb_ld(unsigned* p)              { return __hip_atomic_load(p, __ATOMIC_RELAXED, __HIP_MEMORY_SCOPE_AGENT); }
__device__ __forceinline__ unsigned xb_add(unsigned* p, unsigned v) { return __hip_atomic_fetch_add(p, v, __ATOMIC_RELAXED, __HIP_MEMORY_SCOPE_AGENT); }
__device__ __forceinline__ unsigned xb_xcc_id() { return (unsigned)__builtin_amdgcn_s_getreg((3 << 11) | 20) & 0xFu; }
#define XB_SPIN(cond, bar) do { unsigned _sp = 0; while (cond) { __builtin_amdgcn_s_sleep(1); \
    if ((++_sp & 255u) == 0u) { if (xb_ld(&(bar)[XB_TMO])) break; if (_sp > XB_SPIN_CAP) { atomicAdd(&(bar)[XB_TMO], 1u); break; } } } } while (0)

struct XcdBarrier {
    unsigned* bar; unsigned x;
    volatile LAS unsigned* st;
};

__device__ __forceinline__ XcdBarrier xcd_barrier_post(unsigned* bar, volatile LAS unsigned* st) {
    XcdBarrier b; b.bar = bar; b.x = xb_xcc_id(); b.st = st;
    if (threadIdx.x == 0) (void)xb_add(&bar[XB_XCNT(b.x)], 1u);
    return b;
}
__device__ __forceinline__ void xcd_barrier_complete(unsigned* bar, unsigned x, unsigned& nloc, unsigned& nx) {
    const unsigned G = gridDim.x * gridDim.y * gridDim.z;
    unsigned sum, cnt, mine, sp = 0u;
    for (;;) {
        sum = 0u; cnt = 0u; mine = 0u;
#pragma unroll
        for (unsigned j = 0; j < 16; ++j) { const unsigned c = xb_ld(&bar[XB_XCNT(j)]); sum += c; cnt += (c > 0u) ? 1u : 0u; mine = (j == x) ? c : mine; }
        if (sum == G) break;
        __builtin_amdgcn_s_sleep(1);
        if ((++sp & 255u) == 0u) { if (xb_ld(&bar[XB_TMO])) break; if (sp > XB_SPIN_CAP) { atomicAdd(&bar[XB_TMO], 1u); break; } }
    }
    nloc = mine > 0u ? mine : 1u; nx = cnt > 0u ? cnt : 1u;
}

__device__ __forceinline__ void xcd_barrier(const XcdBarrier& b) {
    asm volatile("s_waitcnt vmcnt(0)" ::: "memory");
    __syncthreads();
    if (threadIdx.x == 0) {
        const unsigned myx = xb_xcc_id();
        unsigned* bar = b.bar; asm volatile("" : "+s"(bar));
        __builtin_amdgcn_s_waitcnt(0);
        unsigned nloc = b.st[0], nx = b.st[1];
        if (nloc == 0u) { xcd_barrier_complete(bar, myx, nloc, nx); b.st[0] = nloc; b.st[1] = nx; }
        const unsigned old = xb_add(&bar[XB_XSUB(myx)], 1u);
        const unsigned gen = old / nloc;
        if (old + 1u == (gen + 1u) * nloc) {
            __builtin_amdgcn_fence(__ATOMIC_RELEASE, "agent");
            asm volatile("s_waitcnt vmcnt(0)" ::: "memory");
            const unsigned og = xb_add(&bar[XB_TOP], 1u);
            const unsigned tg = og / nx;
            if (og + 1u == (tg + 1u) * nx) xb_add(&bar[XB_TOPGEN], 1u);
            else XB_SPIN(xb_ld(&bar[XB_TOPGEN]) == tg, bar);
            __builtin_amdgcn_fence(__ATOMIC_ACQUIRE, "agent");
            xb_add(&bar[XB_XGEN(myx)], 1u);
            asm volatile("s_waitcnt vmcnt(0)" ::: "memory");
        } else {
            XB_SPIN(xb_ld(&bar[XB_XGEN(myx)]) == gen, bar);
            __builtin_amdgcn_fence(__ATOMIC_ACQUIRE, "agent");
            asm volatile("s_waitcnt vmcnt(0)" ::: "memory");
        }
    }
    __syncthreads();
}

__device__ __forceinline__ void xcd_arrive(const XcdBarrier& b, unsigned* bar2) {
    asm volatile("s_waitcnt vmcnt(0)" ::: "memory");
    __syncthreads();
    if (threadIdx.x == 0) {
        const unsigned myx = xb_xcc_id();
        unsigned* bar = bar2; asm volatile("" : "+s"(bar));
        __builtin_amdgcn_s_waitcnt(0);
        unsigned nloc = b.st[0], nx = b.st[1];
        if (nloc == 0u) { unsigned* bm = b.bar; asm volatile("" : "+s"(bm)); xcd_barrier_complete(bm, myx, nloc, nx); b.st[0] = nloc; b.st[1] = nx; }
        const unsigned old = xb_add(&bar[XB_XSUB(myx)], 1u);
        if ((old + 1u) % nloc == 0u) {
            __builtin_amdgcn_fence(__ATOMIC_RELEASE, "agent");
            asm volatile("s_waitcnt vmcnt(0)" ::: "memory");
            xb_add(&bar[XB_TOP], 1u);
        }
    }
}
__device__ __forceinline__ void xcd_wait(const XcdBarrier& b, unsigned* bar2, unsigned gen) {
    if (threadIdx.x == 0) {
        unsigned* bar = bar2; asm volatile("" : "+s"(bar));
        const unsigned nx = b.st[1];
        XB_SPIN(xb_ld(&bar[XB_TOP]) < nx * gen, bar);
        __builtin_amdgcn_fence(__ATOMIC_ACQUIRE, "agent");
        asm volatile("s_waitcnt vmcnt(0)" ::: "memory");
    }
    __syncthreads();
}
__device__ __forceinline__ void xcd_barrier_flat(const XcdBarrier& b, unsigned* bar4, volatile LAS unsigned* genw) {
    xcd_arrive(b, bar4);
    if (threadIdx.x == 0) {
        unsigned* bar = bar4; asm volatile("" : "+s"(bar));
        const unsigned gen = genw[0] + 1u; genw[0] = gen;
        const unsigned nx = b.st[1];
        XB_SPIN(xb_ld(&bar[XB_TOP]) < nx * gen, bar);
        __builtin_amdgcn_fence(__ATOMIC_ACQUIRE, "agent");
        asm volatile("s_waitcnt vmcnt(0)" ::: "memory");
    }
    __syncthreads();
}
__device__ __forceinline__ void xcd_arrive3(unsigned* bar3w) {
    asm volatile("s_waitcnt vmcnt(0)" ::: "memory");
    __syncthreads();
    if (threadIdx.x == 0) {
        const unsigned myx = xb_xcc_id();
        unsigned* bar = bar3w; asm volatile("" : "+s"(bar));
        __builtin_amdgcn_s_waitcnt(0);
        __builtin_amdgcn_fence(__ATOMIC_RELEASE, "agent");
        asm volatile("s_waitcnt vmcnt(0)" ::: "memory");
        (void)__hip_atomic_fetch_add(&bar[XB_XSUB(myx)], 1u, __ATOMIC_RELAXED, __HIP_MEMORY_SCOPE_AGENT);
    }
}
__device__ __forceinline__ void xcd_wait3(unsigned* bar3w, unsigned target) {
    if (threadIdx.x == 0) {
        unsigned* bar = bar3w; asm volatile("" : "+s"(bar));
        unsigned sp = 0;
        for (;;) { unsigned s = 0;
#pragma unroll
            for (int j = 0; j < 16; ++j) s += xb_ld(&bar[XB_XSUB(j)]);
            if (s >= target) break;
            __builtin_amdgcn_s_sleep(1);
            if ((++sp & 255u) == 0u) { if (xb_ld(&bar[XB_TMO])) break; if (sp > XB_SPIN_CAP) { atomicAdd(&bar[XB_TMO], 1u); break; } } }
        __builtin_amdgcn_fence(__ATOMIC_ACQUIRE, "agent");
        asm volatile("s_waitcnt vmcnt(0)" ::: "memory");
    }
    __syncthreads();
}
__device__ __forceinline__ void xcd_barrier3(unsigned* bar3w, volatile LAS unsigned* genw, unsigned total) {
    xcd_arrive3(bar3w);
    unsigned gen = 0;
    if (threadIdx.x == 0) { gen = genw[0] + 1u; genw[0] = gen; }
    xcd_wait3(bar3w, gen * total);
}


struct Frame {
    LAS unsigned char* lds;
    volatile LAS unsigned* MISC;
    gu32* ctl;
    int tid, lane, wave;
    int vcu, bx;
    int dry;
    float* out;
    unsigned char* ws;
};
#define DRYP(p) (p)
typedef const unsigned char __attribute__((address_space(4)))* kptr_t;
__device__ __forceinline__ const float* in_ptr(int i) {
    kptr_t kp = (kptr_t)__builtin_amdgcn_kernarg_segment_ptr();
    asm volatile("" : "+s"(kp));
    return *(const float* const __attribute__((address_space(4)))*)(kp + 8 * i);
}
__device__ __forceinline__ bf16* wt_ptr(const Frame& F, int layer, size_t off) { return (bf16*)(F.ws + WS_WT) + (size_t)layer * W_LAYER_ELEMS + off; }
__device__ __forceinline__ bf16* proj_ptr(const Frame& F, int t) { return (bf16*)(F.ws + WS_P) + (size_t)t * PT; }
__device__ __forceinline__ float* ss_ptr(const Frame& F, int idx) { return (float*)(F.ws + WS_CTL + CTL_SS) + (size_t)idx * M; }
__device__ __forceinline__ unsigned* fcnt_ptr(const Frame& F, int idx) { return (unsigned*)(F.ws + WS_CTL + CTL_FCNT) + (size_t)idx * 80 * 64; }
__device__ __forceinline__ float* gs_ptr(const Frame& F, int idx) { return (float*)(F.ws + WS_GS) + (size_t)idx * NSEQ * DM; }
__device__ __forceinline__ bf16* sha_ptr(const Frame& F, int idx) { return (bf16*)(F.ws + WS_SHA) + (size_t)idx * 256 * DM; }
__device__ __forceinline__ bf16* sw_ptr(const Frame& F, int layer, int j) { return (bf16*)(F.ws + WS_SW) + (size_t)layer * SW_LAYER + (size_t)NSEQ * (j == 0 ? 0 : (j == 1 ? 5632 : 5632 + 8192)); }
__device__ __forceinline__ float* mod_ptr(const Frame& F, int layer, int chunk) { return (float*)(F.ws + WS_MOD) + (size_t)layer * NSEQ * NMOD + (size_t)chunk * DM; }

__device__ __forceinline__ void frame_refresh(Frame& F) {
    int t = threadIdx.x; asm volatile("" : "+v"(t));
    F.tid = t; F.lane = t & 63; F.wave = __builtin_amdgcn_readfirstlane(t >> 6);
    int bx = blockIdx.x; asm volatile("" : "+s"(bx));
    F.bx = bx; F.vcu = (bx & 7) * (GRID >> 3) + (bx >> 3);
    kptr_t kp = (kptr_t)__builtin_amdgcn_kernarg_segment_ptr(); asm volatile("" : "+s"(kp));
    F.out = *(float* const __attribute__((address_space(4)))*)(kp + 224); F.ws = *(unsigned char* const __attribute__((address_space(4)))*)(kp + 232);
}
template <int CTRL> __device__ __forceinline__ float dpp_mov(float v) { return __builtin_bit_cast(float, __builtin_amdgcn_update_dpp(0, __builtin_bit_cast(int, v), CTRL, 0xF, 0xF, true)); }
__device__ __forceinline__ float wave_sum(float v) {
    v += dpp_mov<0xB1>(v); v += dpp_mov<0x4E>(v); v += dpp_mov<0x141>(v); v += dpp_mov<0x140>(v);
    const int vi = __builtin_bit_cast(int, v);
    const float s0 = __builtin_bit_cast(float, __builtin_amdgcn_readlane(vi, 0)), s1 = __builtin_bit_cast(float, __builtin_amdgcn_readlane(vi, 16)),
                s2 = __builtin_bit_cast(float, __builtin_amdgcn_readlane(vi, 32)), s3 = __builtin_bit_cast(float, __builtin_amdgcn_readlane(vi, 48));
    return (s0 + s1) + (s2 + s3);
}
__device__ __forceinline__ float bf2f(bf16 b) { return __uint_as_float((unsigned)b << 16); }

template <int MAP> __device__ __forceinline__ int dest_row(int c) {
    if (MAP == 1) { return c < DFF ? (((c >> 7) << 8) + (c & 127)) : ((((c - DFF) >> 7) << 8) + 128 + ((c - DFF) & 127)); }
    if (MAP == 2) { const int d = c < 3072 ? c : (c < 3088 ? 8192 + (c - 3072) : c - 16);
        if (d >= 4096 && d < 6144) { const int j = d < 5120 ? d - 4096 : d - 5120; return 4096 + ((j >> 7) << 8) + (d < 5120 ? 0 : 128) + (j & 127); }
        return d; }
    return c;
}
template <int MAP> __device__ __forceinline__ void p0_item_load(const float* W, int N, int item, int nblk, int lane, f32x4 (&v)[16]) {
    const int kb = item / nblk, nb = item % nblk, k0 = 64 * kb, n0 = 64 * nb;
    const int n4 = (lane & 15) * 4, kr = lane >> 4;
    const bool nok = n0 + n4 < N;
    const float* p = W + (size_t)(k0 + kr) * N + (nok ? n0 + n4 : 0);
#pragma unroll
    for (int i = 0; i < 16; ++i) v[i] = *(const f32x4*)(p + (size_t)(4 * i) * N);
    if (!nok) {
#pragma unroll
        for (int i = 0; i < 16; ++i) v[i] = v[i] * 0.f; }
}
template <int MAP> __device__ __forceinline__ void p0_item_store(int K, int N, bf16* WT, LAS float* scr, int item, int nblk, int lane, const f32x4 (&v)[16]) {
    const int kb = item / nblk, nb = item % nblk, k0 = 64 * kb, n0 = 64 * nb;
    const int n4 = (lane & 15) * 4, kr = lane >> 4;
#pragma unroll
    for (int i = 0; i < 16; ++i) { LAS float* s = scr + (4 * i + kr) * 65 + n4; s[0] = v[i].x; s[1] = v[i].y; s[2] = v[i].z; s[3] = v[i].w; }
    LDS_WAIT(); asm volatile("" ::: "memory");
    const int c = lane & 7;
#pragma unroll
    for (int j = 0; j < 8; ++j) { const int nl = (lane >> 3) + 8 * j; const LAS float* s = scr + (8 * c) * 65 + nl;
        v4u o; o.x = pk2(s[0 * 65], s[1 * 65]); o.y = pk2(s[2 * 65], s[3 * 65]); o.z = pk2(s[4 * 65], s[5 * 65]); o.w = pk2(s[6 * 65], s[7 * 65]);
        if (n0 + nl < N) *(GAS v4u*)(WT + (size_t)dest_row<MAP>(n0 + nl) * K + k0 + 8 * c) = o; }
    LDS_WAIT(); asm volatile("" ::: "memory");
}
template <int MAP> __device__ __forceinline__ void p0_transpose(Frame& F, const float* W, int K, int N, bf16* WT, int& rot, int wg0 = 0) {
    const int nblk = (N + 63) / 64, nitems = (K / 64) * nblk;
    if (F.vcu < wg0) { rot = (rot + nitems) % 65536; return; }
    LAS float* scr = (LAS float*)(F.lds + RING_OFF + F.wave * 16896);
    const int NGW = (GRID - wg0) * NWAVES; const int gw = ((F.vcu - wg0) * NWAVES + F.wave + NGW - rot % NGW) % NGW;
    f32x4 v[16], vn[16];
    if (gw < nitems) p0_item_load<MAP>(W, N, gw, nblk, F.lane, v);
    for (int it = gw; it < nitems; it += NGW) {
        const bool more = it + NGW < nitems;
        if (more) p0_item_load<MAP>(W, N, it + NGW, nblk, F.lane, vn);
        p0_item_store<MAP>(K, N, WT, scr, it, nblk, F.lane, v);
        if (more) {
#pragma unroll
            for (int i = 0; i < 16; ++i) v[i] = vn[i]; }
    }
    rot = (rot + nitems) % 65536;
}
__device__ __forceinline__ void p0a_prologue(Frame& F) {
    frame_refresh(F);
    int rot = 0;
    for (int l = 0; l < DEPTH; ++l) p0_transpose<0>(F, in_ptr(7) + (size_t)l * DM * NMOD, DM, NMOD, (bf16*)(F.ws + WS_P) + (size_t)l * NMOD * DM, rot);
    const int gt = F.vcu * (NWAVES * 64) + F.tid, NT = GRID * NWAVES * 64;
    { float* gn = (float*)(F.ws + WS_GN);
      for (int i = gt; i < 6 * DM; i += NT) { const int l = i / (3 * DM), j = (i / DM) % 3, c = i & (DM - 1); const float* s9 = in_ptr(9); const float* s10 = in_ptr(10); const float* s11 = in_ptr(11);
          const float v0 = s9[l * DM + c], v1 = s10[l * DM + c], v2 = s11[l * DM + c]; gn[i] = j == 0 ? v0 : (j == 1 ? v1 : v2); } }
    { bf16* ca = (bf16*)(F.ws + WS_CA);
      for (int i = gt; i < 256 * DM; i += NT) { const int r = i >> 10, c = i & 1023; float v = 0.f;
          if (r < NB_P) v = in_ptr(2)[r * DM + c]; else if (r < NSEQ) v = in_ptr(3)[(r - NB_P) * DM + c];
          ca[i] = (bf16)f2bf(r < NSEQ ? v / (1.f + __expf(-v)) : 0.f); } }
}
#ifndef FILLW_ON
#define FILLW_ON 1
#endif
constexpr bool FILLW = FILLW_ON;
#ifndef P0B_LAST_ALL
#define P0B_LAST_ALL 0
#endif
#ifndef P0B_WIN_ALL
#define P0B_WIN_ALL 0
#endif
__device__ __forceinline__ void p0_fill(Frame& F, int k) {
    frame_refresh(F);
    constexpr int l = 1; int rot = 0;
    if (k == 0) { p0_transpose<1>(F, in_ptr(12) + (size_t)l * DM * 2 * DFF, DM, 2 * DFF, wt_ptr(F, l, WO_GU1), rot); }
    if (k == 1) { p0_transpose<0>(F, in_ptr(13) + (size_t)l * DFF * DM, DFF, DM, wt_ptr(F, l, WO_D1), rot);
                  p0_transpose<0>(F, in_ptr(23) + (size_t)l * DM * DM, DM, DM, wt_ptr(F, l, WO_SSD), rot);
                  p0_transpose<0>(F, in_ptr(25) + (size_t)l * DM * DM, DM, DM, wt_ptr(F, l, WO_SC), rot);
                  p0_transpose<0>(F, in_ptr(26) + (size_t)l * DM * DM, DM, DM, wt_ptr(F, l, WO_O), rot); }
    if (k == 2) { p0_transpose<2>(F, in_ptr(16) + (size_t)l * DM * DPROJ, DM, DPROJ, wt_ptr(F, l, WO_IN), rot); }
    if (k == 3) { p0_transpose<1>(F, in_ptr(14) + (size_t)l * DM * 2 * DFF, DM, 2 * DFF, wt_ptr(F, l, WO_GU2), rot);
                  p0_transpose<0>(F, in_ptr(15) + (size_t)l * DFF * DM, DFF, DM, wt_ptr(F, l, WO_D2), rot); }
}
__device__ __forceinline__ void p0b_prologue(Frame& F, int wg0) {
    frame_refresh(F);
    int rot = 0;
    for (int l = 0; l < (FILLW ? 1 : DEPTH); ++l) {
        const int w0 = l == 0 ? wg0 : 0;
        p0_transpose<1>(F, in_ptr(12) + (size_t)l * DM * 2 * DFF, DM, 2 * DFF, wt_ptr(F, l, WO_GU1), rot, w0);
        p0_transpose<0>(F, in_ptr(13) + (size_t)l * DFF * DM, DFF, DM, wt_ptr(F, l, WO_D1), rot, w0);
        p0_transpose<0>(F, in_ptr(23) + (size_t)l * DM * DM, DM, DM, wt_ptr(F, l, WO_SSD), rot, w0);
        p0_transpose<0>(F, in_ptr(25) + (size_t)l * DM * DM, DM, DM, wt_ptr(F, l, WO_SC), rot, w0);
        p0_transpose<0>(F, in_ptr(26) + (size_t)l * DM * DM, DM, DM, wt_ptr(F, l, WO_O), rot, w0);
        p0_transpose<2>(F, in_ptr(16) + (size_t)l * DM * DPROJ, DM, DPROJ, wt_ptr(F, l, WO_IN), rot, P0B_WIN_ALL ? 0 : w0);
        p0_transpose<1>(F, in_ptr(14) + (size_t)l * DM * 2 * DFF, DM, 2 * DFF, wt_ptr(F, l, WO_GU2), rot, P0B_LAST_ALL ? 0 : w0);
        p0_transpose<0>(F, in_ptr(15) + (size_t)l * DFF * DM, DFF, DM, wt_ptr(F, l, WO_D2), rot, P0B_LAST_ALL ? 0 : w0);
    }
}

__device__ __forceinline__ void norm0_phase(Frame& F) {
    frame_refresh(F);
    const int gw = F.vcu * NWAVES + F.wave, NGW = GRID * NWAVES;
    const float* Xp = in_ptr(0); const float* Xs = in_ptr(1); bf16* H = (bf16*)(F.ws + WS_H); const float* GS = gs_ptr(F, 0); const float* SH = mod_ptr(F, 0, 0);
    f32x4 v[4], gv[4], sv[4], vn[4], gn[4], sn[4];
    if (gw < M) { const int mr = mod_row(gw); const f32x4* xr = (const f32x4*)(gw < MP ? Xp + (size_t)gw * DM : Xs + (size_t)(gw - MP) * DM) + F.lane;
        const f32x4* gr = (const f32x4*)(GS + (size_t)mr * DM) + F.lane; const f32x4* sr = (const f32x4*)(SH + (size_t)mr * NMOD) + F.lane;
#pragma unroll
        for (int j = 0; j < 4; ++j) { v[j] = xr[64 * j]; gv[j] = gr[64 * j]; sv[j] = sr[64 * j]; } }
    for (int m = gw; m < M; m += NGW) {
        const int mn = m + NGW;
        if (mn < M) { const int mr = mod_row(mn); const f32x4* xr = (const f32x4*)(mn < MP ? Xp + (size_t)mn * DM : Xs + (size_t)(mn - MP) * DM) + F.lane;
            const f32x4* gr = (const f32x4*)(GS + (size_t)mr * DM) + F.lane; const f32x4* sr = (const f32x4*)(SH + (size_t)mr * NMOD) + F.lane;
#pragma unroll
            for (int j = 0; j < 4; ++j) { vn[j] = xr[64 * j]; gn[j] = gr[64 * j]; sn[j] = sr[64 * j]; } }
        float s = 0.f;
#pragma unroll
        for (int j = 0; j < 4; ++j) s += (v[j].x * v[j].x + v[j].y * v[j].y) + (v[j].z * v[j].z + v[j].w * v[j].w);
        const float r = 1.f / sqrtf(wave_sum(s) * (1.f / DM) + EPS);
        unsigned long long* o8 = (unsigned long long*)(H + (size_t)m * DM) + F.lane;
#pragma unroll
        for (int j = 0; j < 4; ++j) { const f32x4 h = (v[j] * r) * gv[j] + sv[j]; o8[64 * j] = (unsigned long long)pk2(h.x, h.y) | ((unsigned long long)pk2(h.z, h.w) << 32); }
#pragma unroll
        for (int j = 0; j < 4; ++j) { v[j] = vn[j]; gv[j] = gn[j]; sv[j] = sn[j]; }
    }
}
__device__ __forceinline__ void final_norm_phase(Frame& F) {
    frame_refresh(F);
    const int gw = F.vcu * NWAVES + F.wave, NGW = GRID * NWAVES;
    f32x4 gv[4];
#pragma unroll
    for (int j = 0; j < 4; ++j) gv[j] = ((const f32x4*)in_ptr(27))[F.lane + 64 * j];
    f32x4 v[4], vn[4];
    if (gw < M) { const f32x4* xr = (const f32x4*)(F.out + (size_t)gw * DM) + F.lane;
#pragma unroll
        for (int j = 0; j < 4; ++j) v[j] = xr[64 * j]; }
    for (int m = gw; m < M; m += NGW) {
        const int mn = m + NGW;
        if (mn < M) { const f32x4* xr = (const f32x4*)(F.out + (size_t)mn * DM) + F.lane;
#pragma unroll
            for (int j = 0; j < 4; ++j) vn[j] = xr[64 * j]; }
        f32x4* xo = (f32x4*)(F.out + (size_t)m * DM) + F.lane;
        float s = 0.f;
#pragma unroll
        for (int j = 0; j < 4; ++j) s += (v[j].x * v[j].x + v[j].y * v[j].y) + (v[j].z * v[j].z + v[j].w * v[j].w);
        const float r = 1.f / sqrtf(wave_sum(s) * (1.f / DM) + EPS);
#pragma unroll
        for (int j = 0; j < 4; ++j) xo[64 * j] = (v[j] * r) * gv[j];
#pragma unroll
        for (int j = 0; j < 4; ++j) v[j] = vn[j];
    }
}

__device__ __forceinline__ void dt_phase(Frame& F, int layer) {
    frame_refresh(F);
    if (F.bx < (GRID >> 1)) return;
    const int gw = (F.bx - (GRID >> 1)) * NWAVES + F.wave, NGW = (GRID >> 1) * NWAVES;
    const bf16* H = (const bf16*)(F.ws + WS_H); const bf16* Wd = wt_ptr(F, layer, WO_IN) + (size_t)8192 * DM;
    float* DT = (float*)(F.ws + WS_DT);
    const int fr = F.lane & 15, fq = F.lane >> 4;
    const float bias = in_ptr(19)[layer * 16 + fr];
    for (int it = gw; it < M / 16; it += NGW) {
        const bf16* ap = H + (size_t)(it * 16 + fr) * DM + 8 * fq; const bf16* bp = Wd + (size_t)fr * DM + 8 * fq;
        f32x4 acc = {0.f, 0.f, 0.f, 0.f};
#pragma unroll 8
        for (int kk = 0; kk < DM / 32; ++kk) { const bf16x8 a = *(const bf16x8*)(ap + kk * 32), b = *(const bf16x8*)(bp + kk * 32);
            acc = __builtin_amdgcn_mfma_f32_16x16x32_bf16(a, b, acc, 0, 0, 0); }
#pragma unroll
        for (int r = 0; r < 4; ++r) { const int row = it * 16 + 4 * fq + r;
            const float x = acc[r] + bias; const float e = __expf(-fabsf(x)); const float l1p = e < 1e-3f ? e * (1.f - 0.5f * e) : __logf(1.f + e);
            const float sp = fmaxf(x, 0.f) + l1p; DT[(size_t)row * 16 + fr] = sp; }
    }
}

struct SCRows { v4u p0, bb, p1, p2; };
__device__ __forceinline__ void sc_load(const bf16* SB, const bf16* SP, int idx, SCRows& R) {
    const int m = idx >> 7, j0 = (idx & 127) * 8;
    const int t = m < MP ? (m & (SEQ_P - 1)) : ((m - MP) & (SEQ_S - 1));
    const size_t ro = (size_t)m * DM + j0, r1 = ro - (t >= 1 ? DM : 0), r2 = ro - (t >= 2 ? 2 * DM : 0);
    R.p0 = *(const v4u*)(SP + ro); R.bb = *(const v4u*)(SB + ro); R.p1 = *(const v4u*)(SP + r1); R.p2 = *(const v4u*)(SP + r2);
}
__device__ __forceinline__ void sc_unpk(const v4u& c, float (&p)[8]) {
    p[0] = bf_lo(c.x); p[1] = bf_hi(c.x); p[2] = bf_lo(c.y); p[3] = bf_hi(c.y); p[4] = bf_lo(c.z); p[5] = bf_hi(c.z); p[6] = bf_lo(c.w); p[7] = bf_hi(c.w);
}
__device__ __forceinline__ void shortconv_phase(Frame& F, int layer) {
    frame_refresh(F);
    const int gt = F.vcu * (NWAVES * 64) + F.tid, NT = GRID * NWAVES * 64;
    bf16* SB = proj_ptr(F, PT_SCB); const bf16* SP = proj_ptr(F, PT_SCC);
    const float* cw = in_ptr(24) + (size_t)layer * 3 * DM;
    const float* st = in_ptr(6) + (size_t)layer * NB_S * 2 * DM;
    float* o_p = F.out + (size_t)M * DM + (size_t)DEPTH * NB_P * 16 * 64 * 128 + (size_t)DEPTH * NB_P * 3 * DXBC + (size_t)layer * NB_P * 2 * DM;
    float* o_s = F.out + (size_t)M * DM + (size_t)DEPTH * NB_P * 16 * 64 * 128 + (size_t)DEPTH * NB_P * 3 * DXBC + (size_t)DEPTH * NB_P * 2 * DM
                 + (size_t)DEPTH * NB_S * 16 * 64 * 128 + (size_t)DEPTH * NB_S * 3 * DXBC + (size_t)layer * NB_S * 2 * DM;
    constexpr int NIT = M * (DM / 8);
    SCRows R, Rn;
    if (gt < NIT) sc_load(SB, SP, gt, R);
    for (int idx = gt; idx < NIT; idx += NT) {
        if (idx + NT < NIT) sc_load(SB, SP, idx + NT, Rn);
        const int m = idx >> 7, j0 = (idx & 127) * 8;
        const bool prm = m < MP; const int t = prm ? (m & (SEQ_P - 1)) : ((m - MP) & (SEQ_S - 1)); const int sq = prm ? (m >> 11) : ((m - MP) >> 3); const int L = prm ? SEQ_P : SEQ_S;
        const size_t ro = (size_t)m * DM + j0;
        float cur[8], p1[8], p2[8], bv[8];
        sc_unpk(R.p0, cur); sc_unpk(R.p1, p1); sc_unpk(R.p2, p2); sc_unpk(R.bb, bv);
        if (t < 2) {
#pragma unroll
            for (int i = 0; i < 8; ++i) { if (t < 1) p1[i] = prm ? 0.f : st[((size_t)sq * 2 + 1) * DM + j0 + i]; p2[i] = prm ? 0.f : st[((size_t)sq * 2 + t) * DM + j0 + i]; } }
        float o[8];
#pragma unroll
        for (int i = 0; i < 8; ++i) o[i] = bv[i] * (cw[j0 + i] * p2[i] + cw[DM + j0 + i] * p1[i] + cw[2 * DM + j0 + i] * cur[i]);
        v4u w; w.x = pk2(o[0], o[1]); w.y = pk2(o[2], o[3]); w.z = pk2(o[4], o[5]); w.w = pk2(o[6], o[7]);
        *(v4u*)(SB + ro) = w;
        if (t >= L - 2) { float* op = (prm ? o_p : o_s) + ((size_t)sq * 2 + (t - (L - 2))) * DM + j0;
            *(f32x4*)op = (f32x4){cur[0], cur[1], cur[2], cur[3]}; *(f32x4*)(op + 4) = (f32x4){cur[4], cur[5], cur[6], cur[7]}; }
        R = Rn;
    }
}

__device__ __forceinline__ void ssd_unit(Frame& F, int layer, int seq, int g) {
    frame_refresh(F);
    const int tid = F.tid, lane = F.lane, wave = F.wave;
    constexpr bool prm = false; const int L = SEQ_S; const int sq = seq - NB_P;
    const size_t mbase = prm ? (size_t)seq * SEQ_P : (size_t)MP + (size_t)sq * SEQ_S;
    LAS float* cv = (LAS float*)(F.lds); LAS float* ybuf = (LAS float*)(F.lds + 16384); LAS float* dts = (LAS float*)(F.lds + 24576); LAS float* dAs = (LAS float*)(F.lds + 24704);
    const bf16* src; int col, chan;
    if (tid < 256) { src = proj_ptr(F, PT_XS); col = g * 256 + tid; chan = col; }
    else if (tid < 384) { src = proj_ptr(F, PT_BC); col = g * 128 + (tid - 256); chan = 1024 + col; }
    else { src = proj_ptr(F, PT_BC); col = 512 + g * 128 + (tid - 384); chan = 1024 + col; }
    const float* cwp = in_ptr(17) + (size_t)layer * 4 * DXBC + chan;
    const float cw0 = cwp[0], cw1 = cwp[DXBC], cw2 = cwp[2 * DXBC], cw3 = cwp[3 * DXBC], cb = in_ptr(18)[(size_t)layer * DXBC + chan];
    float w0, w1, w2;
    { const float* cs = in_ptr(5) + ((size_t)layer * NB_S + sq) * 3 * DXBC + chan; w0 = cs[0]; w1 = cs[DXBC]; w2 = cs[2 * DXBC]; }
    const int hh = tid >> 7, i7 = tid & 127, nseg = i7 & 7, pg = i7 >> 3, head = g * 4 + hh;
    float s[4][16];
    float* nst = F.out + (size_t)M * DM + (prm ? (size_t)0 : (size_t)DEPTH * NB_P * 16 * 8192 + (size_t)DEPTH * NB_P * 3 * DXBC + (size_t)DEPTH * NB_P * 2 * DM)
                 + (((size_t)layer * (prm ? NB_P : NB_S) + sq) * 16 + head) * 8192;
    if (prm) {
#pragma unroll
        for (int r = 0; r < 4; ++r)
#pragma unroll
            for (int i = 0; i < 16; ++i) s[r][i] = 0.f;
    } else { const float* sp = in_ptr(4) + (((size_t)layer * NB_S + sq) * 16 + head) * 8192;
#pragma unroll
        for (int r = 0; r < 4; ++r)
#pragma unroll
            for (int q = 0; q < 4; ++q) { const f32x4 v = *(const f32x4*)(sp + (size_t)(pg + 16 * r) * 128 + 16 * nseg + 4 * q); s[r][4 * q] = v.x; s[r][4 * q + 1] = v.y; s[r][4 * q + 2] = v.z; s[r][4 * q + 3] = v.w; } }
    const float* DT = (const float*)(F.ws + WS_DT);
    bf16* Z = proj_ptr(F, PT_Z);
    const int ech = lane * 4;
    const float Dh = in_ptr(21)[layer * 16 + g * 4 + (ech >> 6)];
    const f32x4 nw = *(const f32x4*)(in_ptr(22) + (size_t)layer * DM + g * 256 + ech);
    float a_neg = 0.f;
    if (tid < 32) a_neg = -__expf(in_ptr(20)[layer * 16 + g * 4 + (tid & 3)]);
    float pre[8];
#pragma unroll
    for (int j = 0; j < 8; ++j) pre[j] = bf2f(src[(mbase + j) * DM + col]);
    for (int t0 = 0; t0 < L; t0 += 8) {
        const unsigned long long zw = *(const unsigned long long*)(Z + (mbase + t0 + wave) * DM + g * 256 + ech);
        float dtv_l = 0.f; if (tid < 32) dtv_l = DT[(mbase + t0 + (tid >> 2)) * 16 + g * 4 + (tid & 3)];
#pragma unroll
        for (int j = 0; j < 8; ++j) { const float v = cw0 * w0 + cw1 * w1 + cw2 * w2 + cw3 * pre[j] + cb; w0 = w1; w1 = w2; w2 = pre[j]; cv[j * 512 + tid] = fast_silu(v); }
        if (t0 + 8 < L) {
#pragma unroll
            for (int j = 0; j < 8; ++j) pre[j] = bf2f(src[(mbase + t0 + 8 + j) * DM + col]); }
        if (tid < 32) { dts[tid] = dtv_l; dAs[tid] = __expf(dtv_l * a_neg); }
        __syncthreads();
#pragma unroll 1
        for (int j = 0; j < 8; ++j) {
            const float dtv = dts[j * 4 + hh], dA = dAs[j * 4 + hh];
            float Bv[16], Cv[16];
#pragma unroll
            for (int q = 0; q < 4; ++q) { const f32x4 b4 = *(const LAS f32x4*)(cv + j * 512 + 256 + 16 * nseg + 4 * q), c4 = *(const LAS f32x4*)(cv + j * 512 + 384 + 16 * nseg + 4 * q);
                Bv[4 * q] = b4.x; Bv[4 * q + 1] = b4.y; Bv[4 * q + 2] = b4.z; Bv[4 * q + 3] = b4.w; Cv[4 * q] = c4.x; Cv[4 * q + 1] = c4.y; Cv[4 * q + 2] = c4.z; Cv[4 * q + 3] = c4.w; }
#pragma unroll
            for (int r = 0; r < 4; ++r) { const float xv = cv[j * 512 + hh * 64 + pg + 16 * r]; const float coef = dtv * xv; float acc = 0.f;
#pragma unroll
                for (int i = 0; i < 16; ++i) { s[r][i] = dA * s[r][i] + coef * Bv[i]; acc += Cv[i] * s[r][i]; }
                acc += __shfl_xor(acc, 1); acc += __shfl_xor(acc, 2); acc += __shfl_xor(acc, 4);
                if (nseg == 0) ybuf[j * 256 + hh * 64 + pg + 16 * r] = acc; }
        }
        __syncthreads();
        {
            const f32x4 y4 = *(const LAS f32x4*)(ybuf + wave * 256 + ech), x4 = *(const LAS f32x4*)(cv + wave * 512 + ech);
            const unsigned zl = (unsigned)zw, zh = (unsigned)(zw >> 32);
            f32x4 y;
            y.x = (y4.x + x4.x * Dh) * fast_silu(bf_lo(zl)); y.y = (y4.y + x4.y * Dh) * fast_silu(bf_hi(zl));
            y.z = (y4.z + x4.z * Dh) * fast_silu(bf_lo(zh)); y.w = (y4.w + x4.w * Dh) * fast_silu(bf_hi(zh));
            const float ss = wave_sum((y.x * y.x + y.y * y.y) + (y.z * y.z + y.w * y.w));
            const float r = 1.f / sqrtf(ss * (1.f / 256.f) + EPS);
            const f32x4 o = (y * r) * nw;
            *(unsigned long long*)DRYP(Z + (mbase + t0 + wave) * DM + g * 256 + ech) = (unsigned long long)pk2(o.x, o.y) | ((unsigned long long)pk2(o.z, o.w) << 32);
        }
        __syncthreads();
    }
#pragma unroll
    for (int r = 0; r < 4; ++r)
#pragma unroll
        for (int q = 0; q < 4; ++q) *(f32x4*)(nst + (size_t)(pg + 16 * r) * 128 + 16 * nseg + 4 * q) = (f32x4){s[r][4 * q], s[r][4 * q + 1], s[r][4 * q + 2], s[r][4 * q + 3]};
    { float* oc = F.out + (size_t)M * DM + (size_t)DEPTH * NB_P * 16 * 8192
                  + (prm ? (size_t)0 : (size_t)DEPTH * NB_P * 3 * DXBC + (size_t)DEPTH * NB_P * 2 * DM + (size_t)DEPTH * NB_S * 16 * 8192)
                  + ((size_t)layer * (prm ? NB_P : NB_S) + sq) * 3 * DXBC + chan;
      oc[0] = w0; oc[DXBC] = w1; oc[2 * DXBC] = w2; }
}

constexpr int XT_OFF = 0, SPITCH = 272, BM_OFF = 256 * SPITCH, CM_OFF = BM_OFF + 128 * SPITCH, ACUM_OFF = CM_OFF + 128 * SPITCH,
              DTV_OFF = ACUM_OFF + 2048, SCL_OFF = DTV_OFF + 2048, RED_OFF = SCL_OFF + 2048, SSD_LDS_END = RED_OFF + 2048;
static_assert(SSD_LDS_END <= LDSCTL_OFF, "ssd LDS image");
typedef float f32x16 __attribute__((ext_vector_type(16)));
typedef short s16x4 __attribute__((ext_vector_type(4)));
typedef float f32x2_t __attribute__((ext_vector_type(2))); typedef __bf16 bf16x2_t __attribute__((ext_vector_type(2)));
__device__ __forceinline__ unsigned cvtpk(float lo, float hi) { f32x2_t v = {lo, hi}; bf16x2_t b = __builtin_convertvector(v, bf16x2_t); return __builtin_bit_cast(unsigned, b); }
__device__ __forceinline__ bf16x8 pack8(float a0, float a1, float a2, float a3, float a4, float a5, float a6, float a7) {
    v4u w; w.x = cvtpk(a0, a1); w.y = cvtpk(a2, a3); w.z = cvtpk(a4, a5); w.w = cvtpk(a6, a7); return __builtin_bit_cast(bf16x8, w); }
__device__ __forceinline__ int crow(int reg, int h) { return (reg & 3) + 8 * (reg >> 2) + 4 * h; }
#define MFMA32(a, b, c) __builtin_amdgcn_mfma_f32_32x32x16_bf16((a), (b), (c), 0, 0, 0)

template <bool S1> __device__ __forceinline__ void ssd_stage(Frame& F, int layer, int b, int c, int g) {
    const int tid = F.tid, lane = F.lane, wave = F.wave;
    const size_t m0 = (size_t)b * SEQ_P + (size_t)c * 128;
    LAS float* acum = (LAS float*)(F.lds + ACUM_OFF); LAS float* dtv = (LAS float*)(F.lds + DTV_OFF); LAS float* scl = (LAS float*)(F.lds + SCL_OFF);
    const float* DT = (const float*)(F.ws + WS_DT);
    float d0 = 0.f, d1 = 0.f, a_dt = 0.f;
    if (wave < 4) { a_dt = -__expf(in_ptr(20)[layer * 16 + g * 4 + wave]); d0 = DT[(m0 + 2 * lane) * 16 + g * 4 + wave]; d1 = DT[(m0 + 2 * lane + 1) * 16 + g * 4 + wave]; }
    {
        const bool xrole = wave < 4;
        int cgl, seg; bool active = true;
        if (xrole) { cgl = lane & 31; seg = 2 * wave + (lane >> 5); }
        else if (S1) { cgl = lane & 15; seg = 4 * (wave - 4) + (lane >> 4); active = wave < 6; }
        else { cgl = lane & 31; seg = 2 * (wave - 4) + (lane >> 5); }
        const int bccol = (cgl < 16 ? g * 128 + 8 * cgl : 512 + g * 128 + 8 * (cgl - 16));
        const unsigned char* sbase = (const unsigned char*)proj_ptr(F, xrole ? PT_XS : PT_BC);
        const int chan = xrole ? g * 256 + 8 * cgl : 1024 + bccol;
        const unsigned soff = (unsigned)(((int)m0 + 16 * seg - 3) * DM + (xrole ? g * 256 + 8 * cgl : bccol)) * 2u;
        const bool seq_start = (c == 0 && seg == 0); const unsigned halo_msk = seq_start ? 0u : 0xffffffffu; const int halo_skip = seq_start ? 3 : 0;
        v4u P[19]; float cwf[4][8], cbf[8];
        if (active) {
#pragma unroll
            for (int i = 0; i < 19; ++i) P[i] = *(const v4u*)(sbase + (soff + (unsigned)(i < 3 ? i + halo_skip : i) * 2048u));
#pragma unroll
            for (int i = 0; i < 3; ++i) { P[i].x &= halo_msk; P[i].y &= halo_msk; P[i].z &= halo_msk; P[i].w &= halo_msk; }
            { const float* cwp = in_ptr(17) + (size_t)layer * 4 * DXBC + chan;
#pragma unroll
              for (int k = 0; k < 4; ++k) { const f32x4 a = *(const f32x4*)(cwp + (size_t)k * DXBC), bq = *(const f32x4*)(cwp + (size_t)k * DXBC + 4);
                  cwf[k][0] = a.x; cwf[k][1] = a.y; cwf[k][2] = a.z; cwf[k][3] = a.w; cwf[k][4] = bq.x; cwf[k][5] = bq.y; cwf[k][6] = bq.z; cwf[k][7] = bq.w; }
              const float* cbp = in_ptr(18) + (size_t)layer * DXBC + chan; const f32x4 a = *(const f32x4*)cbp, bq = *(const f32x4*)(cbp + 4);
              cbf[0] = a.x; cbf[1] = a.y; cbf[2] = a.z; cbf[3] = a.w; cbf[4] = bq.x; cbf[5] = bq.y; cbf[6] = bq.z; cbf[7] = bq.w; }
        }
        if (wave < 4) {
            const int hh = wave; const float a = a_dt;
            const float v0 = d0 * a, v1 = d1 * a; const float s = v0 + v1; float sc = s;
#pragma unroll
            for (int o = 1; o < 64; o <<= 1) { const float u = __shfl_up(sc, o); if (lane >= o) sc += u; }
            const float ex = sc - s, a0 = ex + v0, a1 = ex + s, tot = __shfl(sc, 63);
            dtv[hh * 128 + 2 * lane] = d0; dtv[hh * 128 + 2 * lane + 1] = d1;
            acum[hh * 128 + 2 * lane] = a0; acum[hh * 128 + 2 * lane + 1] = a1;
            if (S1) { scl[hh * 128 + 2 * lane] = d0 * __expf(tot - a0); scl[hh * 128 + 2 * lane + 1] = d1 * __expf(tot - a1);
                if (lane == 0) ((float*)(F.ws + WS_CD))[(b * 16 + c) * 16 + g * 4 + hh] = __expf(tot); } }
        if (S1) __syncthreads();
        if (active) {
#define XV(i, e) ((((e) & 1) ? bf_hi(P[(i)][(e) >> 1]) : bf_lo(P[(i)][(e) >> 1])))
#define CONV(tt, e) fast_silu(cwf[0][e] * XV(tt, e) + cwf[1][e] * XV((tt) + 1, e) + cwf[2][e] * XV((tt) + 2, e) + cwf[3][e] * XV((tt) + 3, e) + cbf[e])
            if (xrole || S1) {
                LAS unsigned char* dst = F.lds + (xrole ? XT_OFF : BM_OFF) + (8 * cgl) * SPITCH + 32 * seg;
                float sc[16];
                if (S1 && xrole) { const LAS float* sp4 = scl + (cgl >> 3) * 128 + 16 * seg;
#pragma unroll
                    for (int q = 0; q < 4; ++q) { const f32x4 t4 = *(const LAS f32x4*)(sp4 + 4 * q); sc[4 * q] = t4.x; sc[4 * q + 1] = t4.y; sc[4 * q + 2] = t4.z; sc[4 * q + 3] = t4.w; } }
#pragma unroll
                for (int e = 0; e < 8; ++e) { float o[16];
#pragma unroll
                    for (int tt = 0; tt < 16; ++tt) { o[tt] = CONV(tt, e); if (S1 && xrole) o[tt] *= sc[tt]; }
                    *(LAS bf16x8*)(dst + e * SPITCH) = pack8(o[0], o[1], o[2], o[3], o[4], o[5], o[6], o[7]);
                    *(LAS bf16x8*)(dst + e * SPITCH + 16) = pack8(o[8], o[9], o[10], o[11], o[12], o[13], o[14], o[15]); }
            } else {
                LAS unsigned char* dst = F.lds + (cgl < 16 ? BM_OFF + 16 * cgl : CM_OFF + 16 * (cgl - 16)) + (16 * seg) * SPITCH;
#pragma unroll
                for (int tt = 0; tt < 16; ++tt) { float o[8];
#pragma unroll
                    for (int e = 0; e < 8; ++e) o[e] = CONV(tt, e);
                    *(LAS bf16x8*)(dst + tt * SPITCH) = pack8(o[0], o[1], o[2], o[3], o[4], o[5], o[6], o[7]); }
            }
            if (!S1 && c == 15 && seg == 7) {
                float* oc = F.out + (size_t)M * DM + (size_t)DEPTH * NB_P * 16 * 8192 + ((size_t)layer * NB_P + b) * 3 * DXBC + chan;
#pragma unroll
                for (int k = 0; k < 3; ++k) { const v4u w = P[16 + k];
                    *(f32x4*)(oc + (size_t)k * DXBC) = (f32x4){bf_lo(w.x), bf_hi(w.x), bf_lo(w.y), bf_hi(w.y)}; *(f32x4*)(oc + (size_t)k * DXBC + 4) = (f32x4){bf_lo(w.z), bf_hi(w.z), bf_lo(w.w), bf_hi(w.w)}; }
            }
#undef XV
#undef CONV
        }
    }
    __syncthreads();
}

__device__ __forceinline__ void ssd_s1_unit(Frame& F, int layer, int b, int c, int g) {
    frame_refresh(F);
    ssd_stage<true>(F, layer, b, c, g);
    const int lane = F.lane, wave = F.wave, hh = wave >> 1, ph = wave & 1, r = lane & 31, h = lane >> 5;
    f32x16 acc[4];
#pragma unroll
    for (int nt = 0; nt < 4; ++nt)
#pragma unroll
        for (int i = 0; i < 16; ++i) acc[nt][i] = 0.f;
    const LAS unsigned char* ap = F.lds + XT_OFF + (hh * 64 + ph * 32 + r) * SPITCH + h * 16;
    const LAS unsigned char* bp = F.lds + BM_OFF + r * SPITCH + h * 16;
#pragma unroll
    for (int ks = 0; ks < 8; ++ks) { const bf16x8 a = *(const LAS bf16x8*)(ap + ks * 32);
#pragma unroll
        for (int nt = 0; nt < 4; ++nt) { const bf16x8 bb = *(const LAS bf16x8*)(bp + nt * 32 * SPITCH + ks * 32); acc[nt] = MFMA32(a, bb, acc[nt]); } }
    __syncthreads();
    {   LAS float* simg = (LAS float*)(F.lds) + wave * (32 * 132);
#pragma unroll
        for (int nt = 0; nt < 4; ++nt)
#pragma unroll
            for (int i = 0; i < 16; ++i) simg[crow(i, h) * 132 + nt * 32 + r] = acc[nt][i];
        v4u* st = (v4u*)((bf16*)(F.ws + WS_S) + ((size_t)(b * 16 + c) * 16 + g * 4 + hh) * 8192 + (size_t)(ph * 32) * 128);
#pragma unroll
        for (int i = 0; i < 8; ++i) { const int idx = i * 64 + lane; const LAS float* sp = simg + (idx >> 4) * 132 + (idx & 15) * 8; const f32x4 v0 = *(const LAS f32x4*)sp, v1 = *(const LAS f32x4*)(sp + 4);
            v4u w; w.x = cvtpk(v0.x, v0.y); w.y = cvtpk(v0.z, v0.w); w.z = cvtpk(v1.x, v1.y); w.w = cvtpk(v1.z, v1.w); st[idx] = w; } }
    __syncthreads();
}

__device__ __forceinline__ void ssd_s2_phase(Frame& F, int layer) {
    frame_refresh(F);
    const int it = F.vcu * (NWAVES * 64) + F.tid;
    const v4u* ST = (const v4u*)(F.ws + WS_S); const float* CD = (const float*)(F.ws + WS_CD); v4u* SB16 = (v4u*)(F.ws + WS_H);
    f32x4* o = (f32x4*)(F.out + (size_t)M * DM + (size_t)layer * NB_P * 16 * 8192);
    static_assert(NB_P * 16 * 1024 == GRID * NWAVES * 64, "one item per thread");
    const int q = it & 1023, head = (it >> 10) & 15, b = it >> 14;
    v4u v[16];
#pragma unroll
    for (int c = 0; c < 16; ++c) v[c] = ST[((size_t)(b * 16 + c) * 16 + head) * 1024 + q];
    float z0 = 0.f; asm volatile("" : "+v"(z0));
    f32x4 c0 = {z0, z0, z0, z0}, c1 = {z0, z0, z0, z0};
#pragma unroll
    for (int c = 0; c < 16; ++c) { const float d = CD[(b * 16 + c) * 16 + head];
        v4u w; w.x = pk2(c0.x, c0.y); w.y = pk2(c0.z, c0.w); w.z = pk2(c1.x, c1.y); w.w = pk2(c1.z, c1.w);
        SB16[((size_t)(b * 16 + c) * 16 + head) * 1024 + q] = w;
        c0 = c0 * d + (f32x4){bf_lo(v[c].x), bf_hi(v[c].x), bf_lo(v[c].y), bf_hi(v[c].y)}; c1 = c1 * d + (f32x4){bf_lo(v[c].z), bf_hi(v[c].z), bf_lo(v[c].w), bf_hi(v[c].w)}; }
    o[((size_t)b * 16 + head) * 2048 + 2 * q] = c0; o[((size_t)b * 16 + head) * 2048 + 2 * q + 1] = c1;
}

__device__ __forceinline__ void ssd_s3_unit(Frame& F, int layer, int b, int c, int g, bool first, const XcdBarrier& bar, unsigned* bar2, unsigned gen) {
    frame_refresh(F);
#ifdef DUP_STG
    ssd_stage<false>(F, layer, b, c, g);
#endif
    ssd_stage<false>(F, layer, b, c, g);
    if (first) xcd_wait(bar, bar2, gen);
    bf16x8 sfr[8][2];
    {   const int hh_ = F.wave >> 1, r_ = F.lane & 31, h_ = F.lane >> 5;
        const bf16* sb = (const bf16*)(F.ws + WS_H) + ((size_t)(b * 16 + c) * 16 + g * 4 + hh_) * 8192 + (size_t)r_ * 128 + 8 * h_;
#pragma unroll
        for (int ks = 0; ks < 8; ++ks)
#pragma unroll
            for (int pt = 0; pt < 2; ++pt) sfr[ks][pt] = *(const bf16x8*)(sb + pt * 32 * 128 + 16 * ks); }
    const int lane = F.lane, wave = F.wave, hh = wave >> 1, lh = wave & 1, r = lane & 31, h = lane >> 5, head = g * 4 + hh;
    const int LT0 = lh, LT1 = 3 - lh;
#define LTILE(lt) ((lt) == 0 ? LT0 : LT1)
    const size_t m0 = (size_t)b * SEQ_P + (size_t)c * 128;
    const LAS float* ac = (const LAS float*)(F.lds + ACUM_OFF) + hh * 128; const LAS float* dv = (const LAS float*)(F.lds + DTV_OFF) + hh * 128;
    f32x16 y[2][2];
#pragma unroll
    for (int lt = 0; lt < 2; ++lt)
#pragma unroll
        for (int pt = 0; pt < 2; ++pt)
#pragma unroll
            for (int i = 0; i < 16; ++i) y[lt][pt][i] = 0.f;
    unsigned long long zw[16];
    const unsigned char* zbase = (const unsigned char*)proj_ptr(F, PT_Z);
    const unsigned zoff0 = (unsigned)(((int)m0 + wave) * DM + g * 256 + lane * 4) * 2u;
    {
#pragma unroll
        for (int k = 0; k < 16; ++k) zw[k] = *(const unsigned long long*)(zbase + (zoff0 + (unsigned)k * (8u * DM * 2u))); }
    {
#pragma unroll
        for (int ks = 0; ks < 8; ++ks) {
#pragma unroll
            for (int lt = 0; lt < 2; ++lt) { const bf16x8 a = *(const LAS bf16x8*)(F.lds + CM_OFF + (32 * LTILE(lt) + r) * SPITCH + 32 * ks + 16 * h);
#pragma unroll
                for (int pt = 0; pt < 2; ++pt) y[lt][pt] = MFMA32(a, sfr[ks][pt], y[lt][pt]); }
        }
#pragma unroll
        for (int lt = 0; lt < 2; ++lt)
#pragma unroll
            for (int i = 0; i < 16; ++i) { const float e = __expf(ac[32 * LTILE(lt) + crow(i, h)]); y[lt][0][i] *= e; y[lt][1][i] *= e; }
    }
#pragma unroll
    for (int lt = 0; lt < 2; ++lt) { const int L = LTILE(lt); const float al = ac[32 * L + r];
#pragma unroll 1
        for (int S = 0; S <= L; ++S) {
            f32x16 xt;
#pragma unroll
            for (int i = 0; i < 16; ++i) xt[i] = 0.f;
#pragma unroll
            for (int ks = 0; ks < 8; ++ks) { const bf16x8 a = *(const LAS bf16x8*)(F.lds + BM_OFF + (32 * S + r) * SPITCH + 32 * ks + 16 * h);
                const bf16x8 bb = *(const LAS bf16x8*)(F.lds + CM_OFF + (32 * L + r) * SPITCH + 32 * ks + 16 * h); xt = MFMA32(a, bb, xt); }
#pragma unroll
            for (int gq = 0; gq < 4; ++gq) { const f32x4 as4 = *(const LAS f32x4*)(ac + 32 * S + 8 * gq + 4 * h), ds4 = *(const LAS f32x4*)(dv + 32 * S + 8 * gq + 4 * h);
#pragma unroll
                for (int i = 0; i < 4; ++i) { const float arg = fminf(al - as4[i], 0.f); float val = xt[4 * gq + i] * __expf(arg) * ds4[i];
                    if (S == L && (8 * gq + 4 * h + i) > r) val = 0.f; xt[4 * gq + i] = val; } }
#pragma unroll
            for (int k2 = 0; k2 < 2; ++k2) { const bf16x8 aop = pack8(xt[8 * k2], xt[8 * k2 + 1], xt[8 * k2 + 2], xt[8 * k2 + 3], xt[8 * k2 + 4], xt[8 * k2 + 5], xt[8 * k2 + 6], xt[8 * k2 + 7]);
#pragma unroll
                for (int pt = 0; pt < 2; ++pt) { const LAS unsigned char* xp = F.lds + XT_OFF + (hh * 64 + 32 * pt + r) * SPITCH + (32 * S + 16 * k2 + 4 * h) * 2;
                    const s16x4 lo = *(const LAS s16x4*)xp, hi = *(const LAS s16x4*)(xp + 16);
                    const bf16x8 bop = __builtin_shufflevector(lo, hi, 0, 1, 2, 3, 4, 5, 6, 7);
                    y[lt][pt] = MFMA32(aop, bop, y[lt][pt]); } }
        }
    }
    {   const float Dh = in_ptr(21)[layer * 16 + head];
#pragma unroll
        for (int lt = 0; lt < 2; ++lt)
#pragma unroll
            for (int gq = 0; gq < 4; ++gq)
#pragma unroll
                for (int pt = 0; pt < 2; ++pt) { const s16x4 xv = *(const LAS s16x4*)(F.lds + XT_OFF + (hh * 64 + 32 * pt + r) * SPITCH + (32 * LTILE(lt) + 8 * gq + 4 * h) * 2);
#pragma unroll
                    for (int i = 0; i < 4; ++i) y[lt][pt][4 * gq + i] += bf2f((bf16)xv[i]) * Dh; }
    }
    __syncthreads();
    constexpr int YPITCH = 1040;
#pragma unroll
    for (int lt = 0; lt < 2; ++lt)
#pragma unroll
        for (int pt = 0; pt < 2; ++pt)
#pragma unroll
            for (int i = 0; i < 16; ++i) *(LAS float*)(F.lds + (32 * LTILE(lt) + crow(i, h)) * YPITCH + (hh * 64 + 32 * pt + r) * 4) = y[lt][pt][i];
    __syncthreads();
    {   const int ech = lane * 4; const f32x4 nw = *(const f32x4*)(in_ptr(22) + (size_t)layer * DM + g * 256 + ech);
        unsigned zo = zoff0; asm volatile("" : "+v"(zo));
#pragma unroll
        for (int k = 0; k < 16; ++k) { const int l = wave + 8 * k;
            const f32x4 y4 = *(const LAS f32x4*)(F.lds + l * YPITCH + ech * 4);
            const unsigned zl = (unsigned)zw[k], zh = (unsigned)(zw[k] >> 32);
            f32x4 yv;
            yv.x = y4.x * fast_silu(bf_lo(zl)); yv.y = y4.y * fast_silu(bf_hi(zl)); yv.z = y4.z * fast_silu(bf_lo(zh)); yv.w = y4.w * fast_silu(bf_hi(zh));
            const float ss = wave_sum((yv.x * yv.x + yv.y * yv.y) + (yv.z * yv.z + yv.w * yv.w));
            const float rr = 1.f / sqrtf(ss * (1.f / 256.f) + EPS);
            const f32x4 o = (yv * rr) * nw;
            *(unsigned long long*)((unsigned char*)zbase + (zo + (unsigned)k * (8u * DM * 2u))) = (unsigned long long)pk2(o.x, o.y) | ((unsigned long long)pk2(o.z, o.w) << 32); }
    }
    __syncthreads();
#undef LTILE
}
__device__ __forceinline__ void ssd_sample_unit(Frame& F, int layer, int sq, int g) {
    frame_refresh(F);
    const int tid = F.tid, lane = F.lane, wave = F.wave;
    const size_t mbase = (size_t)MP + (size_t)sq * SEQ_S;
    LAS float* cv = (LAS float*)(F.lds); LAS float* ybuf = (LAS float*)(F.lds + 16384); LAS float* dts = (LAS float*)(F.lds + 24576); LAS float* acs = (LAS float*)(F.lds + 24704);
    const bf16* src; int col, chan;
    if (tid < 256) { src = proj_ptr(F, PT_XS); col = g * 256 + tid; chan = col; }
    else if (tid < 384) { src = proj_ptr(F, PT_BC); col = g * 128 + (tid - 256); chan = 1024 + col; }
    else { src = proj_ptr(F, PT_BC); col = 512 + g * 128 + (tid - 384); chan = 1024 + col; }
    float pre[8];
#pragma unroll
    for (int j = 0; j < 8; ++j) pre[j] = bf2f(src[(mbase + j) * DM + col]);
    const float* cwp = in_ptr(17) + (size_t)layer * 4 * DXBC + chan;
    const float cw0 = cwp[0], cw1 = cwp[DXBC], cw2 = cwp[2 * DXBC], cw3 = cwp[3 * DXBC], cb = in_ptr(18)[(size_t)layer * DXBC + chan];
    float w0, w1, w2;
    { const float* cs = in_ptr(5) + ((size_t)layer * NB_S + sq) * 3 * DXBC + chan; w0 = cs[0]; w1 = cs[DXBC]; w2 = cs[2 * DXBC]; }
    bf16* Z = proj_ptr(F, PT_Z);
    const int ech = lane * 4;
    const unsigned long long zw = *(const unsigned long long*)(Z + (mbase + wave) * DM + g * 256 + ech);
    const float Dh = in_ptr(21)[layer * 16 + g * 4 + (ech >> 6)];
    const f32x4 nw = *(const f32x4*)(in_ptr(22) + (size_t)layer * DM + g * 256 + ech);
    f32x4 sv[16];
    { const f32x4* sp = (const f32x4*)(in_ptr(4) + (((size_t)layer * NB_S + sq) * 16 + g * 4 + (wave >> 1)) * 8192 + (size_t)(32 * (wave & 1)) * 128);
#pragma unroll
      for (int i = 0; i < 16; ++i) sv[i] = sp[i * 64 + lane]; }
    if (tid < 32) {
        const float d = ((const float*)(F.ws + WS_DT))[(mbase + (tid >> 2)) * 16 + g * 4 + (tid & 3)]; const float an = -__expf(in_ptr(20)[layer * 16 + g * 4 + (tid & 3)]);
        float v = d * an;
#pragma unroll
        for (int o = 4; o < 32; o <<= 1) { const float u = __shfl_up(v, o); if (lane >= o) v += u; }
        dts[tid] = d; acs[tid] = v; }
#pragma unroll
    for (int j = 0; j < 8; ++j) { const float v = cw0 * w0 + cw1 * w1 + cw2 * w2 + cw3 * pre[j] + cb; w0 = w1; w1 = w2; w2 = pre[j]; cv[j * 512 + tid] = fast_silu(v); }
    {
        float* oc = F.out + (size_t)M * DM + (size_t)DEPTH * NB_P * 16 * 8192 + (size_t)DEPTH * NB_P * 3 * DXBC + (size_t)DEPTH * NB_P * 2 * DM + (size_t)DEPTH * NB_S * 16 * 8192
                    + ((size_t)layer * NB_S + sq) * 3 * DXBC + chan;
        oc[0] = w0; oc[DXBC] = w1; oc[2 * DXBC] = w2; }
    __syncthreads();
    {
        const int hh = wave >> 1, ph = wave & 1, r = lane & 31, h = lane >> 5, head = g * 4 + hh;
        float* SN = F.out + (size_t)M * DM + (size_t)DEPTH * NB_P * 16 * 8192 + (size_t)DEPTH * NB_P * 3 * DXBC + (size_t)DEPTH * NB_P * 2 * DM + (((size_t)layer * NB_S + sq) * 16 + head) * 8192 + (size_t)(32 * ph) * 128;
        const float ac8 = acs[7 * 4 + hh], A8 = __expf(ac8);
        LAS float* simg = (LAS float*)(F.lds + 25088) + wave * (32 * 132);
#pragma unroll
        for (int i = 0; i < 16; ++i) { const int idx = i * 64 + lane; *(LAS f32x4*)(simg + (idx >> 5) * 132 + (idx & 31) * 4) = sv[i]; }
        f32x16 acc[4];
#pragma unroll
        for (int nt = 0; nt < 4; ++nt)
#pragma unroll
            for (int q = 0; q < 16; ++q) acc[nt][q] = simg[crow(q, h) * 132 + 32 * nt + r];
        bf16x8 cfr[8];
#pragma unroll
        for (int ks = 0; ks < 8; ++ks) { const LAS float* cp = cv + (r & 7) * 512 + 384 + 16 * ks + 8 * h; const f32x4 c0 = *(const LAS f32x4*)cp, c1 = *(const LAS f32x4*)(cp + 4);
            const float mk = r < 8 ? 1.f : 0.f; cfr[ks] = pack8(c0.x * mk, c0.y * mk, c0.z * mk, c0.w * mk, c1.x * mk, c1.y * mk, c1.z * mk, c1.w * mk); }
        f32x16 yo;
#pragma unroll
        for (int q = 0; q < 16; ++q) yo[q] = 0.f;
#pragma unroll
        for (int ks = 0; ks < 8; ++ks) { const LAS float* sp = simg + r * 132 + 16 * ks + 8 * h; const f32x4 v0 = *(const LAS f32x4*)sp, v1 = *(const LAS f32x4*)(sp + 4);
            yo = MFMA32(cfr[ks], pack8(v0.x, v0.y, v0.z, v0.w, v1.x, v1.y, v1.z, v1.w), yo); }
#pragma unroll
        for (int q = 0; q < 4; ++q) yo[q] *= __expf(acs[(4 * h + q) * 4 + hh]);
        {
            float xa[8];
#pragma unroll
            for (int j = 0; j < 8; ++j) xa[j] = h == 0 ? cv[j * 512 + hh * 64 + 32 * ph + r] * dts[j * 4 + hh] * __expf(ac8 - acs[j * 4 + hh]) : 0.f;
            const bf16x8 xop = pack8(xa[0], xa[1], xa[2], xa[3], xa[4], xa[5], xa[6], xa[7]);
#pragma unroll
            for (int nt = 0; nt < 4; ++nt) { float bv[8];
#pragma unroll
                for (int j = 0; j < 8; ++j) bv[j] = h == 0 ? cv[j * 512 + 256 + 32 * nt + r] : 0.f;
#pragma unroll
                for (int q = 0; q < 16; ++q) acc[nt][q] *= A8;
                acc[nt] = MFMA32(xop, pack8(bv[0], bv[1], bv[2], bv[3], bv[4], bv[5], bv[6], bv[7]), acc[nt]);
#pragma unroll
                for (int q = 0; q < 16; ++q) simg[crow(q, h) * 132 + 32 * nt + r] = acc[nt][q]; }
#pragma unroll
            for (int i = 0; i < 16; ++i) { const int idx = i * 64 + lane; ((f32x4*)SN)[idx] = *(const LAS f32x4*)(simg + (idx >> 5) * 132 + (idx & 31) * 4); }
        }
        {
            f32x16 xt;
#pragma unroll
            for (int q = 0; q < 16; ++q) xt[q] = 0.f;
#pragma unroll
            for (int ks = 0; ks < 8; ++ks) { const LAS float* bp = cv + (r & 7) * 512 + 256 + 16 * ks + 8 * h; const f32x4 b0 = *(const LAS f32x4*)bp, b1 = *(const LAS f32x4*)(bp + 4);
                const float mk = r < 8 ? 1.f : 0.f; xt = MFMA32(pack8(b0.x * mk, b0.y * mk, b0.z * mk, b0.w * mk, b1.x * mk, b1.y * mk, b1.z * mk, b1.w * mk), cfr[ks], xt); }
            const int t = r & 7; const float at = acs[t * 4 + hh];
            float mv[4];
#pragma unroll
            for (int q = 0; q < 4; ++q) { const int sidx = 4 * h + q; const float arg = fminf(at - acs[sidx * 4 + hh], 0.f); mv[q] = (sidx <= t && r < 8) ? xt[q] * __expf(arg) * dts[sidx * 4 + hh] : 0.f; }
            const bf16x8 aop = pack8(mv[0], mv[1], mv[2], mv[3], 0.f, 0.f, 0.f, 0.f);
            float xs[4];
#pragma unroll
            for (int q = 0; q < 4; ++q) xs[q] = cv[(4 * h + q) * 512 + hh * 64 + 32 * ph + r];
            yo = MFMA32(aop, pack8(xs[0], xs[1], xs[2], xs[3], 0.f, 0.f, 0.f, 0.f), yo);
        }
#pragma unroll
        for (int q = 0; q < 4; ++q) ybuf[(4 * h + q) * 256 + hh * 64 + 32 * ph + r] = yo[q];
    }
    __syncthreads();
    {
        const f32x4 y4 = *(const LAS f32x4*)(ybuf + wave * 256 + ech), x4 = *(const LAS f32x4*)(cv + wave * 512 + ech);
        const unsigned zl = (unsigned)zw, zh = (unsigned)(zw >> 32);
        f32x4 y;
        y.x = (y4.x + x4.x * Dh) * fast_silu(bf_lo(zl)); y.y = (y4.y + x4.y * Dh) * fast_silu(bf_hi(zl));
        y.z = (y4.z + x4.z * Dh) * fast_silu(bf_lo(zh)); y.w = (y4.w + x4.w * Dh) * fast_silu(bf_hi(zh));
        const float ss = wave_sum((y.x * y.x + y.y * y.y) + (y.z * y.z + y.w * y.w));
        const float rr = 1.f / sqrtf(ss * (1.f / 256.f) + EPS);
        const f32x4 o = (y * rr) * nw;
        *(unsigned long long*)(Z + (mbase + wave) * DM + g * 256 + ech) = (unsigned long long)pk2(o.x, o.y) | ((unsigned long long)pk2(o.z, o.w) << 32);
    }
    __syncthreads();
}
__device__ __forceinline__ void ssd_s1_phase(Frame& F, int layer, const XcdBarrier& bar, unsigned* bar2, unsigned gen) {
    frame_refresh(F);
#ifdef DUP_S1P
    for (int u = F.vcu; u < 512; u += GRID) ssd_s1_unit(F, layer, u >> 6, (u >> 2) & 15, u & 3);
#endif
  {
    for (int u = F.vcu; u < 512; u += GRID) ssd_s1_unit(F, layer, u >> 6, (u >> 2) & 15, u & 3);
    xcd_arrive(bar, bar2);
    for (int u = F.vcu; u < NB_S * 4; u += GRID) ssd_sample_unit(F, layer, u >> 2, u & 3);
    xcd_wait(bar, bar2, gen);
  }
}
__device__ __forceinline__ void ssd_s3_phase(Frame& F, int layer, const XcdBarrier& bar, unsigned* bar2, unsigned gen) {
    frame_refresh(F);
  {
    for (int u = F.vcu; u < 512; u += GRID) ssd_s3_unit(F, layer, u >> 6, (u >> 2) & 15, u & 3, u < GRID, bar, bar2, gen);
  }
}

template <class Epi> __device__ __forceinline__ void sgemm64(Frame& F, const bf16* A  , const bf16* Bt, int K, const Epi& E) {
    constexpr int KC = 256, PITCH = 528, HBUF = 64 * PITCH, BUF = 2 * HBUF;
    static_assert(2 * BUF <= LDSCTL_OFF && 8 * 16384 <= 2 * BUF, "sgemm64 LDS");
    const int tid = F.tid, lane = F.lane, wave = F.wave, r = lane & 31, h = lane >> 5;
    const int tile = F.vcu & 255, rb = tile >> 4, cb = tile & 15;
    const int nch = K / KC, lrow = tid >> 5, lseg = tid & 31;
    const bf16* ag = A + (size_t)(rb * 64 + lrow) * K + lseg * 8; const bf16* bg = Bt + (size_t)(cb * 64 + lrow) * K + lseg * 8;
    LAS unsigned char* lw = F.lds + lrow * PITCH + lseg * 16;
    const LAS unsigned char* lr = F.lds + r * PITCH + (2 * wave) * 32 + 16 * h;
    v4u ra[4], rbv[4];
#pragma unroll
    for (int i = 0; i < 4; ++i) { ra[i] = *(const v4u*)(ag + (size_t)(16 * i) * K); rbv[i] = *(const v4u*)(bg + (size_t)(16 * i) * K); }
#pragma unroll
    for (int i = 0; i < 4; ++i) { *(LAS v4u*)(lw + 16 * i * PITCH) = ra[i]; *(LAS v4u*)(lw + HBUF + 16 * i * PITCH) = rbv[i]; }
    __syncthreads();
    f32x16 acc[2][2];
#pragma unroll
    for (int i = 0; i < 2; ++i)
#pragma unroll
        for (int j = 0; j < 2; ++j)
#pragma unroll
            for (int q = 0; q < 16; ++q) acc[i][j][q] = 0.f;
#pragma unroll 1
    for (int ch = 0; ch < nch; ++ch) {
        const bool more = ch + 1 < nch;
        if (more) {
#pragma unroll
            for (int i = 0; i < 4; ++i) { ra[i] = *(const v4u*)(ag + (size_t)(16 * i) * K + (ch + 1) * KC); rbv[i] = *(const v4u*)(bg + (size_t)(16 * i) * K + (ch + 1) * KC); } }
        const LAS unsigned char* cur = lr + (ch & 1) * BUF;
#pragma unroll
        for (int q = 0; q < 2; ++q) {
            const bf16x8 a0 = *(const LAS bf16x8*)(cur + q * 32), a1 = *(const LAS bf16x8*)(cur + 32 * PITCH + q * 32);
            const bf16x8 b0 = *(const LAS bf16x8*)(cur + HBUF + q * 32), b1 = *(const LAS bf16x8*)(cur + HBUF + 32 * PITCH + q * 32);
            acc[0][0] = MFMA32(a0, b0, acc[0][0]); acc[0][1] = MFMA32(a0, b1, acc[0][1]);
            acc[1][0] = MFMA32(a1, b0, acc[1][0]); acc[1][1] = MFMA32(a1, b1, acc[1][1]); }
        if (more) { LAS unsigned char* nx = lw + ((ch + 1) & 1) * BUF;
#pragma unroll
            for (int i = 0; i < 4; ++i) { *(LAS v4u*)(nx + 16 * i * PITCH) = ra[i]; *(LAS v4u*)(nx + HBUF + 16 * i * PITCH) = rbv[i]; } }
        __syncthreads();
    }
    {   LAS float* part = (LAS float*)(F.lds) + wave * 4096;
#pragma unroll
        for (int i = 0; i < 2; ++i)
#pragma unroll
            for (int j = 0; j < 2; ++j)
#pragma unroll
                for (int q = 0; q < 16; ++q) part[(32 * i + crow(q, h)) * 64 + 32 * j + r] = acc[i][j][q];
    }
    __syncthreads();
    {   const int row = tid >> 3, c8 = (tid & 7) * 8;
        float v[8];
#pragma unroll
        for (int q = 0; q < 8; ++q) v[q] = 0.f;
#pragma unroll
        for (int w = 0; w < 8; ++w) { const LAS float* p = (const LAS float*)(F.lds) + w * 4096 + row * 64 + c8; const f32x4 x0 = *(const LAS f32x4*)p, x1 = *(const LAS f32x4*)(p + 4);
            v[0] += x0.x; v[1] += x0.y; v[2] += x0.z; v[3] += x0.w; v[4] += x1.x; v[5] += x1.y; v[6] += x1.z; v[7] += x1.w; }
        E(MP + rb * 64 + row, cb * 64 + c8, v);
    }
    __syncthreads();
}
template <bool XF32> struct SEpiResidLN {
    const void* Xin; bf16* X; const float* gate; float sc;
    bf16* H; const float* GS; const float* SH; float* SSQ; unsigned* cnt;
    __device__ __forceinline__ void operator()(int m, int c, const float (&v)[8]) const {
        const int mr = mod_row(m);
        const float* gp = gate + (size_t)mr * NMOD + c;
        f32x4 x0, x1;
        if constexpr (XF32) { const float* xi = (const float*)Xin + (size_t)(m - MP) * DM + c; x0 = *(const f32x4*)xi; x1 = *(const f32x4*)(xi + 4); }
        else { const v4u xw = *(const v4u*)((const bf16*)Xin + (size_t)m * DM + c); x0 = (f32x4){bf_lo(xw.x), bf_hi(xw.x), bf_lo(xw.y), bf_hi(xw.y)}; x1 = (f32x4){bf_lo(xw.z), bf_hi(xw.z), bf_lo(xw.w), bf_hi(xw.w)}; }
        const f32x4 g0 = *(const f32x4*)gp, g1 = *(const f32x4*)(gp + 4);
        const f32x4 s0 = *(const f32x4*)(GS + (size_t)mr * DM + c), s1 = *(const f32x4*)(GS + (size_t)mr * DM + c + 4), h0 = *(const f32x4*)(SH + (size_t)mr * NMOD + c), h1 = *(const f32x4*)(SH + (size_t)mr * NMOD + c + 4);
        const f32x4 n0 = x0 + (g0 * sc) * (f32x4){v[0], v[1], v[2], v[3]}, n1 = x1 + (g1 * sc) * (f32x4){v[4], v[5], v[6], v[7]};
        { v4u w; w.x = pk2(n0.x, n0.y); w.y = pk2(n0.z, n0.w); w.z = pk2(n1.x, n1.y); w.w = pk2(n1.z, n1.w); *(v4u*)(X + (size_t)m * DM + c) = w; }
        float ss = ((n0.x * n0.x + n0.y * n0.y) + (n0.z * n0.z + n0.w * n0.w)) + ((n1.x * n1.x + n1.y * n1.y) + (n1.z * n1.z + n1.w * n1.w));
        ss += __shfl_xor(ss, 1); ss += __shfl_xor(ss, 2); ss += __shfl_xor(ss, 4);
        if ((threadIdx.x & 7) == 0) atomicAdd(SSQ + m, ss);
        asm volatile("s_waitcnt vmcnt(0)" ::: "memory");
        __syncthreads();
        if (threadIdx.x == 0) { unsigned* cp = cnt + 64 * ((m - MP) >> 6);
            __hip_atomic_fetch_add(cp, 1u, __ATOMIC_RELAXED, __HIP_MEMORY_SCOPE_AGENT);
            unsigned sp = 0; while (__hip_atomic_load(cp, __ATOMIC_RELAXED, __HIP_MEMORY_SCOPE_AGENT) < 16u && ++sp < (1u << 22)) __builtin_amdgcn_s_sleep(1); }
        __syncthreads();
        const float tot = __hip_atomic_load(SSQ + m, __ATOMIC_RELAXED, __HIP_MEMORY_SCOPE_AGENT);
        const float rinv = 1.f / sqrtf(tot * (1.f / DM) + EPS);
        const f32x4 a = (n0 * rinv) * s0 + h0, b = (n1 * rinv) * s1 + h1;
        v4u w; w.x = pk2(a.x, a.y); w.y = pk2(a.z, a.w); w.z = pk2(b.x, b.y); w.w = pk2(b.z, b.w); *(v4u*)(H + (size_t)m * DM + c) = w;
    }
};
template <bool FIRST> struct SEpiGate {
    bf16* T; const bf16* G;
    __device__ __forceinline__ void operator()(int m, int c, const float (&v)[8]) const {
        const size_t o = (size_t)m * DM + c; const v4u gw = *(const v4u*)(G + o);
        float r[8];
        r[0] = bf_lo(gw.x) * v[0]; r[1] = bf_hi(gw.x) * v[1]; r[2] = bf_lo(gw.y) * v[2]; r[3] = bf_hi(gw.y) * v[3];
        r[4] = bf_lo(gw.z) * v[4]; r[5] = bf_hi(gw.z) * v[5]; r[6] = bf_lo(gw.w) * v[6]; r[7] = bf_hi(gw.w) * v[7];
        if (!FIRST) { const v4u tw = *(const v4u*)(T + o);
            r[0] += bf_lo(tw.x); r[1] += bf_hi(tw.x); r[2] += bf_lo(tw.y); r[3] += bf_hi(tw.y); r[4] += bf_lo(tw.z); r[5] += bf_hi(tw.z); r[6] += bf_lo(tw.w); r[7] += bf_hi(tw.w); }
        v4u w; w.x = pk2(r[0], r[1]); w.y = pk2(r[2], r[3]); w.z = pk2(r[4], r[5]); w.w = pk2(r[6], r[7]);
        *(v4u*)(T + o) = w;
    }
};

struct SEpiFinal {
    const bf16* Xin; float* Y; const float* gate; const float* gfin; float* SSF; unsigned* cnt;
    __device__ __forceinline__ void operator()(int m, int c, const float (&v)[8]) const {
        const int mr = mod_row(m);
        const float* gp = gate + (size_t)mr * NMOD + c; const v4u xw = *(const v4u*)(Xin + (size_t)m * DM + c);
        const f32x4 g0 = *(const f32x4*)gp, g1 = *(const f32x4*)(gp + 4), x0 = (f32x4){bf_lo(xw.x), bf_hi(xw.x), bf_lo(xw.y), bf_hi(xw.y)}, x1 = (f32x4){bf_lo(xw.z), bf_hi(xw.z), bf_lo(xw.w), bf_hi(xw.w)};
        const f32x4 n0 = x0 + (g0 * 0.5f) * (f32x4){v[0], v[1], v[2], v[3]}, n1 = x1 + (g1 * 0.5f) * (f32x4){v[4], v[5], v[6], v[7]};
        float ss = ((n0.x * n0.x + n0.y * n0.y) + (n0.z * n0.z + n0.w * n0.w)) + ((n1.x * n1.x + n1.y * n1.y) + (n1.z * n1.z + n1.w * n1.w));
        ss += __shfl_xor(ss, 1); ss += __shfl_xor(ss, 2); ss += __shfl_xor(ss, 4);
        if ((threadIdx.x & 7) == 0) atomicAdd(SSF + m, ss);
        asm volatile("s_waitcnt vmcnt(0)" ::: "memory");
        __syncthreads();
        if (threadIdx.x == 0) { unsigned* cp = cnt + 64 * ((m - MP) >> 6);
            __hip_atomic_fetch_add(cp, 1u, __ATOMIC_RELAXED, __HIP_MEMORY_SCOPE_AGENT);
            unsigned sp = 0; while (__hip_atomic_load(cp, __ATOMIC_RELAXED, __HIP_MEMORY_SCOPE_AGENT) < 16u && ++sp < (1u << 22)) __builtin_amdgcn_s_sleep(1); }
        __syncthreads();
        const float tot = __hip_atomic_load(SSF + m, __ATOMIC_RELAXED, __HIP_MEMORY_SCOPE_AGENT);
        const float rinv = 1.f / sqrtf(tot * (1.f / DM) + EPS);
        const f32x4 f0 = *(const f32x4*)(gfin + c), f1 = *(const f32x4*)(gfin + c + 4);
        float* yp = Y + (size_t)m * DM + c;
        *(f32x4*)yp = (n0 * rinv) * f0; *(f32x4*)(yp + 4) = (n1 * rinv) * f1;
    }
};
#ifdef DUP_BAR
#define GRID_BAR() do { xcd_barrier(bar); xcd_barrier(bar); } while (0)
#else
#if defined(BAR3V)
#define GRID_BAR() xcd_barrier3((unsigned*)(F.ctl + 180224), F.MISC + 10, (unsigned)GRID)
#elif !defined(NO_FLATBAR)
#define GRID_BAR() xcd_barrier_flat(bar, (unsigned*)(F.ctl + 180224), F.MISC + 10)
#else
#define GRID_BAR() xcd_barrier(bar)
#endif
#endif
#ifndef PH_MASK
#define PH_MASK 0xffff
#endif
#define PH(k) (((PH_MASK) >> (k)) & 1)
#ifndef XR_ON_
#define XR_ON_ 1
#endif
constexpr bool XR_ON = XR_ON_;
#define BAR2 ((unsigned*)(F.ctl + CW_BAR + 4096))
#define BAR3 ((unsigned*)(F.ctl + CW_BAR + 8192))
#define FILL_BAR(k, gen) do { if constexpr (FILLW && l == 0) { xcd_arrive(bar, BAR2); p0_fill(F, k); xcd_wait(bar, BAR2, gen); } else GRID_BAR(); } while (0)
#define Hb ((bf16*)(F.ws + WS_H))
#define Tb ((bf16*)(F.ws + WS_S))
#define ACT ((bf16*)(F.ws + WS_P))
#define XB (proj_ptr(F, PT_SCH))

template <int LAYER> __device__ __forceinline__ void layer_fwd(Frame& F, const XcdBarrier& bar) {
    constexpr int l = LAYER;
        if (PH(3)) { frame_refresh(F); pg8::Gemm g{Hb, wt_ptr(F, l, WO_GU1), M, 2 * DFF, DM}; pg8::StaticOrder S; S.init(M, 2 * DFF, GRID, F.bx);
          pg8::EpiSwiglu E{ACT}; pg8::gemm_phase<pg8::EpiSwiglu, pg8::StaticOrder, true, true>(F.lds + RING_OFF, g, S, E);
#ifdef DUP_G1
          GRID_BAR(); pg8::gemm_phase<pg8::EpiSwiglu, pg8::StaticOrder, true, true>(F.lds + RING_OFF, g, S, E);
#endif
        }
        FILL_BAR(0, 2u);
#ifdef DUP_D1
        { frame_refresh(F); pg8::Gemm g{ACT, wt_ptr(F, l, WO_D1), MP, DM, DFF}; pg8::StaticOrder S; S.init(MP, DM, GRID, F.bx);
          pg8::EpiGate<true> E{Tb, Hb}; pg8::gemm_phase<pg8::EpiGate<true>, pg8::StaticOrder, true, true>(F.lds + RING_OFF, g, S, E); }
#endif
#ifdef DUP_K1
        { frame_refresh(F); pg8::Gemm g{Hb, wt_ptr(F, l, WO_SSD), MP, DM, DM}; pg8::StaticOrder S; S.init(MP, DM, GRID, F.bx);
          pg8::EpiGate<true> E{Tb, Hb}; pg8::gemm_phase<pg8::EpiGate<true>, pg8::StaticOrder, true, true>(F.lds + RING_OFF, g, S, E); }
#endif
#ifdef DUP_SGD
        { frame_refresh(F); SEpiGate<true> SE{Tb, Hb}; sgemm64(F, ACT + (size_t)MP * DFF, wt_ptr(F, l, WO_D1), DFF, SE); }
#endif
        if (PH(4)) { frame_refresh(F); pg8::Gemm g{ACT, wt_ptr(F, l, WO_D1), MP, DM, DFF}; pg8::StaticOrder S; S.init(MP, DM, GRID, F.bx);
          pg8::EpiResidLN<true, l == 0> E{l == 0 ? (const void*)in_ptr(0) : (const void*)XB, XB, mod_ptr(F, l, 2), in_ptr(1), Hb, gs_ptr(F, l * 3 + 1), mod_ptr(F, l, 3), ss_ptr(F, l * 3 + 1), fcnt_ptr(F, l * 3 + 1)}; pg8::gemm_phase<pg8::EpiResidLN<true, l == 0>, pg8::StaticOrder, true, true, XR_ON, MP>(F.lds + RING_OFF, g, S, E);
          if constexpr (!XR_ON) {frame_refresh(F); SEpiResidLN<l == 0> SE{l == 0 ? (const void*)in_ptr(1) : (const void*)XB, XB, mod_ptr(F, l, 2), 0.5f, Hb, gs_ptr(F, l * 3 + 1), mod_ptr(F, l, 3), ss_ptr(F, l * 3 + 1), fcnt_ptr(F, l * 3 + 1) + 64 * 64};
            sgemm64(F, ACT + (size_t)MP * DFF, wt_ptr(F, l, WO_D1), DFF, SE); } }
        FILL_BAR(1, 3u);
        if (PH(5)) dt_phase(F, l);
        if (PH(6)) { frame_refresh(F); pg8::Gemm g{Hb, wt_ptr(F, l, WO_IN), M, 6144, DM}; pg8::StaticOrder S; S.init(M, 6144, GRID, F.bx);
          pg8::EpiProj E{(bf16*)(F.ws + WS_P), 0}; pg8::gemm_phase<pg8::EpiProj, pg8::StaticOrder, true, true>(F.lds + RING_OFF, g, S, E); }
        xcd_arrive(bar, BAR2);
        if (PH(6)) { frame_refresh(F); pg8::Gemm g{Hb, wt_ptr(F, l, WO_IN) + (size_t)6144 * DM, M, 2048, DM}; pg8::StaticOrder S; S.init(M, 2048, GRID, (F.bx + GRID - 96) % GRID);
          pg8::EpiProj E{(bf16*)(F.ws + WS_P), 24}; pg8::gemm_phase<pg8::EpiProj, pg8::StaticOrder, true, true>(F.lds + RING_OFF, g, S, E); }
        xcd_wait(bar, BAR2, 4u + 7u * l);
#ifdef DUP_SC
        F.dry = 1; shortconv_phase(F, l); F.dry = 0;
#endif
        if (PH(7)) shortconv_phase(F, l);
        __syncthreads();
        if (PH(8)) ssd_s1_phase(F, l, bar, BAR2, 5u + 7u * l);
#ifdef DUP_S2
        ssd_s2_phase(F, l);
#endif
        if (PH(8)) ssd_s2_phase(F, l);
        xcd_arrive(bar, BAR2);
        if (PH(8)) ssd_s3_phase(F, l, bar, BAR2, 6u + 7u * l);
        xcd_arrive(bar, BAR2);
        if (PH(9)) { frame_refresh(F); pg8::Gemm g{proj_ptr(F, PT_SCB), wt_ptr(F, l, WO_SC), MP, DM, DM, proj_ptr(F, PT_Z), wt_ptr(F, l, WO_SSD)}; pg8::PairOrderW S; S.init(MP, DM, GRID, F.bx);
          S.top = BAR2 + XB_TOP; S.target = bar.st[1] * (7u + 7u * l);
          pg8::EpiGate2 E{Tb, proj_ptr(F, PT_GSC), proj_ptr(F, PT_GSSD)}; pg8::gemm_phase<pg8::EpiGate2, pg8::PairOrderW, true, true, XR_ON, MP>(F.lds + RING_OFF, g, S, E);
          if constexpr (!XR_ON) { frame_refresh(F); SEpiGate<true> SE{Tb, proj_ptr(F, PT_GSSD)};
          sgemm64(F, proj_ptr(F, PT_Z) + (size_t)MP * DM, wt_ptr(F, l, WO_SSD), DM, SE);
          frame_refresh(F); SEpiGate<false> SE2{Tb, proj_ptr(F, PT_GSC)};
          sgemm64(F, proj_ptr(F, PT_SCB) + (size_t)MP * DM, wt_ptr(F, l, WO_SC), DM, SE2); } }
        xcd_arrive(bar, BAR2);
        if (PH(11)) { frame_refresh(F); pg8::Gemm g{Tb, wt_ptr(F, l, WO_O), MP, DM, DM}; pg8::RotWaitOrder S; S.init(MP, DM, GRID, F.bx); S.top = BAR2 + XB_TOP; S.target = bar.st[1] * (8u + 7u * l);
          pg8::EpiResidLN<false, false> E{XB, XB, mod_ptr(F, l, 5), nullptr, Hb, gs_ptr(F, l * 3 + 2), mod_ptr(F, l, 6), ss_ptr(F, l * 3 + 2), fcnt_ptr(F, l * 3 + 2)}; pg8::gemm_phase<pg8::EpiResidLN<false, false>, pg8::RotWaitOrder, true, true, XR_ON, MP>(F.lds + RING_OFF, g, S, E);
          if constexpr (!XR_ON) {frame_refresh(F); SEpiResidLN<false> SE{XB, XB, mod_ptr(F, l, 5), 1.0f, Hb, gs_ptr(F, l * 3 + 2), mod_ptr(F, l, 6), ss_ptr(F, l * 3 + 2), fcnt_ptr(F, l * 3 + 2) + 64 * 64};
            sgemm64(F, Tb + (size_t)MP * DM, wt_ptr(F, l, WO_O), DM, SE); } }
        FILL_BAR(2, 9u);
        if (PH(3)) { frame_refresh(F); pg8::Gemm g{Hb, wt_ptr(F, l, WO_GU2), M, 2 * DFF, DM}; pg8::StaticOrder S; S.init(M, 2 * DFF, GRID, F.bx);
          pg8::EpiSwiglu E{ACT}; pg8::gemm_phase<pg8::EpiSwiglu, pg8::StaticOrder, true, true>(F.lds + RING_OFF, g, S, E);
#ifdef DUP_G1
          GRID_BAR(); pg8::gemm_phase<pg8::EpiSwiglu, pg8::StaticOrder, true, true>(F.lds + RING_OFF, g, S, E);
#endif
        }
        FILL_BAR(3, 10u);
        if (PH(4)) { frame_refresh(F); pg8::Gemm g{ACT, wt_ptr(F, l, WO_D2), MP, DM, DFF}; pg8::StaticOrder S; S.init(MP, DM, GRID, F.bx);
          if constexpr (l + 1 < DEPTH) { pg8::EpiResidLN<true, false> E{XB, XB, mod_ptr(F, l, 8), nullptr, Hb, gs_ptr(F, (l + 1) * 3), mod_ptr(F, l + 1, 0), ss_ptr(F, (l + 1) * 3), fcnt_ptr(F, (l + 1) * 3)}; pg8::gemm_phase<pg8::EpiResidLN<true, false>, pg8::StaticOrder, true, true, XR_ON, MP>(F.lds + RING_OFF, g, S, E);
          if constexpr (!XR_ON) {frame_refresh(F); SEpiResidLN<false> SE{XB, XB, mod_ptr(F, l, 8), 0.5f, Hb, gs_ptr(F, (l + 1) * 3), mod_ptr(F, l + 1, 0), ss_ptr(F, (l + 1) * 3), fcnt_ptr(F, (l + 1) * 3) + 64 * 64};
            sgemm64(F, ACT + (size_t)MP * DFF, wt_ptr(F, l, WO_D2), DFF, SE); } }
          else {
            unsigned* fc = fcnt_ptr(F, 6);
            pg8::EpiFinal E{XB, F.out, mod_ptr(F, l, 8), in_ptr(27), ss_ptr(F, 6), fc}; pg8::gemm_phase<pg8::EpiFinal, pg8::StaticOrder, true, true, XR_ON, MP>(F.lds + RING_OFF, g, S, E);
          if constexpr (!XR_ON) {frame_refresh(F); SEpiFinal SE{XB, F.out, mod_ptr(F, l, 8), in_ptr(27), ss_ptr(F, 6), fcnt_ptr(F, 6) + 64 * 64};
            sgemm64(F, ACT + (size_t)MP * DFF, wt_ptr(F, l, WO_D2), DFF, SE); } } }
        if constexpr (l + 1 < DEPTH) GRID_BAR();
    }

struct Args { const float* in[28]; float* out; unsigned char* ws; };
__global__ void __launch_bounds__(NWAVES * 64, 2) mega_fwd(Args args) {
    extern __shared__ __attribute__((aligned(16))) unsigned char lds[];
    Frame F;
    F.lds = (LAS unsigned char*)lds;
    F.MISC = (volatile LAS unsigned*)(F.lds + MISC_OFF);
    F.tid = threadIdx.x; F.lane = F.tid & 63; F.wave = __builtin_amdgcn_readfirstlane(F.tid >> 6);
    { const int bx = blockIdx.x; F.bx = bx; F.vcu = (bx & 7) * (GRID >> 3) + (bx >> 3); }
    F.out = args.out; F.ws = args.ws; F.dry = 0;
    F.ctl = (gu32*)(F.ws + WS_CTL);
    for (int u = F.tid; u < (LDS_BYTES - LDSCTL_OFF) / 4; u += NWAVES * 64) ((LAS unsigned*)(F.lds + LDSCTL_OFF))[u] = 0u;
    __syncthreads();
    XcdBarrier bar = xcd_barrier_post((unsigned*)(F.ctl + CW_BAR), F.MISC + 8);

    if (PH(0)) p0a_prologue(F);
#ifdef DUP_P0A
    p0a_prologue(F);
#endif
    xcd_arrive(bar, BAR2);
    if (F.vcu < 72) xcd_wait(bar, BAR2, 1u);
    if (PH(1)) for (int l = 0; l < DEPTH; ++l) {
        frame_refresh(F);
        pg8::Gemm g{(const bf16*)(F.ws + WS_CA), (const bf16*)(F.ws + WS_P) + (size_t)l * NMOD * DM, 256, NMOD, DM};
        pg8::StaticOrder S; S.init(256, NMOD, GRID, (F.vcu + GRID - 36 * l) % GRID);
        pg8::EpiMod E{(float*)(F.ws + WS_MOD) + (size_t)l * NSEQ * NMOD, in_ptr(8) + (size_t)l * NMOD, gs_ptr(F, l * 3), (const float*)(F.ws + WS_GN) + (size_t)l * 3 * DM};
        pg8::gemm_phase<pg8::EpiMod, pg8::StaticOrder, true, true>(F.lds + RING_OFF, g, S, E);
    }
    xcd_arrive(bar, BAR3);
    if (PH(0)) p0b_prologue(F, 72);
#ifdef DUP_P0B
    p0b_prologue(F, 0);
#endif
    xcd_wait(bar, BAR3, 1u);
    norm0_phase(F);
#ifdef DUP_XG0
    norm0_phase(F);
#endif
    GRID_BAR();
    layer_fwd<0>(F, bar);
    layer_fwd<1>(F, bar);
#undef GRID_BAR
}

extern "C" void kernel_launch(void* const* d_in, const int* in_sizes, int n_in, void* d_out, int out_size, void* d_ws, size_t ws_size, hipStream_t stream) {
    static int grid = 0;
    if (grid == 0) {
        if (n_in != 28 || ws_size < WS_END) { fprintf(stderr, "kernel_launch: built for 28 inputs and >= %zu bytes of workspace; got n_in %d, ws %zu; nothing launched\n", (size_t)WS_END, n_in, ws_size); grid = -1; return; }
        int dev = 0, cus = 0, per_cu = 0;
        if (hipGetDevice(&dev) != hipSuccess || hipDeviceGetAttribute(&cus, hipDeviceAttributeMultiprocessorCount, dev) != hipSuccess) { grid = -1; return; }
        if (hipFuncSetAttribute((const void*)mega_fwd, hipFuncAttributeMaxDynamicSharedMemorySize, LDS_BYTES) != hipSuccess) { fprintf(stderr, "kernel_launch: hipFuncSetAttribute failed\n"); grid = -1; return; }
        if (hipOccupancyMaxActiveBlocksPerMultiprocessor(&per_cu, (const void*)mega_fwd, NWAVES * 64, LDS_BYTES) != hipSuccess || per_cu < 1)
            fprintf(stderr, "kernel_launch: note: occupancy query reports %d workgroups per CU\n", per_cu);
        (void)hipGetLastError();
        if (cus < GRID) { fprintf(stderr, "kernel_launch: built for a %d-CU device, found %d CUs; nothing launched\n", GRID, cus); grid = -1; return; }
        grid = GRID;
    }
    if (grid < 0) return;
    if (hipMemsetAsync((char*)d_ws + WS_CTL, 0, CTL_ZERO_BYTES, stream) != hipSuccess) { fprintf(stderr, "kernel_launch: hipMemsetAsync failed\n"); return; }
    Args a{};
    for (int i = 0; i < 28; ++i) a.in[i] = (const float*)d_in[i];
    a.out = (float*)d_out; a.ws = (unsigned char*)d_ws;
    hipLaunchKernelGGL(mega_fwd, dim3(grid), dim3(NWAVES * 64), LDS_BYTES, stream, a);
}
```

```cpp
#include <hip/hip_runtime.h>
#include <cstdio>
#include <cstdint>
namespace pg8 {
#define PG8_LAS __attribute__((address_space(3)))
typedef unsigned short bf16_t;
typedef short bf16x8 __attribute__((ext_vector_type(8)));
typedef float f32x4 __attribute__((ext_vector_type(4)));
typedef unsigned u32x4 __attribute__((ext_vector_type(4)));
constexpr int BM = 256, BK = 64, HALF = 128, HTB = HALF * BK * 2  , STAGE_BYTES = 8 * HTB, NXCD = 8, WGM = 4;

__host__ __device__ __forceinline__ int lds_byte(int r, int c) { const int st = (r >> 4) * 2 + (c >> 5), rr = r & 15, cc = c & 31, ob = rr * 64 + cc * 2; return st * 1024 + (ob ^ (((ob >> 9) & 1) << 5)); }
__host__ __device__ __forceinline__ void stage_rc(int b, int& R, int& C) { const int st = b / 1024, sb = b % 1024, swz = sb ^ (((sb >> 9) & 1) << 5); R = (st >> 1) * 16 + swz / 64; C = (st & 1) * 32 + (swz % 64) / 2; }
__host__ __device__ __forceinline__ int perm32(int rho) { const int n = rho >> 4, i = rho & 15; return 8 * (i >> 2) + 4 * n + (i & 3); }

struct Unit { int pm, pn, kind = 0; };
struct Gemm { const bf16_t* A; const bf16_t* Bt; int M, N, K; const bf16_t* A2 = nullptr; const bf16_t* Bt2 = nullptr; };

struct StaticOrder {
    __device__ __forceinline__ int krot(const Unit&) const { return 0; }
    __device__ __forceinline__ void k_ready(const Unit&, int) const {}
    int nM, nN, nwg, G, c;
    __host__ __device__ void init(int M, int N, int G_, int c_) { nM = M / BM; nN = N / BM; nwg = nM * nN; G = G_; c = c_; }
    __host__ __device__ bool next(int i, Unit& u) const {
        const long L = (long)i * G + c; if (L >= nwg) return false;
        int wgid = (int)L; { const int q = nwg / NXCD, r = nwg % NXCD, xcd = wgid % NXCD, off = wgid / NXCD; wgid = (xcd < r ? xcd * (q + 1) : r * (q + 1) + (xcd - r) * q) + off; }
        const int nig = WGM * nN, gid = wgid / nig, fm = gid * WGM, gsz = (nM - fm) < WGM ? (nM - fm) : WGM;
        u.pm = fm + ((wgid % nig) % gsz); u.pn = (wgid % nig) / gsz; return true;
    }
    __device__ __forceinline__ void a_ready(const Unit&) const {}
    __device__ __forceinline__ void done(const Unit&) const {}
};
struct RotWaitOrder {
    static constexpr bool PAIRED = false;
    StaticOrder P; const unsigned* top; unsigned target;
    __host__ __device__ void init(int M, int N, int G_, int c_) { P.init(M, N, G_, c_); }
    __host__ __device__ bool next(int i, Unit& u) const { return P.next(i, u); }
    __device__ __forceinline__ int krot(const Unit& u) const { return 4 * u.pn; }
    __device__ __forceinline__ void k_ready(const Unit&, int t) const {
        if (t != 2) return;
        if (threadIdx.x < 64) { unsigned sp = 0;
            while ((unsigned)__builtin_amdgcn_readfirstlane(__hip_atomic_load(top, __ATOMIC_RELAXED, __HIP_MEMORY_SCOPE_AGENT)) < target && ++sp < (1u << 22)) __builtin_amdgcn_s_sleep(2);
            __builtin_amdgcn_fence(__ATOMIC_ACQUIRE, "agent");
            asm volatile("s_waitcnt vmcnt(0)" ::: "memory"); }
        asm volatile("" ::: "memory"); __builtin_amdgcn_s_barrier(); asm volatile("" ::: "memory");
    }
    __device__ __forceinline__ void a_ready(const Unit&) const {}
    __device__ __forceinline__ void done(const Unit&) const {}
};
struct PairOrder {
    __device__ __forceinline__ int krot(const Unit&) const { return 0; }
    __device__ __forceinline__ void k_ready(const Unit&, int) const {}
    StaticOrder P;
    __host__ __device__ void init(int M, int N, int G_, int c_) { P.init(M, N, G_, c_); }
    __host__ __device__ bool next(int i, Unit& u) const { if (!P.next(i >> 1, u)) return false; u.kind = i & 1; return true; }
    __device__ __forceinline__ void a_ready(const Unit&) const {}
    __device__ __forceinline__ void done(const Unit&) const {}
};
struct PairOrderW {
    __device__ __forceinline__ int krot(const Unit&) const { return 0; }
    __device__ __forceinline__ void k_ready(const Unit&, int) const {}
    StaticOrder P; const unsigned* top; unsigned target;
    __host__ __device__ void init(int M, int N, int G_, int c_) { P.init(M, N, G_, c_); }
    __host__ __device__ bool next(int i, Unit& u) const { if (!P.next(i >> 1, u)) return false; u.kind = i & 1; return true; }
    __device__ __forceinline__ void a_ready(const Unit& u) const {
        if (u.kind == 0) return;
        if (threadIdx.x < 64) { unsigned sp = 0;
            while ((unsigned)__builtin_amdgcn_readfirstlane(__hip_atomic_load(top, __ATOMIC_RELAXED, __HIP_MEMORY_SCOPE_AGENT)) < target && ++sp < (1u << 22)) __builtin_amdgcn_s_sleep(2);
            __builtin_amdgcn_fence(__ATOMIC_ACQUIRE, "agent");
            asm volatile("s_waitcnt vmcnt(0)" ::: "memory"); }
        asm volatile("" ::: "memory"); __builtin_amdgcn_s_barrier(); asm volatile("" ::: "memory");
    }
    __device__ __forceinline__ void done(const Unit&) const {}
};
__device__ __forceinline__ unsigned cvt_pk_bf16(float lo, float hi) { unsigned r; asm volatile("v_cvt_pk_bf16_f32 %0, %1, %2" : "=v"(r) : "v"(lo), "v"(hi)); return r; }
typedef float f32x2 __attribute__((ext_vector_type(2)));
template <class Epi, class Sched, bool ALIGN_EPI = false, bool SP2 = false, bool XROWS = false, int XROW0 = 0>
__device__ __forceinline__ void gemm_phase(PG8_LAS unsigned char* lds, const Gemm g, const Sched& S, const Epi& E) {
    static_assert(!XROWS || SP2, "extra rows: SP2 schedule");
    int tid_ = threadIdx.x; asm volatile("" : "+v"(tid_));
    const int tid = tid_, wid = __builtin_amdgcn_readfirstlane(tid >> 6), lane = tid & 63, wr = wid >> 2, wc = wid & 3, fr = lane & 15, fq = lane >> 4;
    const int K = g.K, nt = K / BK;
    unsigned voffA[2], voffB[2];
#pragma unroll
    for (int i = 0; i < 2; ++i) { int R, C; stage_rc(tid * 16 + i * 8192, R, C); const int Rb = Epi::PERM ? ((R & ~31) + perm32(R & 31)) : R;
        voffA[i] = (unsigned)(R * K + C) * 2u; voffB[i] = (unsigned)(Rb * K + C) * 2u; }
    unsigned voffX = 0;
    if constexpr (XROWS) { const int xr = 2 * wid + (lane >> 5), xs = (lane & 31) >> 2, xc = xs ^ (xr & 7); voffX = (unsigned)(xr * K) * 2u + (unsigned)(xc * 16 + (lane & 3) * 4); }
    const size_t kstep = (size_t)(BK * 2);
    const size_t hstep = (size_t)HALF * K * 2;
    const size_t tstep = 2 * hstep;
    const unsigned ldsw = (unsigned)wid * 1024u;
    const int aoff = lds_byte(wr * 64 + fr, fq * 8), boff = lds_byte(wc * 32 + fr, fq * 8);
#define PG8_SA(b, h) (((b) * 2 + (h)) * HTB)
#define PG8_SB(b, h) ((4 + (b) * 2 + (h)) * HTB)
#define PG8_STAGE(bufoff, gbase, voff) do { _Pragma("unroll") for (int _i = 0; _i < 2; ++_i) \
        __builtin_amdgcn_global_load_lds((const unsigned*)((const char*)(gbase) + (voff)[_i]), (PG8_LAS unsigned*)(lds + (bufoff) + ldsw + _i * 8192), 16, 0, 0); } while (0)
#define PG8_LDA(dst, b, h) do { _Pragma("unroll") for (int m = 0; m < 4; ++m) _Pragma("unroll") for (int k = 0; k < 2; ++k) dst[m][k] = *(const PG8_LAS bf16x8*)(lds + PG8_SA(b, h) + aoff + m * 2048 + k * 1024); } while (0)
#define PG8_LDB(dst, b, h) do { _Pragma("unroll") for (int n = 0; n < 2; ++n) _Pragma("unroll") for (int k = 0; k < 2; ++k) dst[n][k] = *(const PG8_LAS bf16x8*)(lds + PG8_SB(b, h) + boff + n * 2048 + k * 1024); } while (0)
#define PG8_MMA(ai, bj, At, Bt) do { __builtin_amdgcn_s_setprio(1); _Pragma("unroll") for (int m = 0; m < 4; ++m) _Pragma("unroll") for (int n = 0; n < 2; ++n) _Pragma("unroll") for (int k = 0; k < 2; ++k) \
        acc[ai][bj][m][n] = __builtin_amdgcn_mfma_f32_16x16x32_bf16(Bt[n][k], At[m][k], acc[ai][bj][m][n], 0, 0, 0); __builtin_amdgcn_s_setprio(0); } while (0)
#define PG8_XS(b) (STAGE_BYTES + (b) * 2048)
#define PG8_STAGEX(b, gbase) do { if constexpr (XROWS) __builtin_amdgcn_global_load_lds((const unsigned*)((const char*)(gbase) + voffX), (PG8_LAS unsigned*)(lds + PG8_XS(b) + wid * 256), 4, 0, 0); } while (0)
#define PG8_LDX(b) do { if constexpr (XROWS) { _Pragma("unroll") for (int k = 0; k < 2; ++k) Ax[k] = *(const PG8_LAS bf16x8*)(lds + PG8_XS(b) + fr * 128 + (((k * 4 + fq) ^ (fr & 7)) * 16)); } } while (0)
#define PG8_MMAX() do { if constexpr (XROWS) { if (wr == 0) { _Pragma("unroll") for (int n = 0; n < 2; ++n) _Pragma("unroll") for (int k = 0; k < 2; ++k) accx[n] = __builtin_amdgcn_mfma_f32_16x16x32_bf16(B0[n][k], Ax[k], accx[n], 0, 0, 0); } \
        else { _Pragma("unroll") for (int n = 0; n < 2; ++n) _Pragma("unroll") for (int k = 0; k < 2; ++k) accx[n] = __builtin_amdgcn_mfma_f32_16x16x32_bf16(B1[n][k], Ax[k], accx[n], 0, 0, 0); } } } while (0)
#define PG8_WAIT_V2() do { if constexpr (XROWS) asm volatile("s_waitcnt vmcnt(9)" ::: "memory"); else asm volatile("s_waitcnt vmcnt(8)" ::: "memory"); } while (0)
#define PG8_WAIT_V(n) asm volatile("s_waitcnt vmcnt(" #n ")" ::: "memory")
#define PG8_WAIT_L(n) asm volatile("s_waitcnt lgkmcnt(" #n ")" ::: "memory")
#define PG8_BAR __builtin_amdgcn_s_barrier()
#define PG8_SCHED __builtin_amdgcn_sched_barrier(0)
    Unit cur, nxt; int ui = 0;
    if (!S.next(0, cur)) return;
    f32x4 acc[2][2][4][2];
#pragma unroll
    for (int a = 0; a < 2; ++a)
#pragma unroll
        for (int b = 0; b < 2; ++b)
#pragma unroll
            for (int m = 0; m < 4; ++m)
#pragma unroll
                for (int n = 0; n < 2; ++n) acc[a][b][m][n] = (f32x4){0.f, 0.f, 0.f, 0.f};
    bf16x8 At[4][2], B0[2][2], B1[2][2], Ax[2];
    f32x4 accx[2] = {(f32x4){0.f, 0.f, 0.f, 0.f}, (f32x4){0.f, 0.f, 0.f, 0.f}};
    const char* cA = (const char*)(cur.kind ? g.A2 : g.A) + (size_t)cur.pm * tstep; const char* cB = (const char*)(cur.kind ? g.Bt2 : g.Bt) + (size_t)cur.pn * tstep;
    const char* cX = (const char*)(cur.kind ? g.A2 : g.A) + ((size_t)XROW0 + 16 * (size_t)cur.pm) * (size_t)K * 2;
    int kr = S.krot(cur);
    const char* pA = cA + (size_t)kr * kstep; const char* pB = cB + (size_t)kr * kstep; const char* pX = cX + (size_t)kr * kstep;
    S.a_ready(cur);
    if constexpr (SP2) {
        PG8_STAGEX(0, pX); PG8_STAGE(PG8_SB(0, 0), pB, voffB); PG8_STAGE(PG8_SB(0, 1), pB + hstep, voffB); PG8_STAGE(PG8_SA(0, 0), pA, voffA); PG8_STAGE(PG8_SA(0, 1), pA + hstep, voffA);
        if (wr == 1) PG8_BAR;
        PG8_WAIT_V(2); PG8_BAR;
        PG8_STAGEX(1, pX + kstep); PG8_STAGE(PG8_SB(1, 0), pB + kstep, voffB); PG8_STAGE(PG8_SA(1, 0), pA + kstep, voffA); PG8_STAGE(PG8_SB(1, 1), pB + hstep + kstep, voffB);
        PG8_WAIT_V(6); PG8_BAR;
    } else {
        PG8_STAGE(PG8_SB(0, 0), cB, voffB); PG8_STAGE(PG8_SA(0, 0), cA, voffA); PG8_STAGE(PG8_SB(0, 1), cB + hstep, voffB); PG8_STAGE(PG8_SA(0, 1), cA + hstep, voffA);
        if (wr == 1) PG8_BAR;
        PG8_WAIT_V(4); PG8_BAR;
        PG8_STAGE(PG8_SB(1, 0), cB + kstep, voffB); PG8_STAGE(PG8_SA(1, 0), cA + kstep, voffA); PG8_STAGE(PG8_SB(1, 1), cB + hstep + kstep, voffB);
        PG8_WAIT_V(6); PG8_BAR;
    }
    for (;;) {
        const bool has_next = S.next(ui + 1, nxt);
        const char* nA = has_next ? (const char*)(nxt.kind ? g.A2 : g.A) + (size_t)nxt.pm * tstep : cA; const char* nB = has_next ? (const char*)(nxt.kind ? g.Bt2 : g.Bt) + (size_t)nxt.pn * tstep : cB;
        const char* nX = cX;
        if constexpr (XROWS && !Epi::AFTER_DRAIN) { if (has_next) nX = (const char*)(nxt.kind ? g.A2 : g.A) + ((size_t)XROW0 + 16 * (size_t)nxt.pm) * (size_t)K * 2; }
        for (int t = 0; t < nt; t += 2) {
            const bool last = (t == nt - 2);
            const int k1 = kr ? (((t + kr) & (nt - 1)) + 1) : (t + 1), k2 = kr ? ((t + 2 + kr) & (nt - 1)) : (t + 2);
            S.k_ready(cur, t);
            const char* a1 = cA + (size_t)k1 * kstep;
            const char* a2 = last ? nA : cA + (size_t)k2 * kstep; const char* b2 = last ? nB : cB + (size_t)k2 * kstep;
            const char* a3 = a2 + kstep; const char* b3 = b2 + kstep;
            const char* x2 = last ? nX : cX + (size_t)k2 * kstep; const char* x3 = x2 + kstep;
            if (last && has_next) S.a_ready(nxt);
            if (last) E.prefetch(cur, wr, wc, fr, fq);
            if constexpr (SP2) {
            PG8_LDB(B0, 0, 0); PG8_LDB(B1, 0, 1); PG8_SCHED; PG8_LDA(At, 0, 0); PG8_LDX(0); PG8_STAGE(PG8_SA(1, 1), a1 + hstep, voffA);
            PG8_WAIT_V(8); PG8_WAIT_L(0); PG8_BAR; PG8_MMA(0, 0, At, B0); PG8_MMA(0, 1, At, B1); PG8_MMAX(); PG8_BAR; PG8_SCHED;
            PG8_LDA(At, 0, 1); PG8_STAGEX(0, x2); PG8_STAGE(PG8_SB(0, 0), b2, voffB); PG8_STAGE(PG8_SB(0, 1), b2 + hstep, voffB); PG8_STAGE(PG8_SA(0, 0), a2, voffA);
            PG8_WAIT_V2(); PG8_WAIT_L(0); PG8_BAR; PG8_MMA(1, 0, At, B0); PG8_MMA(1, 1, At, B1); PG8_BAR; PG8_SCHED;
            PG8_LDB(B0, 1, 0); PG8_LDB(B1, 1, 1); PG8_SCHED; PG8_LDA(At, 1, 0); PG8_LDX(1); PG8_STAGE(PG8_SA(0, 1), a2 + hstep, voffA);
            PG8_WAIT_V(8); PG8_WAIT_L(0); PG8_BAR; PG8_MMA(0, 0, At, B0); PG8_MMA(0, 1, At, B1); PG8_MMAX(); PG8_BAR; PG8_SCHED;
            PG8_LDA(At, 1, 1); PG8_STAGEX(1, x3); PG8_STAGE(PG8_SB(1, 0), b3, voffB); PG8_STAGE(PG8_SB(1, 1), b3 + hstep, voffB); PG8_STAGE(PG8_SA(1, 0), a3, voffA);
            PG8_WAIT_V2(); PG8_WAIT_L(0); PG8_BAR; PG8_MMA(1, 0, At, B0); PG8_MMA(1, 1, At, B1); PG8_BAR; PG8_SCHED;
            } else {
            PG8_LDB(B0, 0, 0); PG8_SCHED; PG8_LDA(At, 0, 0); PG8_STAGE(PG8_SA(1, 1), a1 + hstep, voffA);
            PG8_WAIT_L(8); PG8_BAR; PG8_WAIT_L(0); PG8_MMA(0, 0, At, B0); PG8_BAR; PG8_SCHED;
            PG8_LDB(B1, 0, 1); PG8_STAGE(PG8_SB(0, 0), b2, voffB);
            PG8_BAR; PG8_WAIT_L(0); PG8_MMA(0, 1, At, B1); PG8_BAR;
            PG8_LDA(At, 0, 1); PG8_STAGE(PG8_SA(0, 0), a2, voffA);
            PG8_BAR; PG8_WAIT_L(0); PG8_MMA(1, 0, At, B0); PG8_BAR; PG8_SCHED;
            PG8_STAGE(PG8_SB(0, 1), b2 + hstep, voffB);
            PG8_WAIT_V(6); PG8_BAR; PG8_MMA(1, 1, At, B1); PG8_BAR;
            PG8_LDB(B0, 1, 0); PG8_SCHED; PG8_LDA(At, 1, 0); PG8_STAGE(PG8_SA(0, 1), a2 + hstep, voffA);
            PG8_WAIT_L(8); PG8_BAR; PG8_WAIT_L(0); PG8_MMA(0, 0, At, B0); PG8_BAR; PG8_SCHED;
            PG8_LDB(B1, 1, 1); PG8_STAGE(PG8_SB(1, 0), b3, voffB);
            PG8_BAR; PG8_WAIT_L(0); PG8_MMA(0, 1, At, B1); PG8_BAR;
            PG8_LDA(At, 1, 1); PG8_STAGE(PG8_SA(1, 0), a3, voffA);
            PG8_BAR; PG8_WAIT_L(0); PG8_MMA(1, 0, At, B0); PG8_BAR; PG8_SCHED;
            PG8_STAGE(PG8_SB(1, 1), b3 + hstep, voffB);
            PG8_WAIT_V(6); PG8_BAR; PG8_MMA(1, 1, At, B1); PG8_BAR;
            }
        }
        if constexpr (ALIGN_EPI) { if (wr == 0) PG8_BAR; }
        if constexpr (!Epi::AFTER_DRAIN) { int fr_ = fr, fq_ = fq; asm volatile("" : "+v"(fr_), "+v"(fq_));
            if constexpr (Epi::CHAIN) E.template chain<XROWS>(acc, accx, cur, wr, wc, fr_, fq_); else { E(acc, cur, wr, wc, fr_, fq_); if constexpr (XROWS) E.xrows(accx, cur, wr, wc, fr_, fq_); }
            S.done(cur); }
        if (!has_next) break;
        if (!(Epi::CHAIN && cur.kind == 0)) {
#pragma unroll
        for (int a = 0; a < 2; ++a)
#pragma unroll
            for (int b = 0; b < 2; ++b)
#pragma unroll
                for (int m = 0; m < 4; ++m)
#pragma unroll
                    for (int n = 0; n < 2; ++n) acc[a][b][m][n] = (f32x4){0.f, 0.f, 0.f, 0.f};
        accx[0] = (f32x4){0.f, 0.f, 0.f, 0.f}; accx[1] = (f32x4){0.f, 0.f, 0.f, 0.f};
        }
        cur = nxt; cA = nA; cB = nB; cX = nX; ++ui; kr = S.krot(cur);
        if constexpr (ALIGN_EPI) { if (wr == 1) PG8_BAR; }
    }
    PG8_WAIT_V(0);
    if constexpr (!ALIGN_EPI) { if (wr == 0) PG8_BAR; }
    PG8_BAR;
    if constexpr (Epi::AFTER_DRAIN) { E.template fused<XROWS>(acc, accx, cur, wr, wc, fr, fq, lds, wid, lane); S.done(cur); }
#undef PG8_SA
#undef PG8_SB
#undef PG8_STAGE
#undef PG8_LDA
#undef PG8_LDB
#undef PG8_MMA
#undef PG8_WAIT_V
#undef PG8_WAIT_V2
#undef PG8_XS
#undef PG8_STAGEX
#undef PG8_LDX
#undef PG8_MMAX
#undef PG8_WAIT_L
#undef PG8_BAR
#undef PG8_SCHED
}
}
constexpr int DM = 1024, NB_P = 8, SEQ_P = 2048, NB_S = 128, SEQ_S = 8, DEPTH = 2;
constexpr int MP = NB_P * SEQ_P;
constexpr int MS = NB_S * SEQ_S;
constexpr int M = MP + MS;
constexpr int NSEQ = NB_P + NB_S;
constexpr int DFF = 2816, NMOD = 9 * DM, DPROJ = 8208, DXBC = 2048;
constexpr float EPS = 1e-6f;

__device__ __forceinline__ int mod_row(int m) { return m < MP ? (m >> 11) : NB_P + ((m - MP) >> 3); }
__device__ __forceinline__ float bf_lo(unsigned w) { return __uint_as_float(w << 16); }
__device__ __forceinline__ float bf_hi(unsigned w) { return __uint_as_float(w & 0xffff0000u); }
__device__ __forceinline__ float fast_sigmoid(float x) { return __builtin_amdgcn_rcpf(1.f + __expf(-x)); }
__device__ __forceinline__ float fast_silu(float x) { return x * fast_sigmoid(x); }

__device__ __forceinline__ __amdgpu_buffer_rsrc_t wt_rsrc(void* base) { return __builtin_amdgcn_make_buffer_rsrc(base, 0, 0x7ffffff0, 0x00020000); }
#ifdef USE_WT
#define WT_STORE16(rs, base, byteoff, val) __builtin_amdgcn_raw_buffer_store_b128((val), (rs), (int)(byteoff), 0, 16)
#else
#define WT_STORE16(rs, base, byteoff, val) (*(pg8::u32x4*)((char*)(base) + (byteoff)) = (val))
#endif
namespace pg8 {
struct EpiMod {
    static constexpr bool CHAIN = false, PERM = false, AFTER_DRAIN = false;
    __device__ __forceinline__ void prefetch(const Unit&, int, int, int, int) const {}
    float* C; const float* bias; float* GS; const float* GN;
    __device__ __forceinline__ void operator()(const f32x4 (&acc)[2][2][4][2], const Unit& u, int wr, int wc, int fr, int fq) const {
        const int row0 = u.pm * BM + wr * 64 + fr, col0 = u.pn * BM + wc * 32 + 4 * fq;
        const int ch = u.pn >> 2, jn = ch / 3, kind = ch - 3 * jn, cc0 = (u.pn & 3) * BM + wc * 32 + 4 * fq;
        const float* gn = GN + jn * DM;
        f32x4 bv[2][2], gv[2][2];
#pragma unroll
        for (int bj = 0; bj < 2; ++bj)
#pragma unroll
            for (int n = 0; n < 2; ++n) { bv[bj][n] = *(const f32x4*)(bias + col0 + bj * HALF + n * 16); gv[bj][n] = *(const f32x4*)(gn + cc0 + bj * HALF + n * 16); }
#pragma unroll
        for (int ai = 0; ai < 2; ++ai)
#pragma unroll
            for (int m = 0; m < 4; ++m) { const int r = row0 + ai * HALF + m * 16;
                if (r < NSEQ) { float* rowp = C + (size_t)r * NMOD + col0;
#pragma unroll
                    for (int bj = 0; bj < 2; ++bj)
#pragma unroll
                        for (int n = 0; n < 2; ++n) { const f32x4 v = acc[ai][bj][m][n] + bv[bj][n]; const int cc = cc0 + bj * HALF + n * 16;
                            if (kind == 1) *(f32x4*)(GS + ((size_t)jn * NSEQ + r) * DM + cc) = gv[bj][n] * (v + 1.f);
                            else *(f32x4*)(rowp + bj * HALF + n * 16) = v; } } }
    }
};
struct EpiSwiglu {
    static constexpr bool CHAIN = false, PERM = true, AFTER_DRAIN = false;
    __device__ __forceinline__ void prefetch(const Unit&, int, int, int, int) const {}
    bf16_t* O;
    __device__ __forceinline__ void operator()(const f32x4 (&acc)[2][2][4][2], const Unit& u, int wr, int wc, int fr, int fq) const {
        const int row0 = u.pm * BM + wr * 64 + fr, col0 = u.pn * HALF + wc * 32 + 8 * fq;
#pragma unroll
        for (int ai = 0; ai < 2; ++ai)
#pragma unroll
            for (int m = 0; m < 4; ++m) { bf16_t* rowp = O + (size_t)(row0 + ai * HALF + m * 16) * DFF + col0;
                const f32x4 g0 = acc[ai][0][m][0], g1 = acc[ai][0][m][1], u0 = acc[ai][1][m][0], u1 = acc[ai][1][m][1];
                u32x4 w;
                w.x = cvt_pk_bf16(fast_silu(g0[0]) * u0[0], fast_silu(g0[1]) * u0[1]); w.y = cvt_pk_bf16(fast_silu(g0[2]) * u0[2], fast_silu(g0[3]) * u0[3]);
                w.z = cvt_pk_bf16(fast_silu(g1[0]) * u1[0], fast_silu(g1[1]) * u1[1]); w.w = cvt_pk_bf16(fast_silu(g1[2]) * u1[2], fast_silu(g1[3]) * u1[3]);
                *(u32x4*)rowp = w; }
    }
};
struct EpiProj {
    static constexpr bool CHAIN = false, PERM = true, AFTER_DRAIN = false;
    __device__ __forceinline__ void prefetch(const Unit&, int, int, int, int) const {}
    bf16_t* P; int pn0 = 0;
    __device__ __forceinline__ void operator()(const f32x4 (&acc)[2][2][4][2], const Unit& u, int wr, int wc, int fr, int fq) const {
        const int pn = u.pn + pn0, t = pn >> 2; bf16_t* base = P + (size_t)t * M * DM;
        const int row0 = u.pm * BM + wr * 64 + fr, col0 = (pn & 3) * BM + wc * 32 + 8 * fq;
        const bool sg = t >= 6;
        if (t == 4 || t == 5) {
            bf16_t* pb = P + (size_t)4 * M * DM + (pn - 16) * HALF + wc * 32 + 8 * fq;
#pragma unroll
            for (int ai = 0; ai < 2; ++ai)
#pragma unroll
                for (int m = 0; m < 4; ++m) { const f32x4 c0 = acc[ai][0][m][0] * acc[ai][1][m][0], c1 = acc[ai][0][m][1] * acc[ai][1][m][1];
                    u32x4 w; w.x = cvt_pk_bf16(c0[0], c0[1]); w.y = cvt_pk_bf16(c0[2], c0[3]); w.z = cvt_pk_bf16(c1[0], c1[1]); w.w = cvt_pk_bf16(c1[2], c1[3]);
                    *(u32x4*)(pb + (size_t)(row0 + ai * HALF + m * 16) * DM) = w; }
            return; }
#pragma unroll
        for (int ai = 0; ai < 2; ++ai)
#pragma unroll
            for (int m = 0; m < 4; ++m) { bf16_t* rowp = base + (size_t)(row0 + ai * HALF + m * 16) * DM + col0;
#pragma unroll
                for (int bj = 0; bj < 2; ++bj) { f32x4 v0 = acc[ai][bj][m][0], v1 = acc[ai][bj][m][1];
                    if (sg) {
#pragma unroll
                        for (int i = 0; i < 4; ++i) { v0[i] = fast_sigmoid(v0[i]); v1[i] = fast_sigmoid(v1[i]); } }
                    u32x4 w; w.x = cvt_pk_bf16(v0[0], v0[1]); w.y = cvt_pk_bf16(v0[2], v0[3]); w.z = cvt_pk_bf16(v1[0], v1[1]); w.w = cvt_pk_bf16(v1[2], v1[3]);
                    *(u32x4*)(rowp + bj * HALF) = w; } }
    }
};
template <bool HALFSC, bool XF32> struct EpiResidLN {
    static constexpr bool CHAIN = false, PERM = true, AFTER_DRAIN = true;
    __device__ __forceinline__ void prefetch(const Unit&, int, int, int, int) const {}
    const void* Xin; bf16_t* X; const float* gate;
    const float* XinS = nullptr;
    bf16_t* H; const float* GS; const float* SH; float* SSQ; unsigned* cnt;
    template <bool XR> __device__ __forceinline__ void fused(f32x4 (&acc)[2][2][4][2], f32x4 (&accx)[2], const Unit& u, int wr, int wc, int fr, int fq, PG8_LAS unsigned char*, int, int) const {
        constexpr float sc = HALFSC ? 0.5f : 1.0f;
        const int col0 = u.pn * BM + wc * 32 + 8 * fq, mr = mod_row(u.pm * BM), rbase = u.pm * BM + wr * 64 + fr;
        f32x4 g4[2][2];
#pragma unroll
        for (int bj = 0; bj < 2; ++bj)
#pragma unroll
            for (int n = 0; n < 2; ++n) g4[bj][n] = *(const f32x4*)(gate + (size_t)mr * NMOD + col0 + bj * HALF + n * 4) * sc;
        float ssr[8];
        f32x4 xc[2][2], xnx[2][2]; u32x4 xr[2], xrn[2];
        if constexpr (XF32) {
#pragma unroll
            for (int bj = 0; bj < 2; ++bj)
#pragma unroll
                for (int n = 0; n < 2; ++n) xc[bj][n] = *(const f32x4*)((const float*)Xin + (size_t)rbase * DM + col0 + bj * HALF + n * 4);
        } else {
#pragma unroll
            for (int bj = 0; bj < 2; ++bj) xr[bj] = *(const u32x4*)((const bf16_t*)Xin + (size_t)rbase * DM + col0 + bj * HALF);
        }
#pragma unroll
        for (int q = 0; q < 8; ++q) { const int ai = q >> 2, m = q & 3; const int r = rbase + ai * HALF + m * 16;
            if (q < 7) { const int rn = rbase + ((q + 1) >> 2) * HALF + ((q + 1) & 3) * 16;
                if constexpr (XF32) {
#pragma unroll
                    for (int bj = 0; bj < 2; ++bj)
#pragma unroll
                        for (int n = 0; n < 2; ++n) xnx[bj][n] = *(const f32x4*)((const float*)Xin + (size_t)rn * DM + col0 + bj * HALF + n * 4);
                } else {
#pragma unroll
                    for (int bj = 0; bj < 2; ++bj) xrn[bj] = *(const u32x4*)((const bf16_t*)Xin + (size_t)rn * DM + col0 + bj * HALF);
                } }
            if constexpr (!XF32) {
#pragma unroll
                for (int bj = 0; bj < 2; ++bj) { xc[bj][0] = (f32x4){bf_lo(xr[bj].x), bf_hi(xr[bj].x), bf_lo(xr[bj].y), bf_hi(xr[bj].y)}; xc[bj][1] = (f32x4){bf_lo(xr[bj].z), bf_hi(xr[bj].z), bf_lo(xr[bj].w), bf_hi(xr[bj].w)}; } }
            float ss = 0.f;
#pragma unroll
            for (int bj = 0; bj < 2; ++bj) {
#pragma unroll
                for (int n = 0; n < 2; ++n) { const f32x4 xn = xc[bj][n] + g4[bj][n] * acc[ai][bj][m][n]; acc[ai][bj][m][n] = xn;
                    ss += (xn[0] * xn[0] + xn[1] * xn[1]) + (xn[2] * xn[2] + xn[3] * xn[3]); }
                const f32x4 a = acc[ai][bj][m][0], b = acc[ai][bj][m][1];
                u32x4 w; w.x = cvt_pk_bf16(a[0], a[1]); w.y = cvt_pk_bf16(a[2], a[3]); w.z = cvt_pk_bf16(b[0], b[1]); w.w = cvt_pk_bf16(b[2], b[3]);
                *(u32x4*)(X + (size_t)r * DM + col0 + bj * HALF) = w; }
            ss += __shfl_xor(ss, 16); ss += __shfl_xor(ss, 32); ssr[q] = ss;
            if constexpr (XF32) {
#pragma unroll
                for (int bj = 0; bj < 2; ++bj)
#pragma unroll
                    for (int n = 0; n < 2; ++n) xc[bj][n] = xnx[bj][n];
            } else { xr[0] = xrn[0]; xr[1] = xrn[1]; } }
        if (fq == 0) {
#pragma unroll
            for (int q = 0; q < 8; ++q) atomicAdd(SSQ + rbase + (q >> 2) * HALF + (q & 3) * 16, ssr[q]); }
        const int ms = MP + 16 * u.pm + fr, mrs = mod_row(ms), cx = u.pn * BM + wr * HALF + wc * 32 + 8 * fq;
        if constexpr (XR) {
            const f32x4 xg0 = *(const f32x4*)(gate + (size_t)mrs * NMOD + cx) * sc, xg1 = *(const f32x4*)(gate + (size_t)mrs * NMOD + cx + 4) * sc;
            f32x4 x0, x1;
            if constexpr (XF32) { const float* xp = XinS + (size_t)(ms - MP) * DM + cx; x0 = *(const f32x4*)xp; x1 = *(const f32x4*)(xp + 4); }
            else { const u32x4 xw = *(const u32x4*)((const bf16_t*)Xin + (size_t)ms * DM + cx); x0 = (f32x4){bf_lo(xw.x), bf_hi(xw.x), bf_lo(xw.y), bf_hi(xw.y)}; x1 = (f32x4){bf_lo(xw.z), bf_hi(xw.z), bf_lo(xw.w), bf_hi(xw.w)}; }
            const f32x4 a = x0 + xg0 * accx[0], b = x1 + xg1 * accx[1]; accx[0] = a; accx[1] = b;
            u32x4 w; w.x = cvt_pk_bf16(a[0], a[1]); w.y = cvt_pk_bf16(a[2], a[3]); w.z = cvt_pk_bf16(b[0], b[1]); w.w = cvt_pk_bf16(b[2], b[3]);
            *(u32x4*)(X + (size_t)ms * DM + cx) = w;
            float ss = ((a[0] * a[0] + a[1] * a[1]) + (a[2] * a[2] + a[3] * a[3])) + ((b[0] * b[0] + b[1] * b[1]) + (b[2] * b[2] + b[3] * b[3]));
            ss += __shfl_xor(ss, 16); ss += __shfl_xor(ss, 32);
            if (fq == 0) atomicAdd(SSQ + ms, ss);
        }
        f32x4 gs[2][2], sh[2][2];
#pragma unroll
        for (int bj = 0; bj < 2; ++bj)
#pragma unroll
            for (int n = 0; n < 2; ++n) { gs[bj][n] = *(const f32x4*)(GS + (size_t)mr * DM + col0 + bj * HALF + n * 4); sh[bj][n] = *(const f32x4*)(SH + (size_t)mr * NMOD + col0 + bj * HALF + n * 4); }
        asm volatile("s_waitcnt vmcnt(0)" ::: "memory");
        __syncthreads();
        if (threadIdx.x == 0) { unsigned* c = cnt + 64 * u.pm;
            __hip_atomic_fetch_add(c, 1u, __ATOMIC_RELAXED, __HIP_MEMORY_SCOPE_AGENT);
            unsigned sp = 0; while (__hip_atomic_load(c, __ATOMIC_RELAXED, __HIP_MEMORY_SCOPE_AGENT) < 4u && ++sp < (1u << 22)) __builtin_amdgcn_s_sleep(1); }
        __syncthreads();
        float totq[8];
#pragma unroll
        for (int q = 0; q < 8; ++q) totq[q] = __hip_atomic_load(SSQ + rbase + (q >> 2) * HALF + (q & 3) * 16, __ATOMIC_RELAXED, __HIP_MEMORY_SCOPE_AGENT);
        if constexpr (XR) {
            const float tot = __hip_atomic_load(SSQ + ms, __ATOMIC_RELAXED, __HIP_MEMORY_SCOPE_AGENT);
            const float rinv = 1.f / sqrtf(tot * (1.f / DM) + EPS);
            const f32x4 a = (accx[0] * rinv) * *(const f32x4*)(GS + (size_t)mrs * DM + cx) + *(const f32x4*)(SH + (size_t)mrs * NMOD + cx), b = (accx[1] * rinv) * *(const f32x4*)(GS + (size_t)mrs * DM + cx + 4) + *(const f32x4*)(SH + (size_t)mrs * NMOD + cx + 4);
            u32x4 w; w.x = cvt_pk_bf16(a[0], a[1]); w.y = cvt_pk_bf16(a[2], a[3]); w.z = cvt_pk_bf16(b[0], b[1]); w.w = cvt_pk_bf16(b[2], b[3]);
            *(u32x4*)(H + (size_t)ms * DM + cx) = w; }
#pragma unroll
        for (int q = 0; q < 8; ++q) { const int ai = q >> 2, m = q & 3; const int r = rbase + ai * HALF + m * 16;
            const float rinv = 1.f / sqrtf(totq[q] * (1.f / DM) + EPS);
#pragma unroll
            for (int bj = 0; bj < 2; ++bj) { const f32x4 a = (acc[ai][bj][m][0] * rinv) * gs[bj][0] + sh[bj][0], b = (acc[ai][bj][m][1] * rinv) * gs[bj][1] + sh[bj][1];
                u32x4 w; w.x = cvt_pk_bf16(a[0], a[1]); w.y = cvt_pk_bf16(a[2], a[3]); w.z = cvt_pk_bf16(b[0], b[1]); w.w = cvt_pk_bf16(b[2], b[3]);
                *(u32x4*)(H + (size_t)r * DM + col0 + bj * HALF) = w; } }
    }
};
template <bool FIRST> struct EpiGate {
    static constexpr bool CHAIN = false, PERM = true, AFTER_DRAIN = false;
    __device__ __forceinline__ void prefetch(const Unit&, int, int, int, int) const {}
    bf16_t* T; const bf16_t* G;
    __device__ __forceinline__ void operator()(const f32x4 (&acc)[2][2][4][2], const Unit& u, int wr, int wc, int fr, int fq) const {
        const int row0 = u.pm * BM + wr * 64 + fr, col0 = u.pn * BM + wc * 32 + 8 * fq;
        u32x4 gc[2], tc[2], gn[2], tn[2];
#pragma unroll
        for (int bj = 0; bj < 2; ++bj) { const size_t ro = (size_t)row0 * DM + col0 + bj * HALF; gc[bj] = *(const u32x4*)(G + ro); if (!FIRST) tc[bj] = *(const u32x4*)(T + ro); }
#pragma unroll
        for (int q = 0; q < 8; ++q) { const int ai = q >> 2, m = q & 3; const size_t ro = (size_t)(row0 + ai * HALF + m * 16) * DM + col0;
            if (q < 7) { const size_t rn = (size_t)(row0 + ((q + 1) >> 2) * HALF + ((q + 1) & 3) * 16) * DM + col0;
#pragma unroll
                for (int bj = 0; bj < 2; ++bj) { gn[bj] = *(const u32x4*)(G + rn + bj * HALF); if (!FIRST) tn[bj] = *(const u32x4*)(T + rn + bj * HALF); } }
#pragma unroll
            for (int bj = 0; bj < 2; ++bj) { const u32x4 gw = gc[bj];
                const f32x4 a0 = acc[ai][bj][m][0], a1 = acc[ai][bj][m][1];
                float o[8];
                o[0] = bf_lo(gw.x) * a0[0]; o[1] = bf_hi(gw.x) * a0[1]; o[2] = bf_lo(gw.y) * a0[2]; o[3] = bf_hi(gw.y) * a0[3];
                o[4] = bf_lo(gw.z) * a1[0]; o[5] = bf_hi(gw.z) * a1[1]; o[6] = bf_lo(gw.w) * a1[2]; o[7] = bf_hi(gw.w) * a1[3];
                if (!FIRST) { const u32x4 tw = tc[bj];
                    o[0] += bf_lo(tw.x); o[1] += bf_hi(tw.x); o[2] += bf_lo(tw.y); o[3] += bf_hi(tw.y); o[4] += bf_lo(tw.z); o[5] += bf_hi(tw.z); o[6] += bf_lo(tw.w); o[7] += bf_hi(tw.w); }
                u32x4 w; w.x = cvt_pk_bf16(o[0], o[1]); w.y = cvt_pk_bf16(o[2], o[3]); w.z = cvt_pk_bf16(o[4], o[5]); w.w = cvt_pk_bf16(o[6], o[7]);
                *(u32x4*)(T + ro + bj * HALF) = w; }
#pragma unroll
            for (int bj = 0; bj < 2; ++bj) { gc[bj] = gn[bj]; if (!FIRST) tc[bj] = tn[bj]; } }
    }
};
struct EpiGate2 {
    static constexpr bool CHAIN = true, PERM = true, AFTER_DRAIN = false;
    __device__ __forceinline__ void prefetch(const Unit&, int, int, int, int) const {}
    bf16_t* T; const bf16_t* G1; const bf16_t* G2;
    template <bool XR> __device__ __forceinline__ void chain(f32x4 (&acc)[2][2][4][2], f32x4 (&accx)[2], const Unit& u, int wr, int wc, int fr, int fq) const {
        if (u.kind != 0) { EpiGate<true> e{T, G2}; e(acc, u, wr, wc, fr, fq); }
        else {
        const int row0 = u.pm * BM + wr * 64 + fr, col0 = u.pn * BM + wc * 32 + 8 * fq;
#pragma unroll
        for (int q = 0; q < 8; ++q) { const int ai = q >> 2, m = q & 3; const size_t ro = (size_t)(row0 + ai * HALF + m * 16) * DM + col0;
#pragma unroll
            for (int bj = 0; bj < 2; ++bj) { const u32x4 a = *(const u32x4*)(G1 + ro + bj * HALF), b = *(const u32x4*)(G2 + ro + bj * HALF);
                f32x4 r0, r1;
                r0[0] = bf_lo(a.x) * __builtin_amdgcn_rcpf(fmaxf(bf_lo(b.x), 1e-30f)); r0[1] = bf_hi(a.x) * __builtin_amdgcn_rcpf(fmaxf(bf_hi(b.x), 1e-30f));
                r0[2] = bf_lo(a.y) * __builtin_amdgcn_rcpf(fmaxf(bf_lo(b.y), 1e-30f)); r0[3] = bf_hi(a.y) * __builtin_amdgcn_rcpf(fmaxf(bf_hi(b.y), 1e-30f));
                r1[0] = bf_lo(a.z) * __builtin_amdgcn_rcpf(fmaxf(bf_lo(b.z), 1e-30f)); r1[1] = bf_hi(a.z) * __builtin_amdgcn_rcpf(fmaxf(bf_hi(b.z), 1e-30f));
                r1[2] = bf_lo(a.w) * __builtin_amdgcn_rcpf(fmaxf(bf_lo(b.w), 1e-30f)); r1[3] = bf_hi(a.w) * __builtin_amdgcn_rcpf(fmaxf(bf_hi(b.w), 1e-30f));
                acc[ai][bj][m][0] = acc[ai][bj][m][0] * r0; acc[ai][bj][m][1] = acc[ai][bj][m][1] * r1; } }
        }
        __builtin_amdgcn_sched_barrier(0);
        if constexpr (XR) {
            const size_t xo = (size_t)(MP + 16 * u.pm + fr) * DM + u.pn * BM + wr * HALF + wc * 32 + 8 * fq;
            const u32x4 b = *(const u32x4*)(G2 + xo);
            const f32x4 g0 = {bf_lo(b.x), bf_hi(b.x), bf_lo(b.y), bf_hi(b.y)}, g1 = {bf_lo(b.z), bf_hi(b.z), bf_lo(b.w), bf_hi(b.w)};
            if (u.kind == 0) { const u32x4 a = *(const u32x4*)(G1 + xo);
                const f32x4 a0 = {bf_lo(a.x), bf_hi(a.x), bf_lo(a.y), bf_hi(a.y)}, a1 = {bf_lo(a.z), bf_hi(a.z), bf_lo(a.w), bf_hi(a.w)};
#pragma unroll
                for (int i = 0; i < 4; ++i) { accx[0][i] *= a0[i] * __builtin_amdgcn_rcpf(fmaxf(g0[i], 1e-30f)); accx[1][i] *= a1[i] * __builtin_amdgcn_rcpf(fmaxf(g1[i], 1e-30f)); } }
            else { const f32x4 o0 = accx[0] * g0, o1 = accx[1] * g1;
                u32x4 w; w.x = cvt_pk_bf16(o0[0], o0[1]); w.y = cvt_pk_bf16(o0[2], o0[3]); w.z = cvt_pk_bf16(o1[0], o1[1]); w.w = cvt_pk_bf16(o1[2], o1[3]);
                *(u32x4*)(T + xo) = w; } }
    }
};
struct EpiFinal {
    static constexpr bool CHAIN = false, PERM = true, AFTER_DRAIN = true;
    __device__ __forceinline__ void prefetch(const Unit&, int, int, int, int) const {}
    const bf16_t* Xin; float* Y; const float* gate; const float* gfin; float* SSF; unsigned* cnt;
    template <bool XR> __device__ __forceinline__ void fused(f32x4 (&acc)[2][2][4][2], f32x4 (&accx)[2], const Unit& u, int wr, int wc, int fr, int fq, PG8_LAS unsigned char*, int, int) const {
        const int col0 = u.pn * BM + wc * 32 + 8 * fq, mr = mod_row(u.pm * BM), rbase = u.pm * BM + wr * 64 + fr;
        f32x4 g4[2][2];
#pragma unroll
        for (int bj = 0; bj < 2; ++bj)
#pragma unroll
            for (int n = 0; n < 2; ++n) g4[bj][n] = *(const f32x4*)(gate + (size_t)mr * NMOD + col0 + bj * HALF + n * 4) * 0.5f;
        float ssr[8];
#pragma unroll
        for (int q = 0; q < 8; ++q) { const int ai = q >> 2, m = q & 3; const int r = rbase + ai * HALF + m * 16; float ss = 0.f;
#pragma unroll
            for (int bj = 0; bj < 2; ++bj) { const u32x4 xw = *(const u32x4*)(Xin + (size_t)r * DM + col0 + bj * HALF);
                const f32x4 x0 = (f32x4){bf_lo(xw.x), bf_hi(xw.x), bf_lo(xw.y), bf_hi(xw.y)}, x1 = (f32x4){bf_lo(xw.z), bf_hi(xw.z), bf_lo(xw.w), bf_hi(xw.w)};
                const f32x4 n0 = x0 + g4[bj][0] * acc[ai][bj][m][0], n1 = x1 + g4[bj][1] * acc[ai][bj][m][1]; acc[ai][bj][m][0] = n0; acc[ai][bj][m][1] = n1;
                ss += ((n0[0] * n0[0] + n0[1] * n0[1]) + (n0[2] * n0[2] + n0[3] * n0[3])) + ((n1[0] * n1[0] + n1[1] * n1[1]) + (n1[2] * n1[2] + n1[3] * n1[3])); }
            ss += __shfl_xor(ss, 16); ss += __shfl_xor(ss, 32); ssr[q] = ss; }
        if (fq == 0) {
#pragma unroll
            for (int q = 0; q < 8; ++q) atomicAdd(SSF + rbase + (q >> 2) * HALF + (q & 3) * 16, ssr[q]); }
        const int ms = MP + 16 * u.pm + fr, cx = u.pn * BM + wr * HALF + wc * 32 + 8 * fq;
        if constexpr (XR) { const int mrs = mod_row(ms);
            const f32x4 xg0 = *(const f32x4*)(gate + (size_t)mrs * NMOD + cx) * 0.5f, xg1 = *(const f32x4*)(gate + (size_t)mrs * NMOD + cx + 4) * 0.5f;
            const u32x4 xw = *(const u32x4*)(Xin + (size_t)ms * DM + cx);
            const f32x4 x0 = (f32x4){bf_lo(xw.x), bf_hi(xw.x), bf_lo(xw.y), bf_hi(xw.y)}, x1 = (f32x4){bf_lo(xw.z), bf_hi(xw.z), bf_lo(xw.w), bf_hi(xw.w)};
            const f32x4 a = x0 + xg0 * accx[0], b = x1 + xg1 * accx[1]; accx[0] = a; accx[1] = b;
            float ss = ((a[0] * a[0] + a[1] * a[1]) + (a[2] * a[2] + a[3] * a[3])) + ((b[0] * b[0] + b[1] * b[1]) + (b[2] * b[2] + b[3] * b[3]));
            ss += __shfl_xor(ss, 16); ss += __shfl_xor(ss, 32);
            if (fq == 0) atomicAdd(SSF + ms, ss); }
        asm volatile("s_waitcnt vmcnt(0)" ::: "memory");
        __syncthreads();
        if (threadIdx.x == 0) { unsigned* c = cnt + 64 * u.pm;
            __hip_atomic_fetch_add(c, 1u, __ATOMIC_RELAXED, __HIP_MEMORY_SCOPE_AGENT);
            unsigned sp = 0; while (__hip_atomic_load(c, __ATOMIC_RELAXED, __HIP_MEMORY_SCOPE_AGENT) < 4u && ++sp < (1u << 22)) __builtin_amdgcn_s_sleep(1); }
        __syncthreads();
        f32x4 gf[2][2];
#pragma unroll
        for (int bj = 0; bj < 2; ++bj)
#pragma unroll
            for (int n = 0; n < 2; ++n) gf[bj][n] = *(const f32x4*)(gfin + col0 + bj * HALF + n * 4);
        float totq[8];
#pragma unroll
        for (int q = 0; q < 8; ++q) totq[q] = __hip_atomic_load(SSF + rbase + (q >> 2) * HALF + (q & 3) * 16, __ATOMIC_RELAXED, __HIP_MEMORY_SCOPE_AGENT);
        if constexpr (XR) {
            const float tot = __hip_atomic_load(SSF + ms, __ATOMIC_RELAXED, __HIP_MEMORY_SCOPE_AGENT);
            const float rinv = 1.f / sqrtf(tot * (1.f / DM) + EPS);
            *(f32x4*)(Y + (size_t)ms * DM + cx) = (accx[0] * rinv) * *(const f32x4*)(gfin + cx); *(f32x4*)(Y + (size_t)ms * DM + cx + 4) = (accx[1] * rinv) * *(const f32x4*)(gfin + cx + 4); }
#pragma unroll
        for (int q = 0; q < 8; ++q) { const int ai = q >> 2, m = q & 3; const int r = rbase + ai * HALF + m * 16;
            const float rinv = 1.f / sqrtf(totq[q] * (1.f / DM) + EPS);
#pragma unroll
            for (int bj = 0; bj < 2; ++bj)
#pragma unroll
                for (int n = 0; n < 2; ++n) *(f32x4*)(Y + (size_t)r * DM + col0 + bj * HALF + n * 4) = (acc[ai][bj][m][n] * rinv) * gf[bj][n]; }
    }
};
}

constexpr size_t MiB = 1u << 20;
constexpr size_t WS_CTL = 0, CTL_ZERO_BYTES = 1 * MiB;
constexpr size_t WO_GU1 = 0, WO_D1 = WO_GU1 + (size_t)2 * DFF * DM, WO_IN = WO_D1 + (size_t)DFF * DM, WO_SSD = WO_IN + (size_t)DPROJ * DM,
                 WO_SC = WO_SSD + (size_t)DM * DM, WO_O = WO_SC + (size_t)DM * DM, WO_GU2 = WO_O + (size_t)DM * DM, WO_D2 = WO_GU2 + (size_t)2 * DFF * DM,
                 W_LAYER_ELEMS = WO_D2 + (size_t)DFF * DM;
constexpr size_t WS_WT = 1 * MiB;
constexpr size_t WS_MOD = 112 * MiB;
constexpr size_t WS_DT = 122 * MiB;
constexpr size_t WS_CA = 124 * MiB;
constexpr size_t WS_SHA = WS_CA + MiB / 2;
constexpr size_t WS_GS = WS_SHA + 3 * MiB;
constexpr size_t WS_SWDT = WS_GS + 3 * MiB + MiB / 4;
constexpr size_t WS_GN = WS_SWDT + 32768;
constexpr size_t WS_H = 131 * MiB;
constexpr size_t WS_S = 165 * MiB;
constexpr size_t WS_CD = WS_DT + (size_t)M * 16 * 4;
constexpr size_t WS_P = 229 * MiB;
constexpr size_t WS_SW = 501 * MiB;
constexpr size_t SW_LAYER = (size_t)NSEQ * (5632 + 8192 + 5632);
constexpr size_t WS_END = WS_SW + 2 * SW_LAYER * 2;
static_assert(WS_END <= 512 * MiB, "workspace budget");
static_assert(WS_WT + 2 * W_LAYER_ELEMS * 2 <= WS_MOD && WS_MOD + (size_t)2 * NSEQ * NMOD * 4 <= WS_DT && WS_CD + 8192 <= WS_CA && WS_SWDT + 2 * NSEQ * 16 * 4 <= WS_GN && WS_GN + 6 * DM * 4 <= WS_H && WS_H + (size_t)M * DM * 2 <= WS_S && WS_S + 64 * MiB <= WS_P && WS_P + (size_t)8 * M * DM * 2 <= WS_SW, "d_ws map");
constexpr size_t CTL_SS = 65536;
constexpr size_t CTL_FCNT = CTL_SS + (size_t)7 * M * 4;
static_assert(CTL_FCNT % 256 == 0 && CTL_FCNT + 7 * 80 * 256 <= CTL_ZERO_BYTES, "sumsq rows and counters inside the per-call memset");
constexpr size_t PT = (size_t)M * DM;
enum ProjT { PT_Z = 0, PT_XS = 1, PT_BC = 2, PT_SCB = 3, PT_SCC = 4, PT_SCH = 5, PT_GSSD = 6, PT_GSC = 7 };
constexpr int CW_BAR = 4096;

constexpr int NWAVES = 8;
constexpr int GRID = 256;
constexpr int RING_OFF = 0, RING_BYTES = 131072;
constexpr int SIDE_OFF = RING_BYTES;
constexpr int LDS_BYTES = 163840;
constexpr int LDSCTL_OFF = LDS_BYTES - 512, MISC_OFF = LDSCTL_OFF + 320;

#define GAS __attribute__((address_space(1)))
#define LAS __attribute__((address_space(3)))
typedef unsigned short bf16;
typedef unsigned v4u __attribute__((ext_vector_type(4)));
typedef float f32x4 __attribute__((ext_vector_type(4)));
typedef short bf16x8 __attribute__((ext_vector_type(8)));
typedef GAS unsigned gu32;
typedef GAS unsigned long long gu64;
#define RLX_AGENT __ATOMIC_RELAXED, __HIP_MEMORY_SCOPE_AGENT
#define LDS_WAIT() asm volatile("s_waitcnt lgkmcnt(0)" ::: "memory")
#define VM_WAIT() asm volatile("s_waitcnt vmcnt(0)" ::: "memory")
__device__ __forceinline__ unsigned long long rt() { return __builtin_amdgcn_s_memrealtime(); }
__device__ __forceinline__ unsigned f2bf(float f) { unsigned u = __builtin_bit_cast(unsigned, f); return (u + 0x7fffu + ((u >> 16) & 1u)) >> 16; }
__device__ __forceinline__ unsigned pk2(float lo, float hi) { return f2bf(lo) | (f2bf(hi) << 16); }

#define XB_TMO      128
#define XB_XCNT(j)  (256  + 64 * (j))
#define XB_XSUB(j)  (1280 + 64 * (j))
#define XB_XGEN(j)  (2304 + 64 * (j))
#define XB_TOP      3328
#define XB_TOPGEN   3392
#define XCD_BAR_WORDS 3456
#define XB_SPIN_CAP (1u << 18)

__device__ __forceinline__ unsigned xb_ld(unsigned* p)              { return __hip_atomic_load(p, __ATOMIC_RELAXED, __HIP_MEMORY_SCOPE_AGENT); }
__device__ __forceinline__ unsigned xb_add(unsigned* p, unsigned v) { return __hip_atomic_fetch_add(p, v, __ATOMIC_RELAXED, __HIP_MEMORY_SCOPE_AGENT); }
__device__ __forceinline__ unsigned xb_xcc_id() { return (unsigned)__builtin_amdgcn_s_getreg((3 << 11) | 20) & 0xFu; }
#define XB_SPIN(cond, bar) do { unsigned _sp = 0; while (cond) { __builtin_amdgcn_s_sleep(1); \
    if ((++_sp & 255u) == 0u) { if (xb_ld(&(bar)[XB_TMO])) break; if (_sp > XB_SPIN_CAP) { atomicAdd(&(bar)[XB_TMO], 1u); break; } } } } while (0)

struct XcdBarrier {
    unsigned* bar; unsigned x;
    volatile LAS unsigned* st;
};

__device__ __forceinline__ XcdBarrier xcd_barrier_post(unsigned* bar, volatile LAS unsigned* st) {
    XcdBarrier b; b.bar = bar; b.x = xb_xcc_id(); b.st = st;
    if (threadIdx.x == 0) (void)xb_add(&bar[XB_XCNT(b.x)], 1u);
    return b;
}
__device__ __forceinline__ void xcd_barrier_complete(unsigned* bar, unsigned x, unsigned& nloc, unsigned& nx) {
    const unsigned G = gridDim.x * gridDim.y * gridDim.z;
    unsigned sum, cnt, mine, sp = 0u;
    for (;;) {
        sum = 0u; cnt = 0u; mine = 0u;
#pragma unroll
        for (unsigned j = 0; j < 16; ++j) { const unsigned c = xb_ld(&bar[XB_XCNT(j)]); sum += c; cnt += (c > 0u) ? 1u : 0u; mine = (j == x) ? c : mine; }
        if (sum == G) break;
        __builtin_amdgcn_s_sleep(1);
        if ((++sp & 255u) == 0u) { if (xb_ld(&bar[XB_TMO])) break; if (sp > XB_SPIN_CAP) { atomicAdd(&bar[XB_TMO], 1u); break; } }
    }
    nloc = mine > 0u ? mine : 1u; nx = cnt > 0u ? cnt : 1u;
}

__device__ __forceinline__ void xcd_barrier(const XcdBarrier& b) {
    asm volatile("s_waitcnt vmcnt(0)" ::: "memory");
    __syncthreads();
    if (threadIdx.x == 0) {
        const unsigned myx = xb_xcc_id();
        unsigned* bar = b.bar; asm volatile("" : "+s"(bar));
        __builtin_amdgcn_s_waitcnt(0);
        unsigned nloc = b.st[0], nx = b.st[1];
        if (nloc == 0u) { xcd_barrier_complete(bar, myx, nloc, nx); b.st[0] = nloc; b.st[1] = nx; }
        const unsigned old = xb_add(&bar[XB_XSUB(myx)], 1u);
        const unsigned gen = old / nloc;
        if (old + 1u == (gen + 1u) * nloc) {
            __builtin_amdgcn_fence(__ATOMIC_RELEASE, "agent");
            asm volatile("s_waitcnt vmcnt(0)" ::: "memory");
            const unsigned og = xb_add(&bar[XB_TOP], 1u);
            const unsigned tg = og / nx;
            if (og + 1u == (tg + 1u) * nx) xb_add(&bar[XB_TOPGEN], 1u);
            else XB_SPIN(xb_ld(&bar[XB_TOPGEN]) == tg, bar);
            __builtin_amdgcn_fence(__ATOMIC_ACQUIRE, "agent");
            xb_add(&bar[XB_XGEN(myx)], 1u);
            asm volatile("s_waitcnt vmcnt(0)" ::: "memory");
        } else {
            XB_SPIN(xb_ld(&bar[XB_XGEN(myx)]) == gen, bar);
            __builtin_amdgcn_fence(__ATOMIC_ACQUIRE, "agent");
            asm volatile("s_waitcnt vmcnt(0)" ::: "memory");
        }
    }
    __syncthreads();
}

__device__ __forceinline__ void xcd_arrive(const XcdBarrier& b, unsigned* bar2) {
    asm volatile("s_waitcnt vmcnt(0)" ::: "memory");
    __syncthreads();
    if (threadIdx.x == 0) {
        const unsigned myx = xb_xcc_id();
        unsigned* bar = bar2; asm volatile("" : "+s"(bar));
        __builtin_amdgcn_s_waitcnt(0);
        unsigned nloc = b.st[0], nx = b.st[1];
        if (nloc == 0u) { unsigned* bm = b.bar; asm volatile("" : "+s"(bm)); xcd_barrier_complete(bm, myx, nloc, nx); b.st[0] = nloc; b.st[1] = nx; }
        const unsigned old = xb_add(&bar[XB_XSUB(myx)], 1u);
        if ((old + 1u) % nloc == 0u) {
            __builtin_amdgcn_fence(__ATOMIC_RELEASE, "agent");
            asm volatile("s_waitcnt vmcnt(0)" ::: "memory");
            xb_add(&bar[XB_TOP], 1u);
        }
    }
}
__device__ __forceinline__ void xcd_wait(const XcdBarrier& b, unsigned* bar2, unsigned gen) {
    if (threadIdx.x == 0) {
        unsigned* bar = bar2; asm volatile("" : "+s"(bar));
        const unsigned nx = b.st[1];
        XB_SPIN(xb_ld(&bar[XB_TOP]) < nx * gen, bar);
        __builtin_amdgcn_fence(__ATOMIC_ACQUIRE, "agent");
        asm volatile("s_waitcnt vmcnt(0)" ::: "memory");
    }
    __syncthreads();
}
__device__ __forceinline__ void xcd_barrier_flat(const XcdBarrier& b, unsigned* bar4, volatile LAS unsigned* genw) {
    xcd_arrive(b, bar4);
    if (threadIdx.x == 0) {
        unsigned* bar = bar4; asm volatile("" : "+s"(bar));
        const unsigned gen = genw[0] + 1u; genw[0] = gen;
        const unsigned nx = b.st[1];
        XB_SPIN(xb_ld(&bar[XB_TOP]) < nx * gen, bar);
        __builtin_amdgcn_fence(__ATOMIC_ACQUIRE, "agent");
        asm volatile("s_waitcnt vmcnt(0)" ::: "memory");
    }
    __syncthreads();
}
__device__ __forceinline__ void xcd_arrive3(unsigned* bar3w) {
    asm volatile("s_waitcnt vmcnt(0)" ::: "memory");
    __syncthreads();
    if (threadIdx.x == 0) {
        const unsigned myx = xb_xcc_id();
        unsigned* bar = bar3w; asm volatile("" : "+s"(bar));
        __builtin_amdgcn_s_waitcnt(0);
        __builtin_amdgcn_fence(__ATOMIC_RELEASE, "agent");
        asm volatile("s_waitcnt vmcnt(0)" ::: "memory");
        (void)__hip_atomic_fetch_add(&bar[XB_XSUB(myx)], 1u, __ATOMIC_RELAXED, __HIP_MEMORY_SCOPE_AGENT);
    }
}
__device__ __forceinline__ void xcd_wait3(unsigned* bar3w, unsigned target) {
    if (threadIdx.x == 0) {
        unsigned* bar = bar3w; asm volatile("" : "+s"(bar));
        unsigned sp = 0;
        for (;;) { unsigned s = 0;
#pragma unroll
            for (int j = 0; j < 16; ++j) s += xb_ld(&bar[XB_XSUB(j)]);
            if (s >= target) break;
            __builtin_amdgcn_s_sleep(1);
            if ((++sp & 255u) == 0u) { if (xb_ld(&bar[XB_TMO])) break; if (sp > XB_SPIN_CAP) { atomicAdd(&bar[XB_TMO], 1u); break; } } }
        __builtin_amdgcn_fence(__ATOMIC_ACQUIRE, "agent");
        asm volatile("s_waitcnt vmcnt(0)" ::: "memory");
    }
    __syncthreads();
}
__device__ __forceinline__ void xcd_barrier3(unsigned* bar3w, volatile LAS unsigned* genw, unsigned total) {
    xcd_arrive3(bar3w);
    unsigned gen = 0;
    if (threadIdx.x == 0) { gen = genw[0] + 1u; genw[0] = gen; }
    xcd_wait3(bar3w, gen * total);
}


struct Frame {
    LAS unsigned char* lds;
    volatile LAS unsigned* MISC;
    gu32* ctl;
    int tid, lane, wave;
    int vcu, bx;
    int dry;
    float* out;
    unsigned char* ws;
};
#define DRYP(p) (p)
typedef const unsigned char __attribute__((address_space(4)))* kptr_t;
__device__ __forceinline__ const float* in_ptr(int i) {
    kptr_t kp = (kptr_t)__builtin_amdgcn_kernarg_segment_ptr();
    asm volatile("" : "+s"(kp));
    return *(const float* const __attribute__((address_space(4)))*)(kp + 8 * i);
}
__device__ __forceinline__ bf16* wt_ptr(const Frame& F, int layer, size_t off) { return (bf16*)(F.ws + WS_WT) + (size_t)layer * W_LAYER_ELEMS + off; }
__device__ __forceinline__ bf16* proj_ptr(const Frame& F, int t) { return (bf16*)(F.ws + WS_P) + (size_t)t * PT; }
__device__ __forceinline__ float* ss_ptr(const Frame& F, int idx) { return (float*)(F.ws + WS_CTL + CTL_SS) + (size_t)idx * M; }
__device__ __forceinline__ unsigned* fcnt_ptr(const Frame& F, int idx) { return (unsigned*)(F.ws + WS_CTL + CTL_FCNT) + (size_t)idx * 80 * 64; }
__device__ __forceinline__ float* gs_ptr(const Frame& F, int idx) { return (float*)(F.ws + WS_GS) + (size_t)idx * NSEQ * DM; }
__device__ __forceinline__ bf16* sha_ptr(const Frame& F, int idx) { return (bf16*)(F.ws + WS_SHA) + (size_t)idx * 256 * DM; }
__device__ __forceinline__ bf16* sw_ptr(const Frame& F, int layer, int j) { return (bf16*)(F.ws + WS_SW) + (size_t)layer * SW_LAYER + (size_t)NSEQ * (j == 0 ? 0 : (j == 1 ? 5632 : 5632 + 8192)); }
__device__ __forceinline__ float* mod_ptr(const Frame& F, int layer, int chunk) { return (float*)(F.ws + WS_MOD) + (size_t)layer * NSEQ * NMOD + (size_t)chunk * DM; }

__device__ __forceinline__ void frame_refresh(Frame& F) {
    int t = threadIdx.x; asm volatile("" : "+v"(t));
    F.tid = t; F.lane = t & 63; F.wave = __builtin_amdgcn_readfirstlane(t >> 6);
    int bx = blockIdx.x; asm volatile("" : "+s"(bx));
    F.bx = bx; F.vcu = (bx & 7) * (GRID >> 3) + (bx >> 3);
    kptr_t kp = (kptr_t)__builtin_amdgcn_kernarg_segment_ptr(); asm volatile("" : "+s"(kp));
    F.out = *(float* const __attribute__((address_space(4)))*)(kp + 224); F.ws = *(unsigned char* const __attribute__((address_space(4)))*)(kp + 232);
}
template <int CTRL> __device__ __forceinline__ float dpp_mov(float v) { return __builtin_bit_cast(float, __builtin_amdgcn_update_dpp(0, __builtin_bit_cast(int, v), CTRL, 0xF, 0xF, true)); }
__device__ __forceinline__ float wave_sum(float v) {
    v += dpp_mov<0xB1>(v); v += dpp_mov<0x4E>(v); v += dpp_mov<0x141>(v); v += dpp_mov<0x140>(v);
    const int vi = __builtin_bit_cast(int, v);
    const float s0 = __builtin_bit_cast(float, __builtin_amdgcn_readlane(vi, 0)), s1 = __builtin_bit_cast(float, __builtin_amdgcn_readlane(vi, 16)),
                s2 = __builtin_bit_cast(float, __builtin_amdgcn_readlane(vi, 32)), s3 = __builtin_bit_cast(float, __builtin_amdgcn_readlane(vi, 48));
    return (s0 + s1) + (s2 + s3);
}
__device__ __forceinline__ float bf2f(bf16 b) { return __uint_as_float((unsigned)b << 16); }

template <int MAP> __device__ __forceinline__ int dest_row(int c) {
    if (MAP == 1) { return c < DFF ? (((c >> 7) << 8) + (c & 127)) : ((((c - DFF) >> 7) << 8) + 128 + ((c - DFF) & 127)); }
    if (MAP == 2) { const int d = c < 3072 ? c : (c < 3088 ? 8192 + (c - 3072) : c - 16);
        if (d >= 4096 && d < 6144) { const int j = d < 5120 ? d - 4096 : d - 5120; return 4096 + ((j >> 7) << 8) + (d < 5120 ? 0 : 128) + (j & 127); }
        return d; }
    return c;
}
template <int MAP> __device__ __forceinline__ void p0_item_load(const float* W, int N, int item, int nblk, int lane, f32x4 (&v)[16]) {
    const int kb = item / nblk, nb = item % nblk, k0 = 64 * kb, n0 = 64 * nb;
    const int n4 = (lane & 15) * 4, kr = lane >> 4;
    const bool nok = n0 + n4 < N;
    const float* p = W + (size_t)(k0 + kr) * N + (nok ? n0 + n4 : 0);
#pragma unroll
    for (int i = 0; i < 16; ++i) v[i] = *(const f32x4*)(p + (size_t)(4 * i) * N);
    if (!nok) {
#pragma unroll
        for (int i = 0; i < 16; ++i) v[i] = v[i] * 0.f; }
}
template <int MAP> __device__ __forceinline__ void p0_item_store(int K, int N, bf16* WT, LAS float* scr, int item, int nblk, int lane, const f32x4 (&v)[16]) {
    const int kb = item / nblk, nb = item % nblk, k0 = 64 * kb, n0 = 64 * nb;
    const int n4 = (lane & 15) * 4, kr = lane >> 4;
#pragma unroll
    for (int i = 0; i < 16; ++i) { LAS float* s = scr + (4 * i + kr) * 65 + n4; s[0] = v[i].x; s[1] = v[i].y; s[2] = v[i].z; s[3] = v[i].w; }
    LDS_WAIT(); asm volatile("" ::: "memory");
    const int c = lane & 7;
#pragma unroll
    for (int j = 0; j < 8; ++j) { const int nl = (lane >> 3) + 8 * j; const LAS float* s = scr + (8 * c) * 65 + nl;
        v4u o; o.x = pk2(s[0 * 65], s[1 * 65]); o.y = pk2(s[2 * 65], s[3 * 65]); o.z = pk2(s[4 * 65], s[5 * 65]); o.w = pk2(s[6 * 65], s[7 * 65]);
        if (n0 + nl < N) *(GAS v4u*)(WT + (size_t)dest_row<MAP>(n0 + nl) * K + k0 + 8 * c) = o; }
    LDS_WAIT(); asm volatile("" ::: "memory");
}
template <int MAP> __device__ __forceinline__ void p0_transpose(Frame& F, const float* W, int K, int N, bf16* WT, int& rot, int wg0 = 0) {
    const int nblk = (N + 63) / 64, nitems = (K / 64) * nblk;
    if (F.vcu < wg0) { rot = (rot + nitems) % 65536; return; }
    LAS float* scr = (LAS float*)(F.lds + RING_OFF + F.wave * 16896);
    const int NGW = (GRID - wg0) * NWAVES; const int gw = ((F.vcu - wg0) * NWAVES + F.wave + NGW - rot % NGW) % NGW;
    f32x4 v[16], vn[16];
    if (gw < nitems) p0_item_load<MAP>(W, N, gw, nblk, F.lane, v);
    for (int it = gw; it < nitems; it += NGW) {
        const bool more = it + NGW < nitems;
        if (more) p0_item_load<MAP>(W, N, it + NGW, nblk, F.lane, vn);
        p0_item_store<MAP>(K, N, WT, scr, it, nblk, F.lane, v);
        if (more) {
#pragma unroll
            for (int i = 0; i < 16; ++i) v[i] = vn[i]; }
    }
    rot = (rot + nitems) % 65536;
}
__device__ __forceinline__ void p0a_prologue(Frame& F) {
    frame_refresh(F);
    int rot = 0;
    for (int l = 0; l < DEPTH; ++l) p0_transpose<0>(F, in_ptr(7) + (size_t)l * DM * NMOD, DM, NMOD, (bf16*)(F.ws + WS_P) + (size_t)l * NMOD * DM, rot);
    const int gt = F.vcu * (NWAVES * 64) + F.tid, NT = GRID * NWAVES * 64;
    { float* gn = (float*)(F.ws + WS_GN);
      for (int i = gt; i < 6 * DM; i += NT) { const int l = i / (3 * DM), j = (i / DM) % 3, c = i & (DM - 1); const float* s9 = in_ptr(9); const float* s10 = in_ptr(10); const float* s11 = in_ptr(11);
          const float v0 = s9[l * DM + c], v1 = s10[l * DM + c], v2 = s11[l * DM + c]; gn[i] = j == 0 ? v0 : (j == 1 ? v1 : v2); } }
    { bf16* ca = (bf16*)(F.ws + WS_CA);
      for (int i = gt; i < 256 * DM; i += NT) { const int r = i >> 10, c = i & 1023; float v = 0.f;
          if (r < NB_P) v = in_ptr(2)[r * DM + c]; else if (r < NSEQ) v = in_ptr(3)[(r - NB_P) * DM + c];
          ca[i] = (bf16)f2bf(r < NSEQ ? v / (1.f + __expf(-v)) : 0.f); } }
}
#ifndef FILLW_ON
#define FILLW_ON 1
#endif
constexpr bool FILLW = FILLW_ON;
#ifndef P0B_LAST_ALL
#define P0B_LAST_ALL 0
#endif
#ifndef P0B_WIN_ALL
#define P0B_WIN_ALL 0
#endif
__device__ __forceinline__ void p0_fill(Frame& F, int k) {
    frame_refresh(F);
    constexpr int l = 1; int rot = 0;
    if (k == 0) { p0_transpose<1>(F, in_ptr(12) + (size_t)l * DM * 2 * DFF, DM, 2 * DFF, wt_ptr(F, l, WO_GU1), rot); }
    if (k == 1) { p0_transpose<0>(F, in_ptr(13) + (size_t)l * DFF * DM, DFF, DM, wt_ptr(F, l, WO_D1), rot);
                  p0_transpose<0>(F, in_ptr(23) + (size_t)l * DM * DM, DM, DM, wt_ptr(F, l, WO_SSD), rot);
                  p0_transpose<0>(F, in_ptr(25) + (size_t)l * DM * DM, DM, DM, wt_ptr(F, l, WO_SC), rot);
                  p0_transpose<0>(F, in_ptr(26) + (size_t)l * DM * DM, DM, DM, wt_ptr(F, l, WO_O), rot); }
    if (k == 2) { p0_transpose<2>(F, in_ptr(16) + (size_t)l * DM * DPROJ, DM, DPROJ, wt_ptr(F, l, WO_IN), rot); }
    if (k == 3) { p0_transpose<1>(F, in_ptr(14) + (size_t)l * DM * 2 * DFF, DM, 2 * DFF, wt_ptr(F, l, WO_GU2), rot);
                  p0_transpose<0>(F, in_ptr(15) + (size_t)l * DFF * DM, DFF, DM, wt_ptr(F, l, WO_D2), rot); }
}
__device__ __forceinline__ void p0b_prologue(Frame& F, int wg0) {
    frame_refresh(F);
    int rot = 0;
    for (int l = 0; l < (FILLW ? 1 : DEPTH); ++l) {
        const int w0 = l == 0 ? wg0 : 0;
        p0_transpose<1>(F, in_ptr(12) + (size_t)l * DM * 2 * DFF, DM, 2 * DFF, wt_ptr(F, l, WO_GU1), rot, w0);
        p0_transpose<0>(F, in_ptr(13) + (size_t)l * DFF * DM, DFF, DM, wt_ptr(F, l, WO_D1), rot, w0);
        p0_transpose<0>(F, in_ptr(23) + (size_t)l * DM * DM, DM, DM, wt_ptr(F, l, WO_SSD), rot, w0);
        p0_transpose<0>(F, in_ptr(25) + (size_t)l * DM * DM, DM, DM, wt_ptr(F, l, WO_SC), rot, w0);
        p0_transpose<0>(F, in_ptr(26) + (size_t)l * DM * DM, DM, DM, wt_ptr(F, l, WO_O), rot, w0);
        p0_transpose<2>(F, in_ptr(16) + (size_t)l * DM * DPROJ, DM, DPROJ, wt_ptr(F, l, WO_IN), rot, P0B_WIN_ALL ? 0 : w0);
        p0_transpose<1>(F, in_ptr(14) + (size_t)l * DM * 2 * DFF, DM, 2 * DFF, wt_ptr(F, l, WO_GU2), rot, P0B_LAST_ALL ? 0 : w0);
        p0_transpose<0>(F, in_ptr(15) + (size_t)l * DFF * DM, DFF, DM, wt_ptr(F, l, WO_D2), rot, P0B_LAST_ALL ? 0 : w0);
    }
}

__device__ __forceinline__ void norm0_phase(Frame& F) {
    frame_refresh(F);
    const int gw = F.vcu * NWAVES + F.wave, NGW = GRID * NWAVES;
    const float* Xp = in_ptr(0); const float* Xs = in_ptr(1); bf16* H = (bf16*)(F.ws + WS_H); const float* GS = gs_ptr(F, 0); const float* SH = mod_ptr(F, 0, 0);
    f32x4 v[4], gv[4], sv[4], vn[4], gn[4], sn[4];
    if (gw < M) { const int mr = mod_row(gw); const f32x4* xr = (const f32x4*)(gw < MP ? Xp + (size_t)gw * DM : Xs + (size_t)(gw - MP) * DM) + F.lane;
        const f32x4* gr = (const f32x4*)(GS + (size_t)mr * DM) + F.lane; const f32x4* sr = (const f32x4*)(SH + (size_t)mr * NMOD) + F.lane;
#pragma unroll
        for (int j = 0; j < 4; ++j) { v[j] = xr[64 * j]; gv[j] = gr[64 * j]; sv[j] = sr[64 * j]; } }
    for (int m = gw; m < M; m += NGW) {
        const int mn = m + NGW;
        if (mn < M) { const int mr = mod_row(mn); const f32x4* xr = (const f32x4*)(mn < MP ? Xp + (size_t)mn * DM : Xs + (size_t)(mn - MP) * DM) + F.lane;
            const f32x4* gr = (const f32x4*)(GS + (size_t)mr * DM) + F.lane; const f32x4* sr = (const f32x4*)(SH + (size_t)mr * NMOD) + F.lane;
#pragma unroll
            for (int j = 0; j < 4; ++j) { vn[j] = xr[64 * j]; gn[j] = gr[64 * j]; sn[j] = sr[64 * j]; } }
        float s = 0.f;
#pragma unroll
        for (int j = 0; j < 4; ++j) s += (v[j].x * v[j].x + v[j].y * v[j].y) + (v[j].z * v[j].z + v[j].w * v[j].w);
        const float r = 1.f / sqrtf(wave_sum(s) * (1.f / DM) + EPS);
        unsigned long long* o8 = (unsigned long long*)(H + (size_t)m * DM) + F.lane;
#pragma unroll
        for (int j = 0; j < 4; ++j) { const f32x4 h = (v[j] * r) * gv[j] + sv[j]; o8[64 * j] = (unsigned long long)pk2(h.x, h.y) | ((unsigned long long)pk2(h.z, h.w) << 32); }
#pragma unroll
        for (int j = 0; j < 4; ++j) { v[j] = vn[j]; gv[j] = gn[j]; sv[j] = sn[j]; }
    }
}
__device__ __forceinline__ void final_norm_phase(Frame& F) {
    frame_refresh(F);
    const int gw = F.vcu * NWAVES + F.wave, NGW = GRID * NWAVES;
    f32x4 gv[4];
#pragma unroll
    for (int j = 0; j < 4; ++j) gv[j] = ((const f32x4*)in_ptr(27))[F.lane + 64 * j];
    f32x4 v[4], vn[4];
    if (gw < M) { const f32x4* xr = (const f32x4*)(F.out + (size_t)gw * DM) + F.lane;
#pragma unroll
        for (int j = 0; j < 4; ++j) v[j] = xr[64 * j]; }
    for (int m = gw; m < M; m += NGW) {
        const int mn = m + NGW;
        if (mn < M) { const f32x4* xr = (const f32x4*)(F.out + (size_t)mn * DM) + F.lane;
#pragma unroll
            for (int j = 0; j < 4; ++j) vn[j] = xr[64 * j]; }
        f32x4* xo = (f32x4*)(F.out + (size_t)m * DM) + F.lane;
        float s = 0.f;
#pragma unroll
        for (int j = 0; j < 4; ++j) s += (v[j].x * v[j].x + v[j].y * v[j].y) + (v[j].z * v[j].z + v[j].w * v[j].w);
        const float r = 1.f / sqrtf(wave_sum(s) * (1.f / DM) + EPS);
#pragma unroll
        for (int j = 0; j < 4; ++j) xo[64 * j] = (v[j] * r) * gv[j];
#pragma unroll
        for (int j = 0; j < 4; ++j) v[j] = vn[j];
    }
}

__device__ __forceinline__ void dt_phase(Frame& F, int layer) {
    frame_refresh(F);
    if (F.bx < (GRID >> 1)) return;
    const int gw = (F.bx - (GRID >> 1)) * NWAVES + F.wave, NGW = (GRID >> 1) * NWAVES;
    const bf16* H = (const bf16*)(F.ws + WS_H); const bf16* Wd = wt_ptr(F, layer, WO_IN) + (size_t)8192 * DM;
    float* DT = (float*)(F.ws + WS_DT);
    const int fr = F.lane & 15, fq = F.lane >> 4;
    const float bias = in_ptr(19)[layer * 16 + fr];
    for (int it = gw; it < M / 16; it += NGW) {
        const bf16* ap = H + (size_t)(it * 16 + fr) * DM + 8 * fq; const bf16* bp = Wd + (size_t)fr * DM + 8 * fq;
        f32x4 acc = {0.f, 0.f, 0.f, 0.f};
#pragma unroll 8
        for (int kk = 0; kk < DM / 32; ++kk) { const bf16x8 a = *(const bf16x8*)(ap + kk * 32), b = *(const bf16x8*)(bp + kk * 32);
            acc = __builtin_amdgcn_mfma_f32_16x16x32_bf16(a, b, acc, 0, 0, 0); }
#pragma unroll
        for (int r = 0; r < 4; ++r) { const int row = it * 16 + 4 * fq + r;
            const float x = acc[r] + bias; const float e = __expf(-fabsf(x)); const float l1p = e < 1e-3f ? e * (1.f - 0.5f * e) : __logf(1.f + e);
            const float sp = fmaxf(x, 0.f) + l1p; DT[(size_t)row * 16 + fr] = sp; }
    }
}

struct SCRows { v4u p0, bb, p1, p2; };
__device__ __forceinline__ void sc_load(const bf16* SB, const bf16* SP, int idx, SCRows& R) {
    const int m = idx >> 7, j0 = (idx & 127) * 8;
    const int t = m < MP ? (m & (SEQ_P - 1)) : ((m - MP) & (SEQ_S - 1));
    const size_t ro = (size_t)m * DM + j0, r1 = ro - (t >= 1 ? DM : 0), r2 = ro - (t >= 2 ? 2 * DM : 0);
    R.p0 = *(const v4u*)(SP + ro); R.bb = *(const v4u*)(SB + ro); R.p1 = *(const v4u*)(SP + r1); R.p2 = *(const v4u*)(SP + r2);
}
__device__ __forceinline__ void sc_unpk(const v4u& c, float (&p)[8]) {
    p[0] = bf_lo(c.x); p[1] = bf_hi(c.x); p[2] = bf_lo(c.y); p[3] = bf_hi(c.y); p[4] = bf_lo(c.z); p[5] = bf_hi(c.z); p[6] = bf_lo(c.w); p[7] = bf_hi(c.w);
}
__device__ __forceinline__ void shortconv_phase(Frame& F, int layer) {
    frame_refresh(F);
    const int gt = F.vcu * (NWAVES * 64) + F.tid, NT = GRID * NWAVES * 64;
    bf16* SB = proj_ptr(F, PT_SCB); const bf16* SP = proj_ptr(F, PT_SCC);
    const float* cw = in_ptr(24) + (size_t)layer * 3 * DM;
    const float* st = in_ptr(6) + (size_t)layer * NB_S * 2 * DM;
    float* o_p = F.out + (size_t)M * DM + (size_t)DEPTH * NB_P * 16 * 64 * 128 + (size_t)DEPTH * NB_P * 3 * DXBC + (size_t)layer * NB_P * 2 * DM;
    float* o_s = F.out + (size_t)M * DM + (size_t)DEPTH * NB_P * 16 * 64 * 128 + (size_t)DEPTH * NB_P * 3 * DXBC + (size_t)DEPTH * NB_P * 2 * DM
                 + (size_t)DEPTH * NB_S * 16 * 64 * 128 + (size_t)DEPTH * NB_S * 3 * DXBC + (size_t)layer * NB_S * 2 * DM;
    constexpr int NIT = M * (DM / 8);
    SCRows R, Rn;
    if (gt < NIT) sc_load(SB, SP, gt, R);
    for (int idx = gt; idx < NIT; idx += NT) {
        if (idx + NT < NIT) sc_load(SB, SP, idx + NT, Rn);
        const int m = idx >> 7, j0 = (idx & 127) * 8;
        const bool prm = m < MP; const int t = prm ? (m & (SEQ_P - 1)) : ((m - MP) & (SEQ_S - 1)); const int sq = prm ? (m >> 11) : ((m - MP) >> 3); const int L = prm ? SEQ_P : SEQ_S;
        const size_t ro = (size_t)m * DM + j0;
        float cur[8], p1[8], p2[8], bv[8];
        sc_unpk(R.p0, cur); sc_unpk(R.p1, p1); sc_unpk(R.p2, p2); sc_unpk(R.bb, bv);
        if (t < 2) {
#pragma unroll
            for (int i = 0; i < 8; ++i) { if (t < 1) p1[i] = prm ? 0.f : st[((size_t)sq * 2 + 1) * DM + j0 + i]; p2[i] = prm ? 0.f : st[((size_t)sq * 2 + t) * DM + j0 + i]; } }
        float o[8];
#pragma unroll
        for (int i = 0; i < 8; ++i) o[i] = bv[i] * (cw[j0 + i] * p2[i] + cw[DM + j0 + i] * p1[i] + cw[2 * DM + j0 + i] * cur[i]);
        v4u w; w.x = pk2(o[0], o[1]); w.y = pk2(o[2], o[3]); w.z = pk2(o[4], o[5]); w.w = pk2(o[6], o[7]);
        *(v4u*)(SB + ro) = w;
        if (t >= L - 2) { float* op = (prm ? o_p : o_s) + ((size_t)sq * 2 + (t - (L - 2))) * DM + j0;
            *(f32x4*)op = (f32x4){cur[0], cur[1], cur[2], cur[3]}; *(f32x4*)(op + 4) = (f32x4){cur[4], cur[5], cur[6], cur[7]}; }
        R = Rn;
    }
}

__device__ __forceinline__ void ssd_unit(Frame& F, int layer, int seq, int g) {
    frame_refresh(F);
    const int tid = F.tid, lane = F.lane, wave = F.wave;
    constexpr bool prm = false; const int L = SEQ_S; const int sq = seq - NB_P;
    const size_t mbase = prm ? (size_t)seq * SEQ_P : (size_t)MP + (size_t)sq * SEQ_S;
    LAS float* cv = (LAS float*)(F.lds); LAS float* ybuf = (LAS float*)(F.lds + 16384); LAS float* dts = (LAS float*)(F.lds + 24576); LAS float* dAs = (LAS float*)(F.lds + 24704);
    const bf16* src; int col, chan;
    if (tid < 256) { src = proj_ptr(F, PT_XS); col = g * 256 + tid; chan = col; }
    else if (tid < 384) { src = proj_ptr(F, PT_BC); col = g * 128 + (tid - 256); chan = 1024 + col; }
    else { src = proj_ptr(F, PT_BC); col = 512 + g * 128 + (tid - 384); chan = 1024 + col; }
    const float* cwp = in_ptr(17) + (size_t)layer * 4 * DXBC + chan;
    const float cw0 = cwp[0], cw1 = cwp[DXBC], cw2 = cwp[2 * DXBC], cw3 = cwp[3 * DXBC], cb = in_ptr(18)[(size_t)layer * DXBC + chan];
    float w0, w1, w2;
    { const float* cs = in_ptr(5) + ((size_t)layer * NB_S + sq) * 3 * DXBC + chan; w0 = cs[0]; w1 = cs[DXBC]; w2 = cs[2 * DXBC]; }
    const int hh = tid >> 7, i7 = tid & 127, nseg = i7 & 7, pg = i7 >> 3, head = g * 4 + hh;
    float s[4][16];
    float* nst = F.out + (size_t)M * DM + (prm ? (size_t)0 : (size_t)DEPTH * NB_P * 16 * 8192 + (size_t)DEPTH * NB_P * 3 * DXBC + (size_t)DEPTH * NB_P * 2 * DM)
                 + (((size_t)layer * (prm ? NB_P : NB_S) + sq) * 16 + head) * 8192;
    if (prm) {
#pragma unroll
        for (int r = 0; r < 4; ++r)
#pragma unroll
            for (int i = 0; i < 16; ++i) s[r][i] = 0.f;
    } else { const float* sp = in_ptr(4) + (((size_t)layer * NB_S + sq) * 16 + head) * 8192;
#pragma unroll
        for (int r = 0; r < 4; ++r)
#pragma unroll
            for (int q = 0; q < 4; ++q) { const f32x4 v = *(const f32x4*)(sp + (size_t)(pg + 16 * r) * 128 + 16 * nseg + 4 * q); s[r][4 * q] = v.x; s[r][4 * q + 1] = v.y; s[r][4 * q + 2] = v.z; s[r][4 * q + 3] = v.w; } }
    const float* DT = (const float*)(F.ws + WS_DT);
    bf16* Z = proj_ptr(F, PT_Z);
    const int ech = lane * 4;
    const float Dh = in_ptr(21)[layer * 16 + g * 4 + (ech >> 6)];
    const f32x4 nw = *(const f32x4*)(in_ptr(22) + (size_t)layer * DM + g * 256 + ech);
    float a_neg = 0.f;
    if (tid < 32) a_neg = -__expf(in_ptr(20)[layer * 16 + g * 4 + (tid & 3)]);
    float pre[8];
#pragma unroll
    for (int j = 0; j < 8; ++j) pre[j] = bf2f(src[(mbase + j) * DM + col]);
    for (int t0 = 0; t0 < L; t0 += 8) {
        const unsigned long long zw = *(const unsigned long long*)(Z + (mbase + t0 + wave) * DM + g * 256 + ech);
        float dtv_l = 0.f; if (tid < 32) dtv_l = DT[(mbase + t0 + (tid >> 2)) * 16 + g * 4 + (tid & 3)];
#pragma unroll
        for (int j = 0; j < 8; ++j) { const float v = cw0 * w0 + cw1 * w1 + cw2 * w2 + cw3 * pre[j] + cb; w0 = w1; w1 = w2; w2 = pre[j]; cv[j * 512 + tid] = fast_silu(v); }
        if (t0 + 8 < L) {
#pragma unroll
            for (int j = 0; j < 8; ++j) pre[j] = bf2f(src[(mbase + t0 + 8 + j) * DM + col]); }
        if (tid < 32) { dts[tid] = dtv_l; dAs[tid] = __expf(dtv_l * a_neg); }
        __syncthreads();
#pragma unroll 1
        for (int j = 0; j < 8; ++j) {
            const float dtv = dts[j * 4 + hh], dA = dAs[j * 4 + hh];
            float Bv[16], Cv[16];
#pragma unroll
            for (int q = 0; q < 4; ++q) { const f32x4 b4 = *(const LAS f32x4*)(cv + j * 512 + 256 + 16 * nseg + 4 * q), c4 = *(const LAS f32x4*)(cv + j * 512 + 384 + 16 * nseg + 4 * q);
                Bv[4 * q] = b4.x; Bv[4 * q + 1] = b4.y; Bv[4 * q + 2] = b4.z; Bv[4 * q + 3] = b4.w; Cv[4 * q] = c4.x; Cv[4 * q + 1] = c4.y; Cv[4 * q + 2] = c4.z; Cv[4 * q + 3] = c4.w; }
#pragma unroll
            for (int r = 0; r < 4; ++r) { const float xv = cv[j * 512 + hh * 64 + pg + 16 * r]; const float coef = dtv * xv; float acc = 0.f;
#pragma unroll
                for (int i = 0; i < 16; ++i) { s[r][i] = dA * s[r][i] + coef * Bv[i]; acc += Cv[i] * s[r][i]; }
                acc += __shfl_xor(acc, 1); acc += __shfl_xor(acc, 2); acc += __shfl_xor(acc, 4);
                if (nseg == 0) ybuf[j * 256 + hh * 64 + pg + 16 * r] = acc; }
        }
        __syncthreads();
        {
            const f32x4 y4 = *(const LAS f32x4*)(ybuf + wave * 256 + ech), x4 = *(const LAS f32x4*)(cv + wave * 512 + ech);
            const unsigned zl = (unsigned)zw, zh = (unsigned)(zw >> 32);
            f32x4 y;
            y.x = (y4.x + x4.x * Dh) * fast_silu(bf_lo(zl)); y.y = (y4.y + x4.y * Dh) * fast_silu(bf_hi(zl));
            y.z = (y4.z + x4.z * Dh) * fast_silu(bf_lo(zh)); y.w = (y4.w + x4.w * Dh) * fast_silu(bf_hi(zh));
            const float ss = wave_sum((y.x * y.x + y.y * y.y) + (y.z * y.z + y.w * y.w));
            const float r = 1.f / sqrtf(ss * (1.f / 256.f) + EPS);
            const f32x4 o = (y * r) * nw;
            *(unsigned long long*)DRYP(Z + (mbase + t0 + wave) * DM + g * 256 + ech) = (unsigned long long)pk2(o.x, o.y) | ((unsigned long long)pk2(o.z, o.w) << 32);
        }
        __syncthreads();
    }
#pragma unroll
    for (int r = 0; r < 4; ++r)
#pragma unroll
        for (int q = 0; q < 4; ++q) *(f32x4*)(nst + (size_t)(pg + 16 * r) * 128 + 16 * nseg + 4 * q) = (f32x4){s[r][4 * q], s[r][4 * q + 1], s[r][4 * q + 2], s[r][4 * q + 3]};
    { float* oc = F.out + (size_t)M * DM + (size_t)DEPTH * NB_P * 16 * 8192
                  + (prm ? (size_t)0 : (size_t)DEPTH * NB_P * 3 * DXBC + (size_t)DEPTH * NB_P * 2 * DM + (size_t)DEPTH * NB_S * 16 * 8192)
                  + ((size_t)layer * (prm ? NB_P : NB_S) + sq) * 3 * DXBC + chan;
      oc[0] = w0; oc[DXBC] = w1; oc[2 * DXBC] = w2; }
}

constexpr int XT_OFF = 0, SPITCH = 272, BM_OFF = 256 * SPITCH, CM_OFF = BM_OFF + 128 * SPITCH, ACUM_OFF = CM_OFF + 128 * SPITCH,
              DTV_OFF = ACUM_OFF + 2048, SCL_OFF = DTV_OFF + 2048, RED_OFF = SCL_OFF + 2048, SSD_LDS_END = RED_OFF + 2048;
static_assert(SSD_LDS_END <= LDSCTL_OFF, "ssd LDS image");
typedef float f32x16 __attribute__((ext_vector_type(16)));
typedef short s16x4 __attribute__((ext_vector_type(4)));
typedef float f32x2_t __attribute__((ext_vector_type(2))); typedef __bf16 bf16x2_t __attribute__((ext_vector_type(2)));
__device__ __forceinline__ unsigned cvtpk(float lo, float hi) { f32x2_t v = {lo, hi}; bf16x2_t b = __builtin_convertvector(v, bf16x2_t); return __builtin_bit_cast(unsigned, b); }
__device__ __forceinline__ bf16x8 pack8(float a0, float a1, float a2, float a3, float a4, float a5, float a6, float a7) {
    v4u w; w.x = cvtpk(a0, a1); w.y = cvtpk(a2, a3); w.z = cvtpk(a4, a5); w.w = cvtpk(a6, a7); return __builtin_bit_cast(bf16x8, w); }
__device__ __forceinline__ int crow(int reg, int h) { return (reg & 3) + 8 * (reg >> 2) + 4 * h; }
#define MFMA32(a, b, c) __builtin_amdgcn_mfma_f32_32x32x16_bf16((a), (b), (c), 0, 0, 0)

template <bool S1> __device__ __forceinline__ void ssd_stage(Frame& F, int layer, int b, int c, int g) {
    const int tid = F.tid, lane = F.lane, wave = F.wave;
    const size_t m0 = (size_t)b * SEQ_P + (size_t)c * 128;
    LAS float* acum = (LAS float*)(F.lds + ACUM_OFF); LAS float* dtv = (LAS float*)(F.lds + DTV_OFF); LAS float* scl = (LAS float*)(F.lds + SCL_OFF);
    const float* DT = (const float*)(F.ws + WS_DT);
    float d0 = 0.f, d1 = 0.f, a_dt = 0.f;
    if (wave < 4) { a_dt = -__expf(in_ptr(20)[layer * 16 + g * 4 + wave]); d0 = DT[(m0 + 2 * lane) * 16 + g * 4 + wave]; d1 = DT[(m0 + 2 * lane + 1) * 16 + g * 4 + wave]; }
    {
        const bool xrole = wave < 4;
        int cgl, seg; bool active = true;
        if (xrole) { cgl = lane & 31; seg = 2 * wave + (lane >> 5); }
        else if (S1) { cgl = lane & 15; seg = 4 * (wave - 4) + (lane >> 4); active = wave < 6; }
        else { cgl = lane & 31; seg = 2 * (wave - 4) + (lane >> 5); }
        const int bccol = (cgl < 16 ? g * 128 + 8 * cgl : 512 + g * 128 + 8 * (cgl - 16));
        const unsigned char* sbase = (const unsigned char*)proj_ptr(F, xrole ? PT_XS : PT_BC);
        const int chan = xrole ? g * 256 + 8 * cgl : 1024 + bccol;
        const unsigned soff = (unsigned)(((int)m0 + 16 * seg - 3) * DM + (xrole ? g * 256 + 8 * cgl : bccol)) * 2u;
        const bool seq_start = (c == 0 && seg == 0); const unsigned halo_msk = seq_start ? 0u : 0xffffffffu; const int halo_skip = seq_start ? 3 : 0;
        v4u P[19]; float cwf[4][8], cbf[8];
        if (active) {
#pragma unroll
            for (int i = 0; i < 19; ++i) P[i] = *(const v4u*)(sbase + (soff + (unsigned)(i < 3 ? i + halo_skip : i) * 2048u));
#pragma unroll
            for (int i = 0; i < 3; ++i) { P[i].x &= halo_msk; P[i].y &= halo_msk; P[i].z &= halo_msk; P[i].w &= halo_msk; }
            { const float* cwp = in_ptr(17) + (size_t)layer * 4 * DXBC + chan;
#pragma unroll
              for (int k = 0; k < 4; ++k) { const f32x4 a = *(const f32x4*)(cwp + (size_t)k * DXBC), bq = *(const f32x4*)(cwp + (size_t)k * DXBC + 4);
                  cwf[k][0] = a.x; cwf[k][1] = a.y; cwf[k][2] = a.z; cwf[k][3] = a.w; cwf[k][4] = bq.x; cwf[k][5] = bq.y; cwf[k][6] = bq.z; cwf[k][7] = bq.w; }
              const float* cbp = in_ptr(18) + (size_t)layer * DXBC + chan; const f32x4 a = *(const f32x4*)cbp, bq = *(const f32x4*)(cbp + 4);
              cbf[0] = a.x; cbf[1] = a.y; cbf[2] = a.z; cbf[3] = a.w; cbf[4] = bq.x; cbf[5] = bq.y; cbf[6] = bq.z; cbf[7] = bq.w; }
        }
        if (wave < 4) {
            const int hh = wave; const float a = a_dt;
            const float v0 = d0 * a, v1 = d1 * a; const float s = v0 + v1; float sc = s;
#pragma unroll
            for (int o = 1; o < 64; o <<= 1) { const float u = __shfl_up(sc, o); if (lane >= o) sc += u; }
            const float ex = sc - s, a0 = ex + v0, a1 = ex + s, tot = __shfl(sc, 63);
            dtv[hh * 128 + 2 * lane] = d0; dtv[hh * 128 + 2 * lane + 1] = d1;
            acum[hh * 128 + 2 * lane] = a0; acum[hh * 128 + 2 * lane + 1] = a1;
            if (S1) { scl[hh * 128 + 2 * lane] = d0 * __expf(tot - a0); scl[hh * 128 + 2 * lane + 1] = d1 * __expf(tot - a1);
                if (lane == 0) ((float*)(F.ws + WS_CD))[(b * 16 + c) * 16 + g * 4 + hh] = __expf(tot); } }
        if (S1) __syncthreads();
        if (active) {
#define XV(i, e) ((((e) & 1) ? bf_hi(P[(i)][(e) >> 1]) : bf_lo(P[(i)][(e) >> 1])))
#define CONV(tt, e) fast_silu(cwf[0][e] * XV(tt, e) + cwf[1][e] * XV((tt) + 1, e) + cwf[2][e] * XV((tt) + 2, e) + cwf[3][e] * XV((tt) + 3, e) + cbf[e])
            if (xrole || S1) {
                LAS unsigned char* dst = F.lds + (xrole ? XT_OFF : BM_OFF) + (8 * cgl) * SPITCH + 32 * seg;
                float sc[16];
                if (S1 && xrole) { const LAS float* sp4 = scl + (cgl >> 3) * 128 + 16 * seg;
#pragma unroll
                    for (int q = 0; q < 4; ++q) { const f32x4 t4 = *(const LAS f32x4*)(sp4 + 4 * q); sc[4 * q] = t4.x; sc[4 * q + 1] = t4.y; sc[4 * q + 2] = t4.z; sc[4 * q + 3] = t4.w; } }
#pragma unroll
                for (int e = 0; e < 8; ++e) { float o[16];
#pragma unroll
                    for (int tt = 0; tt < 16; ++tt) { o[tt] = CONV(tt, e); if (S1 && xrole) o[tt] *= sc[tt]; }
                    *(LAS bf16x8*)(dst + e * SPITCH) = pack8(o[0], o[1], o[2], o[3], o[4], o[5], o[6], o[7]);
                    *(LAS bf16x8*)(dst + e * SPITCH + 16) = pack8(o[8], o[9], o[10], o[11], o[12], o[13], o[14], o[15]); }
            } else {
                LAS unsigned char* dst = F.lds + (cgl < 16 ? BM_OFF + 16 * cgl : CM_OFF + 16 * (cgl - 16)) + (16 * seg) * SPITCH;
#pragma unroll
                for (int tt = 0; tt < 16; ++tt) { float o[8];
#pragma unroll
                    for (int e = 0; e < 8; ++e) o[e] = CONV(tt, e);
                    *(LAS bf16x8*)(dst + tt * SPITCH) = pack8(o[0], o[1], o[2], o[3], o[4], o[5], o[6], o[7]); }
            }
            if (!S1 && c == 15 && seg == 7) {
                float* oc = F.out + (size_t)M * DM + (size_t)DEPTH * NB_P * 16 * 8192 + ((size_t)layer * NB_P + b) * 3 * DXBC + chan;
#pragma unroll
                for (int k = 0; k < 3; ++k) { const v4u w = P[16 + k];
                    *(f32x4*)(oc + (size_t)k * DXBC) = (f32x4){bf_lo(w.x), bf_hi(w.x), bf_lo(w.y), bf_hi(w.y)}; *(f32x4*)(oc + (size_t)k * DXBC + 4) = (f32x4){bf_lo(w.z), bf_hi(w.z), bf_lo(w.w), bf_hi(w.w)}; }
            }
#undef XV
#undef CONV
        }
    }
    __syncthreads();
}

__device__ __forceinline__ void ssd_s1_unit(Frame& F, int layer, int b, int c, int g) {
    frame_refresh(F);
    ssd_stage<true>(F, layer, b, c, g);
    const int lane = F.lane, wave = F.wave, hh = wave >> 1, ph = wave & 1, r = lane & 31, h = lane >> 5;
    f32x16 acc[4];
#pragma unroll
    for (int nt = 0; nt < 4; ++nt)
#pragma unroll
        for (int i = 0; i < 16; ++i) acc[nt][i] = 0.f;
    const LAS unsigned char* ap = F.lds + XT_OFF + (hh * 64 + ph * 32 + r) * SPITCH + h * 16;
    const LAS unsigned char* bp = F.lds + BM_OFF + r * SPITCH + h * 16;
#pragma unroll
    for (int ks = 0; ks < 8; ++ks) { const bf16x8 a = *(const LAS bf16x8*)(ap + ks * 32);
#pragma unroll
        for (int nt = 0; nt < 4; ++nt) { const bf16x8 bb = *(const LAS bf16x8*)(bp + nt * 32 * SPITCH + ks * 32); acc[nt] = MFMA32(a, bb, acc[nt]); } }
    __syncthreads();
    {   LAS float* simg = (LAS float*)(F.lds) + wave * (32 * 132);
#pragma unroll
        for (int nt = 0; nt < 4; ++nt)
#pragma unroll
            for (int i = 0; i < 16; ++i) simg[crow(i, h) * 132 + nt * 32 + r] = acc[nt][i];
        v4u* st = (v4u*)((bf16*)(F.ws + WS_S) + ((size_t)(b * 16 + c) * 16 + g * 4 + hh) * 8192 + (size_t)(ph * 32) * 128);
#pragma unroll
        for (int i = 0; i < 8; ++i) { const int idx = i * 64 + lane; const LAS float* sp = simg + (idx >> 4) * 132 + (idx & 15) * 8; const f32x4 v0 = *(const LAS f32x4*)sp, v1 = *(const LAS f32x4*)(sp + 4);
            v4u w; w.x = cvtpk(v0.x, v0.y); w.y = cvtpk(v0.z, v0.w); w.z = cvtpk(v1.x, v1.y); w.w = cvtpk(v1.z, v1.w); st[idx] = w; } }
    __syncthreads();
}

__device__ __forceinline__ void ssd_s2_phase(Frame& F, int layer) {
    frame_refresh(F);
    const int it = F.vcu * (NWAVES * 64) + F.tid;
    const v4u* ST = (const v4u*)(F.ws + WS_S); const float* CD = (const float*)(F.ws + WS_CD); v4u* SB16 = (v4u*)(F.ws + WS_H);
    f32x4* o = (f32x4*)(F.out + (size_t)M * DM + (size_t)layer * NB_P * 16 * 8192);
    static_assert(NB_P * 16 * 1024 == GRID * NWAVES * 64, "one item per thread");
    const int q = it & 1023, head = (it >> 10) & 15, b = it >> 14;
    v4u v[16];
#pragma unroll
    for (int c = 0; c < 16; ++c) v[c] = ST[((size_t)(b * 16 + c) * 16 + head) * 1024 + q];
    float z0 = 0.f; asm volatile("" : "+v"(z0));
    f32x4 c0 = {z0, z0, z0, z0}, c1 = {z0, z0, z0, z0};
#pragma unroll
    for (int c = 0; c < 16; ++c) { const float d = CD[(b * 16 + c) * 16 + head];
        v4u w; w.x = pk2(c0.x, c0.y); w.y = pk2(c0.z, c0.w); w.z = pk2(c1.x, c1.y); w.w = pk2(c1.z, c1.w);
        SB16[((size_t)(b * 16 + c) * 16 + head) * 1024 + q] = w;
        c0 = c0 * d + (f32x4){bf_lo(v[c].x), bf_hi(v[c].x), bf_lo(v[c].y), bf_hi(v[c].y)}; c1 = c1 * d + (f32x4){bf_lo(v[c].z), bf_hi(v[c].z), bf_lo(v[c].w), bf_hi(v[c].w)}; }
    o[((size_t)b * 16 + head) * 2048 + 2 * q] = c0; o[((size_t)b * 16 + head) * 2048 + 2 * q + 1] = c1;
}

__device__ __forceinline__ void ssd_s3_unit(Frame& F, int layer, int b, int c, int g, bool first, const XcdBarrier& bar, unsigned* bar2, unsigned gen) {
    frame_refresh(F);
#ifdef DUP_STG
    ssd_stage<false>(F, layer, b, c, g);
#endif
    ssd_stage<false>(F, layer, b, c, g);
    if (first) xcd_wait(bar, bar2, gen);
    bf16x8 sfr[8][2];
    {   const int hh_ = F.wave >> 1, r_ = F.lane & 31, h_ = F.lane >> 5;
        const bf16* sb = (const bf16*)(F.ws + WS_H) + ((size_t)(b * 16 + c) * 16 + g * 4 + hh_) * 8192 + (size_t)r_ * 128 + 8 * h_;
#pragma unroll
        for (int ks = 0; ks < 8; ++ks)
#pragma unroll
            for (int pt = 0; pt < 2; ++pt) sfr[ks][pt] = *(const bf16x8*)(sb + pt * 32 * 128 + 16 * ks); }
    const int lane = F.lane, wave = F.wave, hh = wave >> 1, lh = wave & 1, r = lane & 31, h = lane >> 5, head = g * 4 + hh;
    const int LT0 = lh, LT1 = 3 - lh;
#define LTILE(lt) ((lt) == 0 ? LT0 : LT1)
    const size_t m0 = (size_t)b * SEQ_P + (size_t)c * 128;
    const LAS float* ac = (const LAS float*)(F.lds + ACUM_OFF) + hh * 128; const LAS float* dv = (const LAS float*)(F.lds + DTV_OFF) + hh * 128;
    f32x16 y[2][2];
#pragma unroll
    for (int lt = 0; lt < 2; ++lt)
#pragma unroll
        for (int pt = 0; pt < 2; ++pt)
#pragma unroll
            for (int i = 0; i < 16; ++i) y[lt][pt][i] = 0.f;
    unsigned long long zw[16];
    const unsigned char* zbase = (const unsigned char*)proj_ptr(F, PT_Z);
    const unsigned zoff0 = (unsigned)(((int)m0 + wave) * DM + g * 256 + lane * 4) * 2u;
    {
#pragma unroll
        for (int k = 0; k < 16; ++k) zw[k] = *(const unsigned long long*)(zbase + (zoff0 + (unsigned)k * (8u * DM * 2u))); }
    {
#pragma unroll
        for (int ks = 0; ks < 8; ++ks) {
#pragma unroll
            for (int lt = 0; lt < 2; ++lt) { const bf16x8 a = *(const LAS bf16x8*)(F.lds + CM_OFF + (32 * LTILE(lt) + r) * SPITCH + 32 * ks + 16 * h);
#pragma unroll
                for (int pt = 0; pt < 2; ++pt) y[lt][pt] = MFMA32(a, sfr[ks][pt], y[lt][pt]); }
        }
#pragma unroll
        for (int lt = 0; lt < 2; ++lt)
#pragma unroll
            for (int i = 0; i < 16; ++i) { const float e = __expf(ac[32 * LTILE(lt) + crow(i, h)]); y[lt][0][i] *= e; y[lt][1][i] *= e; }
    }
#pragma unroll
    for (int lt = 0; lt < 2; ++lt) { const int L = LTILE(lt); const float al = ac[32 * L + r];
#pragma unroll 1
        for (int S = 0; S <= L; ++S) {
            f32x16 xt;
#pragma unroll
            for (int i = 0; i < 16; ++i) xt[i] = 0.f;
#pragma unroll
            for (int ks = 0; ks < 8; ++ks) { const bf16x8 a = *(const LAS bf16x8*)(F.lds + BM_OFF + (32 * S + r) * SPITCH + 32 * ks + 16 * h);
                const bf16x8 bb = *(const LAS bf16x8*)(F.lds + CM_OFF + (32 * L + r) * SPITCH + 32 * ks + 16 * h); xt = MFMA32(a, bb, xt); }
#pragma unroll
            for (int gq = 0; gq < 4; ++gq) { const f32x4 as4 = *(const LAS f32x4*)(ac + 32 * S + 8 * gq + 4 * h), ds4 = *(const LAS f32x4*)(dv + 32 * S + 8 * gq + 4 * h);
#pragma unroll
                for (int i = 0; i < 4; ++i) { const float arg = fminf(al - as4[i], 0.f); float val = xt[4 * gq + i] * __expf(arg) * ds4[i];
                    if (S == L && (8 * gq + 4 * h + i) > r) val = 0.f; xt[4 * gq + i] = val; } }
#pragma unroll
            for (int k2 = 0; k2 < 2; ++k2) { const bf16x8 aop = pack8(xt[8 * k2], xt[8 * k2 + 1], xt[8 * k2 + 2], xt[8 * k2 + 3], xt[8 * k2 + 4], xt[8 * k2 + 5], xt[8 * k2 + 6], xt[8 * k2 + 7]);
#pragma unroll
                for (int pt = 0; pt < 2; ++pt) { const LAS unsigned char* xp = F.lds + XT_OFF + (hh * 64 + 32 * pt + r) * SPITCH + (32 * S + 16 * k2 + 4 * h) * 2;
                    const s16x4 lo = *(const LAS s16x4*)xp, hi = *(const LAS s16x4*)(xp + 16);
                    const bf16x8 bop = __builtin_shufflevector(lo, hi, 0, 1, 2, 3, 4, 5, 6, 7);
                    y[lt][pt] = MFMA32(aop, bop, y[lt][pt]); } }
        }
    }
    {   const float Dh = in_ptr(21)[layer * 16 + head];
#pragma unroll
        for (int lt = 0; lt < 2; ++lt)
#pragma unroll
            for (int gq = 0; gq < 4; ++gq)
#pragma unroll
                for (int pt = 0; pt < 2; ++pt) { const s16x4 xv = *(const LAS s16x4*)(F.lds + XT_OFF + (hh * 64 + 32 * pt + r) * SPITCH + (32 * LTILE(lt) + 8 * gq + 4 * h) * 2);
#pragma unroll
                    for (int i = 0; i < 4; ++i) y[lt][pt][4 * gq + i] += bf2f((bf16)xv[i]) * Dh; }
    }
    __syncthreads();
    constexpr int YPITCH = 1040;
#pragma unroll
    for (int lt = 0; lt < 2; ++lt)
#pragma unroll
        for (int pt = 0; pt < 2; ++pt)
#pragma unroll
            for (int i = 0; i < 16; ++i) *(LAS float*)(F.lds + (32 * LTILE(lt) + crow(i, h)) * YPITCH + (hh * 64 + 32 * pt + r) * 4) = y[lt][pt][i];
    __syncthreads();
    {   const int ech = lane * 4; const f32x4 nw = *(const f32x4*)(in_ptr(22) + (size_t)layer * DM + g * 256 + ech);
        unsigned zo = zoff0; asm volatile("" : "+v"(zo));
#pragma unroll
        for (int k = 0; k < 16; ++k) { const int l = wave + 8 * k;
            const f32x4 y4 = *(const LAS f32x4*)(F.lds + l * YPITCH + ech * 4);
            const unsigned zl = (unsigned)zw[k], zh = (unsigned)(zw[k] >> 32);
            f32x4 yv;
            yv.x = y4.x * fast_silu(bf_lo(zl)); yv.y = y4.y * fast_silu(bf_hi(zl)); yv.z = y4.z * fast_silu(bf_lo(zh)); yv.w = y4.w * fast_silu(bf_hi(zh));
            const float ss = wave_sum((yv.x * yv.x + yv.y * yv.y) + (yv.z * yv.z + yv.w * yv.w));
            const float rr = 1.f / sqrtf(ss * (1.f / 256.f) + EPS);
            const f32x4 o = (yv * rr) * nw;
            *(unsigned long long*)((unsigned char*)zbase + (zo + (unsigned)k * (8u * DM * 2u))) = (unsigned long long)pk2(o.x, o.y) | ((unsigned long long)pk2(o.z, o.w) << 32); }
    }
    __syncthreads();
#undef LTILE
}
__device__ __forceinline__ void ssd_sample_unit(Frame& F, int layer, int sq, int g) {
    frame_refresh(F);
    const int tid = F.tid, lane = F.lane, wave = F.wave;
    const size_t mbase = (size_t)MP + (size_t)sq * SEQ_S;
    LAS float* cv = (LAS float*)(F.lds); LAS float* ybuf = (LAS float*)(F.lds + 16384); LAS float* dts = (LAS float*)(F.lds + 24576); LAS float* acs = (LAS float*)(F.lds + 24704);
    const bf16* src; int col, chan;
    if (tid < 256) { src = proj_ptr(F, PT_XS); col = g * 256 + tid; chan = col; }
    else if (tid < 384) { src = proj_ptr(F, PT_BC); col = g * 128 + (tid - 256); chan = 1024 + col; }
    else { src = proj_ptr(F, PT_BC); col = 512 + g * 128 + (tid - 384); chan = 1024 + col; }
    float pre[8];
#pragma unroll
    for (int j = 0; j < 8; ++j) pre[j] = bf2f(src[(mbase + j) * DM + col]);
    const float* cwp = in_ptr(17) + (size_t)layer * 4 * DXBC + chan;
    const float cw0 = cwp[0], cw1 = cwp[DXBC], cw2 = cwp[2 * DXBC], cw3 = cwp[3 * DXBC], cb = in_ptr(18)[(size_t)layer * DXBC + chan];
    float w0, w1, w2;
    { const float* cs = in_ptr(5) + ((size_t)layer * NB_S + sq) * 3 * DXBC + chan; w0 = cs[0]; w1 = cs[DXBC]; w2 = cs[2 * DXBC]; }
    bf16* Z = proj_ptr(F, PT_Z);
    const int ech = lane * 4;
    const unsigned long long zw = *(const unsigned long long*)(Z + (mbase + wave) * DM + g * 256 + ech);
    f32x4 sv[16];
    { const f32x4* sp = (const f32x4*)(in_ptr(4) + (((size_t)layer * NB_S + sq) * 16 + g * 4 + (wave >> 1)) * 8192 + (size_t)(32 * (wave & 1)) * 128);
#pragma unroll
      for (int i = 0; i < 16; ++i) sv[i] = sp[i * 64 + lane]; }
    if (tid < 32) {
        const float d = ((const float*)(F.ws + WS_DT))[(mbase + (tid >> 2)) * 16 + g * 4 + (tid & 3)]; const float an = -__expf(in_ptr(20)[layer * 16 + g * 4 + (tid & 3)]);
        float v = d * an;
#pragma unroll
        for (int o = 4; o < 32; o <<= 1) { const float u = __shfl_up(v, o); if (lane >= o) v += u; }
        dts[tid] = d; acs[tid] = v; }
#pragma unroll
    for (int j = 0; j < 8; ++j) { const float v = cw0 * w0 + cw1 * w1 + cw2 * w2 + cw3 * pre[j] + cb; w0 = w1; w1 = w2; w2 = pre[j]; cv[j * 512 + tid] = fast_silu(v); }
    {
        float* oc = F.out + (size_t)M * DM + (size_t)DEPTH * NB_P * 16 * 8192 + (size_t)DEPTH * NB_P * 3 * DXBC + (size_t)DEPTH * NB_P * 2 * DM + (size_t)DEPTH * NB_S * 16 * 8192
                    + ((size_t)layer * NB_S + sq) * 3 * DXBC + chan;
        oc[0] = w0; oc[DXBC] = w1; oc[2 * DXBC] = w2; }
    __syncthreads();
    {
        const int hh = wave >> 1, ph = wave & 1, r = lane & 31, h = lane >> 5, head = g * 4 + hh;
        float* SN = F.out + (size_t)M * DM + (size_t)DEPTH * NB_P * 16 * 8192 + (size_t)DEPTH * NB_P * 3 * DXBC + (size_t)DEPTH * NB_P * 2 * DM + (((size_t)layer * NB_S + sq) * 16 + head) * 8192 + (size_t)(32 * ph) * 128;
        const float ac8 = acs[7 * 4 + hh], A8 = __expf(ac8);
        LAS float* simg = (LAS float*)(F.lds + 25088) + wave * (32 * 132);
#pragma unroll
        for (int i = 0; i < 16; ++i) { const int idx = i * 64 + lane; *(LAS f32x4*)(simg + (idx >> 5) * 132 + (idx & 31) * 4) = sv[i]; }
        f32x16 acc[4];
#pragma unroll
        for (int nt = 0; nt < 4; ++nt)
#pragma unroll
            for (int q = 0; q < 16; ++q) acc[nt][q] = simg[crow(q, h) * 132 + 32 * nt + r];
        bf16x8 cfr[8];
#pragma unroll
        for (int ks = 0; ks < 8; ++ks) { const LAS float* cp = cv + (r & 7) * 512 + 384 + 16 * ks + 8 * h; const f32x4 c0 = *(const LAS f32x4*)cp, c1 = *(const LAS f32x4*)(cp + 4);
            const float mk = r < 8 ? 1.f : 0.f; cfr[ks] = pack8(c0.x * mk, c0.y * mk, c0.z * mk, c0.w * mk, c1.x * mk, c1.y * mk, c1.z * mk, c1.w * mk); }
        f32x16 yo;
#pragma unroll
        for (int q = 0; q < 16; ++q) yo[q] = 0.f;
#pragma unroll
        for (int ks = 0; ks < 8; ++ks) { const LAS float* sp = simg + r * 132 + 16 * ks + 8 * h; const f32x4 v0 = *(const LAS f32x4*)sp, v1 = *(const LAS f32x4*)(sp + 4);
            yo = MFMA32(cfr[ks], pack8(v0.x, v0.y, v0.z, v0.w, v1.x, v1.y, v1.z, v1.w), yo); }
#pragma unroll
        for (int q = 0; q < 4; ++q) yo[q] *= __expf(acs[(4 * h + q) * 4 + hh]);
        {
            float xa[8];
#pragma unroll
            for (int j = 0; j < 8; ++j) xa[j] = h == 0 ? cv[j * 512 + hh * 64 + 32 * ph + r] * dts[j * 4 + hh] * __expf(ac8 - acs[j * 4 + hh]) : 0.f;
            const bf16x8 xop = pack8(xa[0], xa[1], xa[2], xa[3], xa[4], xa[5], xa[6], xa[7]);
#pragma unroll
            for (int nt = 0; nt < 4; ++nt) { float bv[8];
#pragma unroll
                for (int j = 0; j < 8; ++j) bv[j] = h == 0 ? cv[j * 512 + 256 + 32 * nt + r] : 0.f;
#pragma unroll
                for (int q = 0; q < 16; ++q) acc[nt][q] *= A8;
                acc[nt] = MFMA32(xop, pack8(bv[0], bv[1], bv[2], bv[3], bv[4], bv[5], bv[6], bv[7]), acc[nt]);
#pragma unroll
                for (int q = 0; q < 16; ++q) simg[crow(q, h) * 132 + 32 * nt + r] = acc[nt][q]; }
#pragma unroll
            for (int i = 0; i < 16; ++i) { const int idx = i * 64 + lane; ((f32x4*)SN)[idx] = *(const LAS f32x4*)(simg + (idx >> 5) * 132 + (idx & 31) * 4); }
        }
        {
            f32x16 xt;
#pragma unroll
            for (int q = 0; q < 16; ++q) xt[q] = 0.f;
#pragma unroll
            for (int ks = 0; ks < 8; ++ks) { const LAS float* bp = cv + (r & 7) * 512 + 256 + 16 * ks + 8 * h; const f32x4 b0 = *(const LAS f32x4*)bp, b1 = *(const LAS f32x4*)(bp + 4);
                const float mk = r < 8 ? 1.f : 0.f; xt = MFMA32(pack8(b0.x * mk, b0.y * mk, b0.z * mk, b0.w * mk, b1.x * mk, b1.y * mk, b1.z * mk, b1.w * mk), cfr[ks], xt); }
            const int t = r & 7; const float at = acs[t * 4 + hh];
            float mv[4];
#pragma unroll
            for (int q = 0; q < 4; ++q) { const int sidx = 4 * h + q; const float arg = fminf(at - acs[sidx * 4 + hh], 0.f); mv[q] = (sidx <= t && r < 8) ? xt[q] * __expf(arg) * dts[sidx * 4 + hh] : 0.f; }
            const bf16x8 aop = pack8(mv[0], mv[1], mv[2], mv[3], 0.f, 0.f, 0.f, 0.f);
            float xs[4];
#pragma unroll
            for (int q = 0; q < 4; ++q) xs[q] = cv[(4 * h + q) * 512 + hh * 64 + 32 * ph + r];
            yo = MFMA32(aop, pack8(xs[0], xs[1], xs[2], xs[3], 0.f, 0.f, 0.f, 0.f), yo);
        }
#pragma unroll
        for (int q = 0; q < 4; ++q) ybuf[(4 * h + q) * 256 + hh * 64 + 32 * ph + r] = yo[q];
    }
    __syncthreads();
    {
        const float Dh = in_ptr(21)[layer * 16 + g * 4 + (ech >> 6)];
        const f32x4 nw = *(const f32x4*)(in_ptr(22) + (size_t)layer * DM + g * 256 + ech);
        const f32x4 y4 = *(const LAS f32x4*)(ybuf + wave * 256 + ech), x4 = *(const LAS f32x4*)(cv + wave * 512 + ech);
        const unsigned zl = (unsigned)zw, zh = (unsigned)(zw >> 32);
        f32x4 y;
        y.x = (y4.x + x4.x * Dh) * fast_silu(bf_lo(zl)); y.y = (y4.y + x4.y * Dh) * fast_silu(bf_hi(zl));
        y.z = (y4.z + x4.z * Dh) * fast_silu(bf_lo(zh)); y.w = (y4.w + x4.w * Dh) * fast_silu(bf_hi(zh));
        const float ss = wave_sum((y.x * y.x + y.y * y.y) + (y.z * y.z + y.w * y.w));
        const float rr = 1.f / sqrtf(ss * (1.f / 256.f) + EPS);
        const f32x4 o = (y * rr) * nw;
        *(unsigned long long*)(Z + (mbase + wave) * DM + g * 256 + ech) = (unsigned long long)pk2(o.x, o.y) | ((unsigned long long)pk2(o.z, o.w) << 32);
    }
    __syncthreads();
}
__device__ __forceinline__ void ssd_s1_phase(Frame& F, int layer, const XcdBarrier& bar, unsigned* bar2, unsigned gen) {
    frame_refresh(F);
#ifdef DUP_S1P
    for (int u = F.vcu; u < 512; u += GRID) ssd_s1_unit(F, layer, u >> 6, (u >> 2) & 15, u & 3);
#endif
  {
    for (int u = F.vcu; u < 512; u += GRID) ssd_s1_unit(F, layer, u >> 6, (u >> 2) & 15, u & 3);
    xcd_arrive(bar, bar2);
    for (int u = F.vcu; u < NB_S * 4; u += GRID) ssd_sample_unit(F, layer, u >> 2, u & 3);
    xcd_wait(bar, bar2, gen);
  }
}
__device__ __forceinline__ void ssd_s3_phase(Frame& F, int layer, const XcdBarrier& bar, unsigned* bar2, unsigned gen) {
    frame_refresh(F);
  {
    for (int u = F.vcu; u < 512; u += GRID) ssd_s3_unit(F, layer, u >> 6, (u >> 2) & 15, u & 3, u < GRID, bar, bar2, gen);
  }
}

template <class Epi> __device__ __forceinline__ void sgemm64(Frame& F, const bf16* A  , const bf16* Bt, int K, const Epi& E) {
    constexpr int KC = 256, PITCH = 528, HBUF = 64 * PITCH, BUF = 2 * HBUF;
    static_assert(2 * BUF <= LDSCTL_OFF && 8 * 16384 <= 2 * BUF, "sgemm64 LDS");
    const int tid = F.tid, lane = F.lane, wave = F.wave, r = lane & 31, h = lane >> 5;
    const int tile = F.vcu & 255, rb = tile >> 4, cb = tile & 15;
    const int nch = K / KC, lrow = tid >> 5, lseg = tid & 31;
    const bf16* ag = A + (size_t)(rb * 64 + lrow) * K + lseg * 8; const bf16* bg = Bt + (size_t)(cb * 64 + lrow) * K + lseg * 8;
    LAS unsigned char* lw = F.lds + lrow * PITCH + lseg * 16;
    const LAS unsigned char* lr = F.lds + r * PITCH + (2 * wave) * 32 + 16 * h;
    v4u ra[4], rbv[4];
#pragma unroll
    for (int i = 0; i < 4; ++i) { ra[i] = *(const v4u*)(ag + (size_t)(16 * i) * K); rbv[i] = *(const v4u*)(bg + (size_t)(16 * i) * K); }
#pragma unroll
    for (int i = 0; i < 4; ++i) { *(LAS v4u*)(lw + 16 * i * PITCH) = ra[i]; *(LAS v4u*)(lw + HBUF + 16 * i * PITCH) = rbv[i]; }
    __syncthreads();
    f32x16 acc[2][2];
#pragma unroll
    for (int i = 0; i < 2; ++i)
#pragma unroll
        for (int j = 0; j < 2; ++j)
#pragma unroll
            for (int q = 0; q < 16; ++q) acc[i][j][q] = 0.f;
#pragma unroll 1
    for (int ch = 0; ch < nch; ++ch) {
        const bool more = ch + 1 < nch;
        if (more) {
#pragma unroll
            for (int i = 0; i < 4; ++i) { ra[i] = *(const v4u*)(ag + (size_t)(16 * i) * K + (ch + 1) * KC); rbv[i] = *(const v4u*)(bg + (size_t)(16 * i) * K + (ch + 1) * KC); } }
        const LAS unsigned char* cur = lr + (ch & 1) * BUF;
#pragma unroll
        for (int q = 0; q < 2; ++q) {
            const bf16x8 a0 = *(const LAS bf16x8*)(cur + q * 32), a1 = *(const LAS bf16x8*)(cur + 32 * PITCH + q * 32);
            const bf16x8 b0 = *(const LAS bf16x8*)(cur + HBUF + q * 32), b1 = *(const LAS bf16x8*)(cur + HBUF + 32 * PITCH + q * 32);
            acc[0][0] = MFMA32(a0, b0, acc[0][0]); acc[0][1] = MFMA32(a0, b1, acc[0][1]);
            acc[1][0] = MFMA32(a1, b0, acc[1][0]); acc[1][1] = MFMA32(a1, b1, acc[1][1]); }
        if (more) { LAS unsigned char* nx = lw + ((ch + 1) & 1) * BUF;
#pragma unroll
            for (int i = 0; i < 4; ++i) { *(LAS v4u*)(nx + 16 * i * PITCH) = ra[i]; *(LAS v4u*)(nx + HBUF + 16 * i * PITCH) = rbv[i]; } }
        __syncthreads();
    }
    {   LAS float* part = (LAS float*)(F.lds) + wave * 4096;
#pragma unroll
        for (int i = 0; i < 2; ++i)
#pragma unroll
            for (int j = 0; j < 2; ++j)
#pragma unroll
                for (int q = 0; q < 16; ++q) part[(32 * i + crow(q, h)) * 64 + 32 * j + r] = acc[i][j][q];
    }
    __syncthreads();
    {   const int row = tid >> 3, c8 = (tid & 7) * 8;
        float v[8];
#pragma unroll
        for (int q = 0; q < 8; ++q) v[q] = 0.f;
#pragma unroll
        for (int w = 0; w < 8; ++w) { const LAS float* p = (const LAS float*)(F.lds) + w * 4096 + row * 64 + c8; const f32x4 x0 = *(const LAS f32x4*)p, x1 = *(const LAS f32x4*)(p + 4);
            v[0] += x0.x; v[1] += x0.y; v[2] += x0.z; v[3] += x0.w; v[4] += x1.x; v[5] += x1.y; v[6] += x1.z; v[7] += x1.w; }
        E(MP + rb * 64 + row, cb * 64 + c8, v);
    }
    __syncthreads();
}
template <bool XF32> struct SEpiResidLN {
    const void* Xin; bf16* X; const float* gate; float sc;
    bf16* H; const float* GS; const float* SH; float* SSQ; unsigned* cnt;
    __device__ __forceinline__ void operator()(int m, int c, const float (&v)[8]) const {
        const int mr = mod_row(m);
        const float* gp = gate + (size_t)mr * NMOD + c;
        f32x4 x0, x1;
        if constexpr (XF32) { const float* xi = (const float*)Xin + (size_t)(m - MP) * DM + c; x0 = *(const f32x4*)xi; x1 = *(const f32x4*)(xi + 4); }
        else { const v4u xw = *(const v4u*)((const bf16*)Xin + (size_t)m * DM + c); x0 = (f32x4){bf_lo(xw.x), bf_hi(xw.x), bf_lo(xw.y), bf_hi(xw.y)}; x1 = (f32x4){bf_lo(xw.z), bf_hi(xw.z), bf_lo(xw.w), bf_hi(xw.w)}; }
        const f32x4 g0 = *(const f32x4*)gp, g1 = *(const f32x4*)(gp + 4);
        const f32x4 s0 = *(const f32x4*)(GS + (size_t)mr * DM + c), s1 = *(const f32x4*)(GS + (size_t)mr * DM + c + 4), h0 = *(const f32x4*)(SH + (size_t)mr * NMOD + c), h1 = *(const f32x4*)(SH + (size_t)mr * NMOD + c + 4);
        const f32x4 n0 = x0 + (g0 * sc) * (f32x4){v[0], v[1], v[2], v[3]}, n1 = x1 + (g1 * sc) * (f32x4){v[4], v[5], v[6], v[7]};
        { v4u w; w.x = pk2(n0.x, n0.y); w.y = pk2(n0.z, n0.w); w.z = pk2(n1.x, n1.y); w.w = pk2(n1.z, n1.w); *(v4u*)(X + (size_t)m * DM + c) = w; }
        float ss = ((n0.x * n0.x + n0.y * n0.y) + (n0.z * n0.z + n0.w * n0.w)) + ((n1.x * n1.x + n1.y * n1.y) + (n1.z * n1.z + n1.w * n1.w));
        ss += __shfl_xor(ss, 1); ss += __shfl_xor(ss, 2); ss += __shfl_xor(ss, 4);
        if ((threadIdx.x & 7) == 0) atomicAdd(SSQ + m, ss);
        asm volatile("s_waitcnt vmcnt(0)" ::: "memory");
        __syncthreads();
        if (threadIdx.x == 0) { unsigned* cp = cnt + 64 * ((m - MP) >> 6);
            __hip_atomic_fetch_add(cp, 1u, __ATOMIC_RELAXED, __HIP_MEMORY_SCOPE_AGENT);
            unsigned sp = 0; while (__hip_atomic_load(cp, __ATOMIC_RELAXED, __HIP_MEMORY_SCOPE_AGENT) < 16u && ++sp < (1u << 22)) __builtin_amdgcn_s_sleep(1); }
        __syncthreads();
        const float tot = __hip_atomic_load(SSQ + m, __ATOMIC_RELAXED, __HIP_MEMORY_SCOPE_AGENT);
        const float rinv = 1.f / sqrtf(tot * (1.f / DM) + EPS);
        const f32x4 a = (n0 * rinv) * s0 + h0, b = (n1 * rinv) * s1 + h1;
        v4u w; w.x = pk2(a.x, a.y); w.y = pk2(a.z, a.w); w.z = pk2(b.x, b.y); w.w = pk2(b.z, b.w); *(v4u*)(H + (size_t)m * DM + c) = w;
    }
};
template <bool FIRST> struct SEpiGate {
    bf16* T; const bf16* G;
    __device__ __forceinline__ void operator()(int m, int c, const float (&v)[8]) const {
        const size_t o = (size_t)m * DM + c; const v4u gw = *(const v4u*)(G + o);
        float r[8];
        r[0] = bf_lo(gw.x) * v[0]; r[1] = bf_hi(gw.x) * v[1]; r[2] = bf_lo(gw.y) * v[2]; r[3] = bf_hi(gw.y) * v[3];
        r[4] = bf_lo(gw.z) * v[4]; r[5] = bf_hi(gw.z) * v[5]; r[6] = bf_lo(gw.w) * v[6]; r[7] = bf_hi(gw.w) * v[7];
        if (!FIRST) { const v4u tw = *(const v4u*)(T + o);
            r[0] += bf_lo(tw.x); r[1] += bf_hi(tw.x); r[2] += bf_lo(tw.y); r[3] += bf_hi(tw.y); r[4] += bf_lo(tw.z); r[5] += bf_hi(tw.z); r[6] += bf_lo(tw.w); r[7] += bf_hi(tw.w); }
        v4u w; w.x = pk2(r[0], r[1]); w.y = pk2(r[2], r[3]); w.z = pk2(r[4], r[5]); w.w = pk2(r[6], r[7]);
        *(v4u*)(T + o) = w;
    }
};

struct SEpiFinal {
    const bf16* Xin; float* Y; const float* gate; const float* gfin; float* SSF; unsigned* cnt;
    __device__ __forceinline__ void operator()(int m, int c, const float (&v)[8]) const {
        const int mr = mod_row(m);
        const float* gp = gate + (size_t)mr * NMOD + c; const v4u xw = *(const v4u*)(Xin + (size_t)m * DM + c);
        const f32x4 g0 = *(const f32x4*)gp, g1 = *(const f32x4*)(gp + 4), x0 = (f32x4){bf_lo(xw.x), bf_hi(xw.x), bf_lo(xw.y), bf_hi(xw.y)}, x1 = (f32x4){bf_lo(xw.z), bf_hi(xw.z), bf_lo(xw.w), bf_hi(xw.w)};
        const f32x4 n0 = x0 + (g0 * 0.5f) * (f32x4){v[0], v[1], v[2], v[3]}, n1 = x1 + (g1 * 0.5f) * (f32x4){v[4], v[5], v[6], v[7]};
        float ss = ((n0.x * n0.x + n0.y * n0.y) + (n0.z * n0.z + n0.w * n0.w)) + ((n1.x * n1.x + n1.y * n1.y) + (n1.z * n1.z + n1.w * n1.w));
        ss += __shfl_xor(ss, 1); ss += __shfl_xor(ss, 2); ss += __shfl_xor(ss, 4);
        if ((threadIdx.x & 7) == 0) atomicAdd(SSF + m, ss);
        asm volatile("s_waitcnt vmcnt(0)" ::: "memory");
        __syncthreads();
        if (threadIdx.x == 0) { unsigned* cp = cnt + 64 * ((m - MP) >> 6);
            __hip_atomic_fetch_add(cp, 1u, __ATOMIC_RELAXED, __HIP_MEMORY_SCOPE_AGENT);
            unsigned sp = 0; while (__hip_atomic_load(cp, __ATOMIC_RELAXED, __HIP_MEMORY_SCOPE_AGENT) < 16u && ++sp < (1u << 22)) __builtin_amdgcn_s_sleep(1); }
        __syncthreads();
        const float tot = __hip_atomic_load(SSF + m, __ATOMIC_RELAXED, __HIP_MEMORY_SCOPE_AGENT);
        const float rinv = 1.f / sqrtf(tot * (1.f / DM) + EPS);
        const f32x4 f0 = *(const f32x4*)(gfin + c), f1 = *(const f32x4*)(gfin + c + 4);
        float* yp = Y + (size_t)m * DM + c;
        *(f32x4*)yp = (n0 * rinv) * f0; *(f32x4*)(yp + 4) = (n1 * rinv) * f1;
    }
};
#ifdef DUP_BAR
#define GRID_BAR() do { xcd_barrier(bar); xcd_barrier(bar); } while (0)
#else
#if defined(BAR3V)
#define GRID_BAR() xcd_barrier3((unsigned*)(F.ctl + 180224), F.MISC + 10, (unsigned)GRID)
#elif !defined(NO_FLATBAR)
#define GRID_BAR() xcd_barrier_flat(bar, (unsigned*)(F.ctl + 180224), F.MISC + 10)
#else
#define GRID_BAR() xcd_barrier(bar)
#endif
#endif
#ifndef PH_MASK
#define PH_MASK 0xffff
#endif
#define PH(k) (((PH_MASK) >> (k)) & 1)
#ifndef XR_ON_
#define XR_ON_ 1
#endif
constexpr bool XR_ON = XR_ON_;
#define BAR2 ((unsigned*)(F.ctl + CW_BAR + 4096))
#define BAR3 ((unsigned*)(F.ctl + CW_BAR + 8192))
#define FILL_BAR(k, gen) do { if constexpr (FILLW && l == 0) { xcd_arrive(bar, BAR2); p0_fill(F, k); xcd_wait(bar, BAR2, gen); } else GRID_BAR(); } while (0)
#define Hb ((bf16*)(F.ws + WS_H))
#define Tb ((bf16*)(F.ws + WS_S))
#define ACT ((bf16*)(F.ws + WS_P))
#define XB (proj_ptr(F, PT_SCH))

template <int LAYER> __device__ __forceinline__ void layer_fwd(Frame& F, const XcdBarrier& bar) {
    constexpr int l = LAYER;
        if (PH(3)) { frame_refresh(F); pg8::Gemm g{Hb, wt_ptr(F, l, WO_GU1), M, 2 * DFF, DM}; pg8::StaticOrder S; S.init(M, 2 * DFF, GRID, F.bx);
          pg8::EpiSwiglu E{ACT}; pg8::gemm_phase<pg8::EpiSwiglu, pg8::StaticOrder, true, true>(F.lds + RING_OFF, g, S, E);
#ifdef DUP_G1
          GRID_BAR(); pg8::gemm_phase<pg8::EpiSwiglu, pg8::StaticOrder, true, true>(F.lds + RING_OFF, g, S, E);
#endif
        }
        FILL_BAR(0, 2u);
#ifdef DUP_D1
        { frame_refresh(F); pg8::Gemm g{ACT, wt_ptr(F, l, WO_D1), MP, DM, DFF}; pg8::StaticOrder S; S.init(MP, DM, GRID, F.bx);
          pg8::EpiGate<true> E{Tb, Hb}; pg8::gemm_phase<pg8::EpiGate<true>, pg8::StaticOrder, true, true>(F.lds + RING_OFF, g, S, E); }
#endif
#ifdef DUP_K1
        { frame_refresh(F); pg8::Gemm g{Hb, wt_ptr(F, l, WO_SSD), MP, DM, DM}; pg8::StaticOrder S; S.init(MP, DM, GRID, F.bx);
          pg8::EpiGate<true> E{Tb, Hb}; pg8::gemm_phase<pg8::EpiGate<true>, pg8::StaticOrder, true, true>(F.lds + RING_OFF, g, S, E); }
#endif
#ifdef DUP_SGD
        { frame_refresh(F); SEpiGate<true> SE{Tb, Hb}; sgemm64(F, ACT + (size_t)MP * DFF, wt_ptr(F, l, WO_D1), DFF, SE); }
#endif
        if (PH(4)) { frame_refresh(F); pg8::Gemm g{ACT, wt_ptr(F, l, WO_D1), MP, DM, DFF}; pg8::StaticOrder S; S.init(MP, DM, GRID, F.bx);
          pg8::EpiResidLN<true, l == 0> E{l == 0 ? (const void*)in_ptr(0) : (const void*)XB, XB, mod_ptr(F, l, 2), in_ptr(1), Hb, gs_ptr(F, l * 3 + 1), mod_ptr(F, l, 3), ss_ptr(F, l * 3 + 1), fcnt_ptr(F, l * 3 + 1)}; pg8::gemm_phase<pg8::EpiResidLN<true, l == 0>, pg8::StaticOrder, true, true, XR_ON, MP>(F.lds + RING_OFF, g, S, E);
          if constexpr (!XR_ON) {frame_refresh(F); SEpiResidLN<l == 0> SE{l == 0 ? (const void*)in_ptr(1) : (const void*)XB, XB, mod_ptr(F, l, 2), 0.5f, Hb, gs_ptr(F, l * 3 + 1), mod_ptr(F, l, 3), ss_ptr(F, l * 3 + 1), fcnt_ptr(F, l * 3 + 1) + 64 * 64};
            sgemm64(F, ACT + (size_t)MP * DFF, wt_ptr(F, l, WO_D1), DFF, SE); } }
        FILL_BAR(1, 3u);
        if (PH(5)) dt_phase(F, l);
        if (PH(6)) { frame_refresh(F); pg8::Gemm g{Hb, wt_ptr(F, l, WO_IN), M, 6144, DM}; pg8::StaticOrder S; S.init(M, 6144, GRID, F.bx);
          pg8::EpiProj E{(bf16*)(F.ws + WS_P), 0}; pg8::gemm_phase<pg8::EpiProj, pg8::StaticOrder, true, true>(F.lds + RING_OFF, g, S, E); }
        xcd_arrive(bar, BAR2);
        if (PH(6)) { frame_refresh(F); pg8::Gemm g{Hb, wt_ptr(F, l, WO_IN) + (size_t)6144 * DM, M, 2048, DM}; pg8::StaticOrder S; S.init(M, 2048, GRID, (F.bx + GRID - 96) % GRID);
          pg8::EpiProj E{(bf16*)(F.ws + WS_P), 24}; pg8::gemm_phase<pg8::EpiProj, pg8::StaticOrder, true, true>(F.lds + RING_OFF, g, S, E); }
        xcd_wait(bar, BAR2, 4u + 7u * l);
#ifdef DUP_SC
        F.dry = 1; shortconv_phase(F, l); F.dry = 0;
#endif
        if (PH(7)) shortconv_phase(F, l);
        __syncthreads();
        if (PH(8)) ssd_s1_phase(F, l, bar, BAR2, 5u + 7u * l);
#ifdef DUP_S2
        ssd_s2_phase(F, l);
#endif
        if (PH(8)) ssd_s2_phase(F, l);
        xcd_arrive(bar, BAR2);
        if (PH(8)) ssd_s3_phase(F, l, bar, BAR2, 6u + 7u * l);
        xcd_arrive(bar, BAR2);
        if (PH(9)) { frame_refresh(F); pg8::Gemm g{proj_ptr(F, PT_SCB), wt_ptr(F, l, WO_SC), MP, DM, DM, proj_ptr(F, PT_Z), wt_ptr(F, l, WO_SSD)}; pg8::PairOrderW S; S.init(MP, DM, GRID, F.bx);
          S.top = BAR2 + XB_TOP; S.target = bar.st[1] * (7u + 7u * l);
          pg8::EpiGate2 E{Tb, proj_ptr(F, PT_GSC), proj_ptr(F, PT_GSSD)}; pg8::gemm_phase<pg8::EpiGate2, pg8::PairOrderW, true, true, XR_ON, MP>(F.lds + RING_OFF, g, S, E);
          if constexpr (!XR_ON) { frame_refresh(F); SEpiGate<true> SE{Tb, proj_ptr(F, PT_GSSD)};
          sgemm64(F, proj_ptr(F, PT_Z) + (size_t)MP * DM, wt_ptr(F, l, WO_SSD), DM, SE);
          frame_refresh(F); SEpiGate<false> SE2{Tb, proj_ptr(F, PT_GSC)};
          sgemm64(F, proj_ptr(F, PT_SCB) + (size_t)MP * DM, wt_ptr(F, l, WO_SC), DM, SE2); } }
        xcd_arrive(bar, BAR2);
        if (PH(11)) { frame_refresh(F); pg8::Gemm g{Tb, wt_ptr(F, l, WO_O), MP, DM, DM}; pg8::RotWaitOrder S; S.init(MP, DM, GRID, F.bx); S.top = BAR2 + XB_TOP; S.target = bar.st[1] * (8u + 7u * l);
          pg8::EpiResidLN<false, false> E{XB, XB, mod_ptr(F, l, 5), nullptr, Hb, gs_ptr(F, l * 3 + 2), mod_ptr(F, l, 6), ss_ptr(F, l * 3 + 2), fcnt_ptr(F, l * 3 + 2)}; pg8::gemm_phase<pg8::EpiResidLN<false, false>, pg8::RotWaitOrder, true, true, XR_ON, MP>(F.lds + RING_OFF, g, S, E);
          if constexpr (!XR_ON) {frame_refresh(F); SEpiResidLN<false> SE{XB, XB, mod_ptr(F, l, 5), 1.0f, Hb, gs_ptr(F, l * 3 + 2), mod_ptr(F, l, 6), ss_ptr(F, l * 3 + 2), fcnt_ptr(F, l * 3 + 2) + 64 * 64};
            sgemm64(F, Tb + (size_t)MP * DM, wt_ptr(F, l, WO_O), DM, SE); } }
        FILL_BAR(2, 9u);
        if (PH(3)) { frame_refresh(F); pg8::Gemm g{Hb, wt_ptr(F, l, WO_GU2), M, 2 * DFF, DM}; pg8::StaticOrder S; S.init(M, 2 * DFF, GRID, F.bx);
          pg8::EpiSwiglu E{ACT}; pg8::gemm_phase<pg8::EpiSwiglu, pg8::StaticOrder, true, true>(F.lds + RING_OFF, g, S, E);
#ifdef DUP_G1
          GRID_BAR(); pg8::gemm_phase<pg8::EpiSwiglu, pg8::StaticOrder, true, true>(F.lds + RING_OFF, g, S, E);
#endif
        }
        FILL_BAR(3, 10u);
        if (PH(4)) { frame_refresh(F); pg8::Gemm g{ACT, wt_ptr(F, l, WO_D2), MP, DM, DFF}; pg8::StaticOrder S; S.init(MP, DM, GRID, F.bx);
          if constexpr (l + 1 < DEPTH) { pg8::EpiResidLN<true, false> E{XB, XB, mod_ptr(F, l, 8), nullptr, Hb, gs_ptr(F, (l + 1) * 3), mod_ptr(F, l + 1, 0), ss_ptr(F, (l + 1) * 3), fcnt_ptr(F, (l + 1) * 3)}; pg8::gemm_phase<pg8::EpiResidLN<true, false>, pg8::StaticOrder, true, true, XR_ON, MP>(F.lds + RING_OFF, g, S, E);
          if constexpr (!XR_ON) {frame_refresh(F); SEpiResidLN<false> SE{XB, XB, mod_ptr(F, l, 8), 0.5f, Hb, gs_ptr(F, (l + 1) * 3), mod_ptr(F, l + 1, 0), ss_ptr(F, (l + 1) * 3), fcnt_ptr(F, (l + 1) * 3) + 64 * 64};
            sgemm64(F, ACT + (size_t)MP * DFF, wt_ptr(F, l, WO_D2), DFF, SE); } }
          else {
            unsigned* fc = fcnt_ptr(F, 6);
            pg8::EpiFinal E{XB, F.out, mod_ptr(F, l, 8), in_ptr(27), ss_ptr(F, 6), fc}; pg8::gemm_phase<pg8::EpiFinal, pg8::StaticOrder, true, true, XR_ON, MP>(F.lds + RING_OFF, g, S, E);
          if constexpr (!XR_ON) {frame_refresh(F); SEpiFinal SE{XB, F.out, mod_ptr(F, l, 8), in_ptr(27), ss_ptr(F, 6), fcnt_ptr(F, 6) + 64 * 64};
            sgemm64(F, ACT + (size_t)MP * DFF, wt_ptr(F, l, WO_D2), DFF, SE); } } }
        if constexpr (l + 1 < DEPTH) GRID_BAR();
    }

struct Args { const float* in[28]; float* out; unsigned char* ws; };
__global__ void __launch_bounds__(NWAVES * 64, 2) mega_fwd(Args args) {
    extern __shared__ __attribute__((aligned(16))) unsigned char lds[];
    Frame F;
    F.lds = (LAS unsigned char*)lds;
    F.MISC = (volatile LAS unsigned*)(F.lds + MISC_OFF);
    F.tid = threadIdx.x; F.lane = F.tid & 63; F.wave = __builtin_amdgcn_readfirstlane(F.tid >> 6);
    { const int bx = blockIdx.x; F.bx = bx; F.vcu = (bx & 7) * (GRID >> 3) + (bx >> 3); }
    F.out = args.out; F.ws = args.ws; F.dry = 0;
    F.ctl = (gu32*)(F.ws + WS_CTL);
    for (int u = F.tid; u < (LDS_BYTES - LDSCTL_OFF) / 4; u += NWAVES * 64) ((LAS unsigned*)(F.lds + LDSCTL_OFF))[u] = 0u;
    __syncthreads();
    XcdBarrier bar = xcd_barrier_post((unsigned*)(F.ctl + CW_BAR), F.MISC + 8);

    if (PH(0)) p0a_prologue(F);
#ifdef DUP_P0A
    p0a_prologue(F);
#endif
    xcd_arrive(bar, BAR2);
    if (F.vcu < 72) xcd_wait(bar, BAR2, 1u);
    if (PH(1)) for (int l = 0; l < DEPTH; ++l) {
        frame_refresh(F);
        pg8::Gemm g{(const bf16*)(F.ws + WS_CA), (const bf16*)(F.ws + WS_P) + (size_t)l * NMOD * DM, 256, NMOD, DM};
        pg8::StaticOrder S; S.init(256, NMOD, GRID, (F.vcu + GRID - 36 * l) % GRID);
        pg8::EpiMod E{(float*)(F.ws + WS_MOD) + (size_t)l * NSEQ * NMOD, in_ptr(8) + (size_t)l * NMOD, gs_ptr(F, l * 3), (const float*)(F.ws + WS_GN) + (size_t)l * 3 * DM};
        pg8::gemm_phase<pg8::EpiMod, pg8::StaticOrder, true, true>(F.lds + RING_OFF, g, S, E);
    }
    xcd_arrive(bar, BAR3);
    if (PH(0)) p0b_prologue(F, 72);
#ifdef DUP_P0B
    p0b_prologue(F, 0);
#endif
    xcd_wait(bar, BAR3, 1u);
    norm0_phase(F);
#ifdef DUP_XG0
    norm0_phase(F);
#endif
    GRID_BAR();
    layer_fwd<0>(F, bar);
    layer_fwd<1>(F, bar);
#undef GRID_BAR
}

extern "C" void kernel_launch(void* const* d_in, const int* in_sizes, int n_in, void* d_out, int out_size, void* d_ws, size_t ws_size, hipStream_t stream) {
    static int grid = 0;
    if (grid == 0) {
        if (n_in != 28 || ws_size < WS_END) { fprintf(stderr, "kernel_launch: built for 28 inputs and >= %zu bytes of workspace; got n_in %d, ws %zu; nothing launched\n", (size_t)WS_END, n_in, ws_size); grid = -1; return; }
        int dev = 0, cus = 0, per_cu = 0;
        if (hipGetDevice(&dev) != hipSuccess || hipDeviceGetAttribute(&cus, hipDeviceAttributeMultiprocessorCount, dev) != hipSuccess) { grid = -1; return; }
        if (hipFuncSetAttribute((const void*)mega_fwd, hipFuncAttributeMaxDynamicSharedMemorySize, LDS_BYTES) != hipSuccess) { fprintf(stderr, "kernel_launch: hipFuncSetAttribute failed\n"); grid = -1; return; }
        if (hipOccupancyMaxActiveBlocksPerMultiprocessor(&per_cu, (const void*)mega_fwd, NWAVES * 64, LDS_BYTES) != hipSuccess || per_cu < 1)
            fprintf(stderr, "kernel_launch: note: occupancy query reports %d workgroups per CU\n", per_cu);
        (void)hipGetLastError();
        if (cus < GRID) { fprintf(stderr, "kernel_launch: built for a %d-CU device, found %d CUs; nothing launched\n", GRID, cus); grid = -1; return; }
        grid = GRID;
    }
    if (grid < 0) return;
    if (hipMemsetAsync((char*)d_ws + WS_CTL, 0, CTL_ZERO_BYTES, stream) != hipSuccess) { fprintf(stderr, "kernel_launch: hipMemsetAsync failed\n"); return; }
    Args a{};
    for (int i = 0; i < 28; ++i) a.in[i] = (const float*)d_in[i];
    a.out = (float*)d_out; a.ws = (unsigned char*)d_ws;
    hipLaunchKernelGGL(mega_fwd, dim3(grid), dim3(NWAVES * 64), LDS_BYTES, stream, a);
}
```

```cpp
#include <hip/hip_runtime.h>
#include <cstdio>
#include <cstdint>
namespace pg8 {
#define PG8_LAS __attribute__((address_space(3)))
typedef unsigned short bf16_t;
typedef short bf16x8 __attribute__((ext_vector_type(8)));
typedef float f32x4 __attribute__((ext_vector_type(4)));
typedef unsigned u32x4 __attribute__((ext_vector_type(4)));
constexpr int BM = 256, BK = 64, HALF = 128, HTB = HALF * BK * 2  , STAGE_BYTES = 8 * HTB, NXCD = 8, WGM = 4;

__host__ __device__ __forceinline__ int lds_byte(int r, int c) { const int st = (r >> 4) * 2 + (c >> 5), rr = r & 15, cc = c & 31, ob = rr * 64 + cc * 2; return st * 1024 + (ob ^ (((ob >> 9) & 1) << 5)); }
__host__ __device__ __forceinline__ void stage_rc(int b, int& R, int& C) { const int st = b / 1024, sb = b % 1024, swz = sb ^ (((sb >> 9) & 1) << 5); R = (st >> 1) * 16 + swz / 64; C = (st & 1) * 32 + (swz % 64) / 2; }
__host__ __device__ __forceinline__ int perm32(int rho) { const int n = rho >> 4, i = rho & 15; return 8 * (i >> 2) + 4 * n + (i & 3); }

struct Unit { int pm, pn, kind = 0; };
struct Gemm { const bf16_t* A; const bf16_t* Bt; int M, N, K; const bf16_t* A2 = nullptr; const bf16_t* Bt2 = nullptr; };

struct StaticOrder {
    __device__ __forceinline__ int krot(const Unit&) const { return 0; }
    __device__ __forceinline__ void k_ready(const Unit&, int) const {}
    int nM, nN, nwg, G, c;
    __host__ __device__ void init(int M, int N, int G_, int c_) { nM = M / BM; nN = N / BM; nwg = nM * nN; G = G_; c = c_; }
    __host__ __device__ bool next(int i, Unit& u) const {
        const long L = (long)i * G + c; if (L >= nwg) return false;
        int wgid = (int)L; { const int q = nwg / NXCD, r = nwg % NXCD, xcd = wgid % NXCD, off = wgid / NXCD; wgid = (xcd < r ? xcd * (q + 1) : r * (q + 1) + (xcd - r) * q) + off; }
        const int nig = WGM * nN, gid = wgid / nig, fm = gid * WGM, gsz = (nM - fm) < WGM ? (nM - fm) : WGM;
        u.pm = fm + ((wgid % nig) % gsz); u.pn = (wgid % nig) / gsz; return true;
    }
    __device__ __forceinline__ void a_ready(const Unit&) const {}
    __device__ __forceinline__ void done(const Unit&) const {}
};
struct RotWaitOrder {
    static constexpr bool PAIRED = false;
    StaticOrder P; const unsigned* top; unsigned target;
    __host__ __device__ void init(int M, int N, int G_, int c_) { P.init(M, N, G_, c_); }
    __host__ __device__ bool next(int i, Unit& u) const { return P.next(i, u); }
    __device__ __forceinline__ int krot(const Unit& u) const { return 4 * u.pn; }
    __device__ __forceinline__ void k_ready(const Unit&, int t) const {
        if (t != 2) return;
        if (threadIdx.x < 64) { unsigned sp = 0;
            while ((unsigned)__builtin_amdgcn_readfirstlane(__hip_atomic_load(top, __ATOMIC_RELAXED, __HIP_MEMORY_SCOPE_AGENT)) < target && ++sp < (1u << 22)) __builtin_amdgcn_s_sleep(2);
            __builtin_amdgcn_fence(__ATOMIC_ACQUIRE, "agent");
            asm volatile("s_waitcnt vmcnt(0)" ::: "memory"); }
        asm volatile("" ::: "memory"); __builtin_amdgcn_s_barrier(); asm volatile("" ::: "memory");
    }
    __device__ __forceinline__ void a_ready(const Unit&) const {}
    __device__ __forceinline__ void done(const Unit&) const {}
};
struct PairOrder {
    __device__ __forceinline__ int krot(const Unit&) const { return 0; }
    __device__ __forceinline__ void k_ready(const Unit&, int) const {}
    StaticOrder P;
    __host__ __device__ void init(int M, int N, int G_, int c_) { P.init(M, N, G_, c_); }
    __host__ __device__ bool next(int i, Unit& u) const { if (!P.next(i >> 1, u)) return false; u.kind = i & 1; return true; }
    __device__ __forceinline__ void a_ready(const Unit&) const {}
    __device__ __forceinline__ void done(const Unit&) const {}
};
struct PairOrderW {
    __device__ __forceinline__ int krot(const Unit&) const { return 0; }
    __device__ __forceinline__ void k_ready(const Unit&, int) const {}
    StaticOrder P; const unsigned* top; unsigned target;
    __host__ __device__ void init(int M, int N, int G_, int c_) { P.init(M, N, G_, c_); }
    __host__ __device__ bool next(int i, Unit& u) const { if (!P.next(i >> 1, u)) return false; u.kind = i & 1; return true; }
    __device__ __forceinline__ void a_ready(const Unit& u) const {
        if (u.kind == 0) return;
        if (threadIdx.x < 64) { unsigned sp = 0;
            while ((unsigned)__builtin_amdgcn_readfirstlane(__hip_atomic_load(top, __ATOMIC_RELAXED, __HIP_MEMORY_SCOPE_AGENT)) < target && ++sp < (1u << 22)) __builtin_amdgcn_s_sleep(2);
            __builtin_amdgcn_fence(__ATOMIC_ACQUIRE, "agent");
            asm volatile("s_waitcnt vmcnt(0)" ::: "memory"); }
        asm volatile("" ::: "memory"); __builtin_amdgcn_s_barrier(); asm volatile("" ::: "memory");
    }
    __device__ __forceinline__ void done(const Unit&) const {}
};
__device__ __forceinline__ unsigned cvt_pk_bf16(float lo, float hi) { unsigned r; asm volatile("v_cvt_pk_bf16_f32 %0, %1, %2" : "=v"(r) : "v"(lo), "v"(hi)); return r; }
typedef float f32x2 __attribute__((ext_vector_type(2)));
template <class Epi, class Sched, bool ALIGN_EPI = false, bool SP2 = false, bool XROWS = false, int XROW0 = 0>
__device__ __forceinline__ void gemm_phase(PG8_LAS unsigned char* lds, const Gemm g, const Sched& S, const Epi& E) {
    static_assert(!XROWS || SP2, "extra rows: SP2 schedule");
    int tid_ = threadIdx.x; asm volatile("" : "+v"(tid_));
    const int tid = tid_, wid = __builtin_amdgcn_readfirstlane(tid >> 6), lane = tid & 63, wr = wid >> 2, wc = wid & 3, fr = lane & 15, fq = lane >> 4;
    const int K = g.K, nt = K / BK;
    unsigned voffA[2], voffB[2];
#pragma unroll
    for (int i = 0; i < 2; ++i) { int R, C; stage_rc(tid * 16 + i * 8192, R, C); const int Rb = Epi::PERM ? ((R & ~31) + perm32(R & 31)) : R;
        voffA[i] = (unsigned)(R * K + C) * 2u; voffB[i] = (unsigned)(Rb * K + C) * 2u; }
    unsigned voffX = 0;
    if constexpr (XROWS) { const int xr = 2 * wid + (lane >> 5), xs = (lane & 31) >> 2, xc = xs ^ (xr & 7); voffX = (unsigned)(xr * K) * 2u + (unsigned)(xc * 16 + (lane & 3) * 4); }
    const size_t kstep = (size_t)(BK * 2);
    const size_t hstep = (size_t)HALF * K * 2;
    const size_t tstep = 2 * hstep;
    const unsigned ldsw = (unsigned)wid * 1024u;
    const int aoff = lds_byte(wr * 64 + fr, fq * 8), boff = lds_byte(wc * 32 + fr, fq * 8);
#define PG8_SA(b, h) (((b) * 2 + (h)) * HTB)
#define PG8_SB(b, h) ((4 + (b) * 2 + (h)) * HTB)
#define PG8_STAGE(bufoff, gbase, voff) do { _Pragma("unroll") for (int _i = 0; _i < 2; ++_i) \
        __builtin_amdgcn_global_load_lds((const unsigned*)((const char*)(gbase) + (voff)[_i]), (PG8_LAS unsigned*)(lds + (bufoff) + ldsw + _i * 8192), 16, 0, 0); } while (0)
#define PG8_LDA(dst, b, h) do { _Pragma("unroll") for (int m = 0; m < 4; ++m) _Pragma("unroll") for (int k = 0; k < 2; ++k) dst[m][k] = *(const PG8_LAS bf16x8*)(lds + PG8_SA(b, h) + aoff + m * 2048 + k * 1024); } while (0)
#define PG8_LDB(dst, b, h) do { _Pragma("unroll") for (int n = 0; n < 2; ++n) _Pragma("unroll") for (int k = 0; k < 2; ++k) dst[n][k] = *(const PG8_LAS bf16x8*)(lds + PG8_SB(b, h) + boff + n * 2048 + k * 1024); } while (0)
#define PG8_MMA(ai, bj, At, Bt) do { __builtin_amdgcn_s_setprio(1); _Pragma("unroll") for (int m = 0; m < 4; ++m) _Pragma("unroll") for (int n = 0; n < 2; ++n) _Pragma("unroll") for (int k = 0; k < 2; ++k) \
        acc[ai][bj][m][n] = __builtin_amdgcn_mfma_f32_16x16x32_bf16(Bt[n][k], At[m][k], acc[ai][bj][m][n], 0, 0, 0); __builtin_amdgcn_s_setprio(0); } while (0)
#define PG8_XS(b) (STAGE_BYTES + (b) * 2048)
#define PG8_STAGEX(b, gbase) do { if constexpr (XROWS) __builtin_amdgcn_global_load_lds((const unsigned*)((const char*)(gbase) + voffX), (PG8_LAS unsigned*)(lds + PG8_XS(b) + wid * 256), 4, 0, 0); } while (0)
#define PG8_LDX(b) do { if constexpr (XROWS) { _Pragma("unroll") for (int k = 0; k < 2; ++k) Ax[k] = *(const PG8_LAS bf16x8*)(lds + PG8_XS(b) + fr * 128 + (((k * 4 + fq) ^ (fr & 7)) * 16)); } } while (0)
#define PG8_MMAX() do { if constexpr (XROWS) { if (wr == 0) { _Pragma("unroll") for (int n = 0; n < 2; ++n) _Pragma("unroll") for (int k = 0; k < 2; ++k) accx[n] = __builtin_amdgcn_mfma_f32_16x16x32_bf16(B0[n][k], Ax[k], accx[n], 0, 0, 0); } \
        else { _Pragma("unroll") for (int n = 0; n < 2; ++n) _Pragma("unroll") for (int k = 0; k < 2; ++k) accx[n] = __builtin_amdgcn_mfma_f32_16x16x32_bf16(B1[n][k], Ax[k], accx[n], 0, 0, 0); } } } while (0)
#define PG8_WAIT_V2() do { if constexpr (XROWS) asm volatile("s_waitcnt vmcnt(9)" ::: "memory"); else asm volatile("s_waitcnt vmcnt(8)" ::: "memory"); } while (0)
#define PG8_WAIT_V(n) asm volatile("s_waitcnt vmcnt(" #n ")" ::: "memory")
#define PG8_WAIT_L(n) asm volatile("s_waitcnt lgkmcnt(" #n ")" ::: "memory")
#define PG8_BAR __builtin_amdgcn_s_barrier()
#define PG8_SCHED __builtin_amdgcn_sched_barrier(0)
    Unit cur, nxt; int ui = 0;
    if (!S.next(0, cur)) return;
    f32x4 acc[2][2][4][2];
#pragma unroll
    for (int a = 0; a < 2; ++a)
#pragma unroll
        for (int b = 0; b < 2; ++b)
#pragma unroll
            for (int m = 0; m < 4; ++m)
#pragma unroll
                for (int n = 0; n < 2; ++n) acc[a][b][m][n] = (f32x4){0.f, 0.f, 0.f, 0.f};
    bf16x8 At[4][2], B0[2][2], B1[2][2], Ax[2];
    f32x4 accx[2] = {(f32x4){0.f, 0.f, 0.f, 0.f}, (f32x4){0.f, 0.f, 0.f, 0.f}};
    const char* cA = (const char*)(cur.kind ? g.A2 : g.A) + (size_t)cur.pm * tstep; const char* cB = (const char*)(cur.kind ? g.Bt2 : g.Bt) + (size_t)cur.pn * tstep;
    const char* cX = (const char*)(cur.kind ? g.A2 : g.A) + ((size_t)XROW0 + 16 * (size_t)cur.pm) * (size_t)K * 2;
    int kr = S.krot(cur);
    const char* pA = cA + (size_t)kr * kstep; const char* pB = cB + (size_t)kr * kstep; const char* pX = cX + (size_t)kr * kstep;
    S.a_ready(cur);
    if constexpr (SP2) {
        PG8_STAGEX(0, pX); PG8_STAGE(PG8_SB(0, 0), pB, voffB); PG8_STAGE(PG8_SB(0, 1), pB + hstep, voffB); PG8_STAGE(PG8_SA(0, 0), pA, voffA); PG8_STAGE(PG8_SA(0, 1), pA + hstep, voffA);
        if (wr == 1) PG8_BAR;
        PG8_WAIT_V(2); PG8_BAR;
        PG8_STAGEX(1, pX + kstep); PG8_STAGE(PG8_SB(1, 0), pB + kstep, voffB); PG8_STAGE(PG8_SA(1, 0), pA + kstep, voffA); PG8_STAGE(PG8_SB(1, 1), pB + hstep + kstep, voffB);
        PG8_WAIT_V(6); PG8_BAR;
    } else {
        PG8_STAGE(PG8_SB(0, 0), cB, voffB); PG8_STAGE(PG8_SA(0, 0), cA, voffA); PG8_STAGE(PG8_SB(0, 1), cB + hstep, voffB); PG8_STAGE(PG8_SA(0, 1), cA + hstep, voffA);
        if (wr == 1) PG8_BAR;
        PG8_WAIT_V(4); PG8_BAR;
        PG8_STAGE(PG8_SB(1, 0), cB + kstep, voffB); PG8_STAGE(PG8_SA(1, 0), cA + kstep, voffA); PG8_STAGE(PG8_SB(1, 1), cB + hstep + kstep, voffB);
        PG8_WAIT_V(6); PG8_BAR;
    }
    for (;;) {
        const bool has_next = S.next(ui + 1, nxt);
        const char* nA = has_next ? (const char*)(nxt.kind ? g.A2 : g.A) + (size_t)nxt.pm * tstep : cA; const char* nB = has_next ? (const char*)(nxt.kind ? g.Bt2 : g.Bt) + (size_t)nxt.pn * tstep : cB;
        const char* nX = cX;
        if constexpr (XROWS && !Epi::AFTER_DRAIN) { if (has_next) nX = (const char*)(nxt.kind ? g.A2 : g.A) + ((size_t)XROW0 + 16 * (size_t)nxt.pm) * (size_t)K * 2; }
        for (int t = 0; t < nt; t += 2) {
            const bool last = (t == nt - 2);
            const int k1 = kr ? (((t + kr) & (nt - 1)) + 1) : (t + 1), k2 = kr ? ((t + 2 + kr) & (nt - 1)) : (t + 2);
            S.k_ready(cur, t);
            const char* a1 = cA + (size_t)k1 * kstep;
            const char* a2 = last ? nA : cA + (size_t)k2 * kstep; const char* b2 = last ? nB : cB + (size_t)k2 * kstep;
            const char* a3 = a2 + kstep; const char* b3 = b2 + kstep;
            const char* x2 = last ? nX : cX + (size_t)k2 * kstep; const char* x3 = x2 + kstep;
            if (last && has_next) S.a_ready(nxt);
            if (last) E.prefetch(cur, wr, wc, fr, fq);
            if constexpr (SP2) {
            PG8_LDB(B0, 0, 0); PG8_LDB(B1, 0, 1); PG8_SCHED; PG8_LDA(At, 0, 0); PG8_LDX(0); PG8_STAGE(PG8_SA(1, 1), a1 + hstep, voffA);
            PG8_WAIT_V(8); PG8_WAIT_L(0); PG8_BAR; PG8_MMA(0, 0, At, B0); PG8_MMA(0, 1, At, B1); PG8_MMAX(); PG8_BAR; PG8_SCHED;
            PG8_LDA(At, 0, 1); PG8_STAGEX(0, x2); PG8_STAGE(PG8_SB(0, 0), b2, voffB); PG8_STAGE(PG8_SB(0, 1), b2 + hstep, voffB); PG8_STAGE(PG8_SA(0, 0), a2, voffA);
            PG8_WAIT_V2(); PG8_WAIT_L(0); PG8_BAR; PG8_MMA(1, 0, At, B0); PG8_MMA(1, 1, At, B1); PG8_BAR; PG8_SCHED;
            PG8_LDB(B0, 1, 0); PG8_LDB(B1, 1, 1); PG8_SCHED; PG8_LDA(At, 1, 0); PG8_LDX(1); PG8_STAGE(PG8_SA(0, 1), a2 + hstep, voffA);
            PG8_WAIT_V(8); PG8_WAIT_L(0); PG8_BAR; PG8_MMA(0, 0, At, B0); PG8_MMA(0, 1, At, B1); PG8_MMAX(); PG8_BAR; PG8_SCHED;
            PG8_LDA(At, 1, 1); PG8_STAGEX(1, x3); PG8_STAGE(PG8_SB(1, 0), b3, voffB); PG8_STAGE(PG8_SB(1, 1), b3 + hstep, voffB); PG8_STAGE(PG8_SA(1, 0), a3, voffA);
            PG8_WAIT_V2(); PG8_WAIT_L(0); PG8_BAR; PG8_MMA(1, 0, At, B0); PG8_MMA(1, 1, At, B1); PG8_BAR; PG8_SCHED;
            } else {
            PG8_LDB(B0, 0, 0); PG8_SCHED; PG8_LDA(At, 0, 0); PG8_STAGE(PG8_SA(1, 1), a1 + hstep, voffA);
            PG8_WAIT_L(8); PG8_BAR; PG8_WAIT_L(0); PG8_MMA(0, 0, At, B0); PG8_BAR; PG8_SCHED;
            PG8_LDB(B1, 0, 1); PG8_STAGE(PG8_SB(0, 0), b2, voffB);
            PG8_BAR; PG8_WAIT_L(0); PG8_MMA(0, 1, At, B1); PG8_BAR;
            PG8_LDA(At, 0, 1); PG8_STAGE(PG8_SA(0, 0), a2, voffA);
            PG8_BAR; PG8_WAIT_L(0); PG8_MMA(1, 0, At, B0); PG8_BAR; PG8_SCHED;
            PG8_STAGE(PG8_SB(0, 1), b2 + hstep, voffB);
            PG8_WAIT_V(6); PG8_BAR; PG8_MMA(1, 1, At, B1); PG8_BAR;
            PG8_LDB(B0, 1, 0); PG8_SCHED; PG8_LDA(At, 1, 0); PG8_STAGE(PG8_SA(0, 1), a2 + hstep, voffA);
            PG8_WAIT_L(8); PG8_BAR; PG8_WAIT_L(0); PG8_MMA(0, 0, At, B0); PG8_BAR; PG8_SCHED;
            PG8_LDB(B1, 1, 1); PG8_STAGE(PG8_SB(1, 0), b3, voffB);
            PG8_BAR; PG8_WAIT_L(0); PG8_MMA(0, 1, At, B1); PG8_BAR;
            PG8_LDA(At, 1, 1); PG8_STAGE(PG8_SA(1, 0), a3, voffA);
            PG8_BAR; PG8_WAIT_L(0); PG8_MMA(1, 0, At, B0); PG8_BAR; PG8_SCHED;
            PG8_STAGE(PG8_SB(1, 1), b3 + hstep, voffB);
            PG8_WAIT_V(6); PG8_BAR; PG8_MMA(1, 1, At, B1); PG8_BAR;
            }
        }
        if constexpr (ALIGN_EPI) { if (wr == 0) PG8_BAR; }
        if constexpr (!Epi::AFTER_DRAIN) { int fr_ = fr, fq_ = fq; asm volatile("" : "+v"(fr_), "+v"(fq_));
            if constexpr (Epi::CHAIN) E.template chain<XROWS>(acc, accx, cur, wr, wc, fr_, fq_); else { E(acc, cur, wr, wc, fr_, fq_); if constexpr (XROWS) E.xrows(accx, cur, wr, wc, fr_, fq_); }
            S.done(cur); }
        if (!has_next) break;
        if (!(Epi::CHAIN && cur.kind == 0)) {
#pragma unroll
        for (int a = 0; a < 2; ++a)
#pragma unroll
            for (int b = 0; b < 2; ++b)
#pragma unroll
                for (int m = 0; m < 4; ++m)
#pragma unroll
                    for (int n = 0; n < 2; ++n) acc[a][b][m][n] = (f32x4){0.f, 0.f, 0.f, 0.f};
        accx[0] = (f32x4){0.f, 0.f, 0.f, 0.f}; accx[1] = (f32x4){0.f, 0.f, 0.f, 0.f};
        }
        cur = nxt; cA = nA; cB = nB; cX = nX; ++ui; kr = S.krot(cur);
        if constexpr (ALIGN_EPI) { if (wr == 1) PG8_BAR; }
    }
    PG8_WAIT_V(0);
    if constexpr (!ALIGN_EPI) { if (wr == 0) PG8_BAR; }
    PG8_BAR;
    if constexpr (Epi::AFTER_DRAIN) { E.template fused<XROWS>(acc, accx, cur, wr, wc, fr, fq, lds, wid, lane); S.done(cur); }
#undef PG8_SA
#undef PG8_SB
#undef PG8_STAGE
#undef PG8_LDA
#undef PG8_LDB
#undef PG8_MMA
#undef PG8_WAIT_V
#undef PG8_WAIT_V2
#undef PG8_XS
#undef PG8_STAGEX
#undef PG8_LDX
#undef PG8_MMAX
#undef PG8_WAIT_L
#undef PG8_BAR
#undef PG8_SCHED
}
}
constexpr int DM = 1024, NB_P = 8, SEQ_P = 2048, NB_S = 128, SEQ_S = 8, DEPTH = 2;
constexpr int MP = NB_P * SEQ_P;
constexpr int MS = NB_S * SEQ_S;
constexpr int M = MP + MS;
constexpr int NSEQ = NB_P + NB_S;
constexpr int DFF = 2816, NMOD = 9 * DM, DPROJ = 8208, DXBC = 2048;
constexpr float EPS = 1e-6f;

__device__ __forceinline__ int mod_row(int m) { return m < MP ? (m >> 11) : NB_P + ((m - MP) >> 3); }
__device__ __forceinline__ float bf_lo(unsigned w) { return __uint_as_float(w << 16); }
__device__ __forceinline__ float bf_hi(unsigned w) { return __uint_as_float(w & 0xffff0000u); }
__device__ __forceinline__ float fast_sigmoid(float x) { return __builtin_amdgcn_rcpf(1.f + __expf(-x)); }
__device__ __forceinline__ float fast_silu(float x) { return x * fast_sigmoid(x); }

__device__ __forceinline__ __amdgpu_buffer_rsrc_t wt_rsrc(void* base) { return __builtin_amdgcn_make_buffer_rsrc(base, 0, 0x7ffffff0, 0x00020000); }
#ifdef USE_WT
#define WT_STORE16(rs, base, byteoff, val) __builtin_amdgcn_raw_buffer_store_b128((val), (rs), (int)(byteoff), 0, 16)
#else
#define WT_STORE16(rs, base, byteoff, val) (*(pg8::u32x4*)((char*)(base) + (byteoff)) = (val))
#endif
namespace pg8 {
struct EpiMod {
    static constexpr bool CHAIN = false, PERM = false, AFTER_DRAIN = false;
    __device__ __forceinline__ void prefetch(const Unit&, int, int, int, int) const {}
    float* C; const float* bias; float* GS; const float* GN;
    __device__ __forceinline__ void operator()(const f32x4 (&acc)[2][2][4][2], const Unit& u, int wr, int wc, int fr, int fq) const {
        const int row0 = u.pm * BM + wr * 64 + fr, col0 = u.pn * BM + wc * 32 + 4 * fq;
        const int ch = u.pn >> 2, jn = ch / 3, kind = ch - 3 * jn, cc0 = (u.pn & 3) * BM + wc * 32 + 4 * fq;
        const float* gn = GN + jn * DM;
        f32x4 bv[2][2], gv[2][2];
#pragma unroll
        for (int bj = 0; bj < 2; ++bj)
#pragma unroll
            for (int n = 0; n < 2; ++n) { bv[bj][n] = *(const f32x4*)(bias + col0 + bj * HALF + n * 16); gv[bj][n] = *(const f32x4*)(gn + cc0 + bj * HALF + n * 16); }
#pragma unroll
        for (int ai = 0; ai < 2; ++ai)
#pragma unroll
            for (int m = 0; m < 4; ++m) { const int r = row0 + ai * HALF + m * 16;
                if (r < NSEQ) { float* rowp = C + (size_t)r * NMOD + col0;
#pragma unroll
                    for (int bj = 0; bj < 2; ++bj)
#pragma unroll
                        for (int n = 0; n < 2; ++n) { const f32x4 v = acc[ai][bj][m][n] + bv[bj][n]; const int cc = cc0 + bj * HALF + n * 16;
                            if (kind == 1) *(f32x4*)(GS + ((size_t)jn * NSEQ + r) * DM + cc) = gv[bj][n] * (v + 1.f);
                            else *(f32x4*)(rowp + bj * HALF + n * 16) = v; } } }
    }
};
struct EpiSwiglu {
    static constexpr bool CHAIN = false, PERM = true, AFTER_DRAIN = false;
    __device__ __forceinline__ void prefetch(const Unit&, int, int, int, int) const {}
    bf16_t* O;
    __device__ __forceinline__ void operator()(const f32x4 (&acc)[2][2][4][2], const Unit& u, int wr, int wc, int fr, int fq) const {
        const int row0 = u.pm * BM + wr * 64 + fr, col0 = u.pn * HALF + wc * 32 + 8 * fq;
#pragma unroll
        for (int ai = 0; ai < 2; ++ai)
#pragma unroll
            for (int m = 0; m < 4; ++m) { bf16_t* rowp = O + (size_t)(row0 + ai * HALF + m * 16) * DFF + col0;
                const f32x4 g0 = acc[ai][0][m][0], g1 = acc[ai][0][m][1], u0 = acc[ai][1][m][0], u1 = acc[ai][1][m][1];
                u32x4 w;
                w.x = cvt_pk_bf16(fast_silu(g0[0]) * u0[0], fast_silu(g0[1]) * u0[1]); w.y = cvt_pk_bf16(fast_silu(g0[2]) * u0[2], fast_silu(g0[3]) * u0[3]);
                w.z = cvt_pk_bf16(fast_silu(g1[0]) * u1[0], fast_silu(g1[1]) * u1[1]); w.w = cvt_pk_bf16(fast_silu(g1[2]) * u1[2], fast_silu(g1[3]) * u1[3]);
                *(u32x4*)rowp = w; }
    }
};
struct EpiProj {
    static constexpr bool CHAIN = false, PERM = true, AFTER_DRAIN = false;
    __device__ __forceinline__ void prefetch(const Unit&, int, int, int, int) const {}
    bf16_t* P; int pn0 = 0;
    __device__ __forceinline__ void operator()(const f32x4 (&acc)[2][2][4][2], const Unit& u, int wr, int wc, int fr, int fq) const {
        const int pn = u.pn + pn0, t = pn >> 2; bf16_t* base = P + (size_t)t * M * DM;
        const int row0 = u.pm * BM + wr * 64 + fr, col0 = (pn & 3) * BM + wc * 32 + 8 * fq;
        const bool sg = t >= 6;
        if (t == 4 || t == 5) {
            bf16_t* pb = P + (size_t)4 * M * DM + (pn - 16) * HALF + wc * 32 + 8 * fq;
#pragma unroll
            for (int ai = 0; ai < 2; ++ai)
#pragma unroll
                for (int m = 0; m < 4; ++m) { const f32x4 c0 = acc[ai][0][m][0] * acc[ai][1][m][0], c1 = acc[ai][0][m][1] * acc[ai][1][m][1];
                    u32x4 w; w.x = cvt_pk_bf16(c0[0], c0[1]); w.y = cvt_pk_bf16(c0[2], c0[3]); w.z = cvt_pk_bf16(c1[0], c1[1]); w.w = cvt_pk_bf16(c1[2], c1[3]);
                    *(u32x4*)(pb + (size_t)(row0 + ai * HALF + m * 16) * DM) = w; }
            return; }
#pragma unroll
        for (int ai = 0; ai < 2; ++ai)
#pragma unroll
            for (int m = 0; m < 4; ++m) { bf16_t* rowp = base + (size_t)(row0 + ai * HALF + m * 16) * DM + col0;
#pragma unroll
                for (int bj = 0; bj < 2; ++bj) { f32x4 v0 = acc[ai][bj][m][0], v1 = acc[ai][bj][m][1];
                    if (sg) {
#pragma unroll
                        for (int i = 0; i < 4; ++i) { v0[i] = fast_sigmoid(v0[i]); v1[i] = fast_sigmoid(v1[i]); } }
                    u32x4 w; w.x = cvt_pk_bf16(v0[0], v0[1]); w.y = cvt_pk_bf16(v0[2], v0[3]); w.z = cvt_pk_bf16(v1[0], v1[1]); w.w = cvt_pk_bf16(v1[2], v1[3]);
                    *(u32x4*)(rowp + bj * HALF) = w; } }
    }
};
template <bool HALFSC, bool XF32> struct EpiResidLN {
    static constexpr bool CHAIN = false, PERM = true, AFTER_DRAIN = true;
    __device__ __forceinline__ void prefetch(const Unit&, int, int, int, int) const {}
    const void* Xin; bf16_t* X; const float* gate;
    const float* XinS = nullptr;
    bf16_t* H; const float* GS; const float* SH; float* SSQ; unsigned* cnt;
    template <bool XR> __device__ __forceinline__ void fused(f32x4 (&acc)[2][2][4][2], f32x4 (&accx)[2], const Unit& u, int wr, int wc, int fr, int fq, PG8_LAS unsigned char*, int, int) const {
        constexpr float sc = HALFSC ? 0.5f : 1.0f;
        const int col0 = u.pn * BM + wc * 32 + 8 * fq, mr = mod_row(u.pm * BM), rbase = u.pm * BM + wr * 64 + fr;
        f32x4 g4[2][2];
#pragma unroll
        for (int bj = 0; bj < 2; ++bj)
#pragma unroll
            for (int n = 0; n < 2; ++n) g4[bj][n] = *(const f32x4*)(gate + (size_t)mr * NMOD + col0 + bj * HALF + n * 4) * sc;
        float ssr[8];
        f32x4 xc[2][2], xnx[2][2]; u32x4 xr[2], xrn[2];
        if constexpr (XF32) {
#pragma unroll
            for (int bj = 0; bj < 2; ++bj)
#pragma unroll
                for (int n = 0; n < 2; ++n) xc[bj][n] = *(const f32x4*)((const float*)Xin + (size_t)rbase * DM + col0 + bj * HALF + n * 4);
        } else {
#pragma unroll
            for (int bj = 0; bj < 2; ++bj) xr[bj] = *(const u32x4*)((const bf16_t*)Xin + (size_t)rbase * DM + col0 + bj * HALF);
        }
#pragma unroll
        for (int q = 0; q < 8; ++q) { const int ai = q >> 2, m = q & 3; const int r = rbase + ai * HALF + m * 16;
            if (q < 7) { const int rn = rbase + ((q + 1) >> 2) * HALF + ((q + 1) & 3) * 16;
                if constexpr (XF32) {
#pragma unroll
                    for (int bj = 0; bj < 2; ++bj)
#pragma unroll
                        for (int n = 0; n < 2; ++n) xnx[bj][n] = *(const f32x4*)((const float*)Xin + (size_t)rn * DM + col0 + bj * HALF + n * 4);
                } else {
#pragma unroll
                    for (int bj = 0; bj < 2; ++bj) xrn[bj] = *(const u32x4*)((const bf16_t*)Xin + (size_t)rn * DM + col0 + bj * HALF);
                } }
            if constexpr (!XF32) {
#pragma unroll
                for (int bj = 0; bj < 2; ++bj) { xc[bj][0] = (f32x4){bf_lo(xr[bj].x), bf_hi(xr[bj].x), bf_lo(xr[bj].y), bf_hi(xr[bj].y)}; xc[bj][1] = (f32x4){bf_lo(xr[bj].z), bf_hi(xr[bj].z), bf_lo(xr[bj].w), bf_hi(xr[bj].w)}; } }
            float ss = 0.f;
#pragma unroll
            for (int bj = 0; bj < 2; ++bj) {
#pragma unroll
                for (int n = 0; n < 2; ++n) { const f32x4 xn = xc[bj][n] + g4[bj][n] * acc[ai][bj][m][n]; acc[ai][bj][m][n] = xn;
                    ss += (xn[0] * xn[0] + xn[1] * xn[1]) + (xn[2] * xn[2] + xn[3] * xn[3]); }
            }
            ss += __shfl_xor(ss, 16); ss += __shfl_xor(ss, 32); ssr[q] = ss;
            if constexpr (XF32) {
#pragma unroll
                for (int bj = 0; bj < 2; ++bj)
#pragma unroll
                    for (int n = 0; n < 2; ++n) xc[bj][n] = xnx[bj][n];
            } else { xr[0] = xrn[0]; xr[1] = xrn[1]; } }
        if (fq == 0) {
#pragma unroll
            for (int q = 0; q < 8; ++q) atomicAdd(SSQ + rbase + (q >> 2) * HALF + (q & 3) * 16, ssr[q]); }
        const int ms = MP + 16 * u.pm + fr, mrs = mod_row(ms), cx = u.pn * BM + wr * HALF + wc * 32 + 8 * fq;
        if constexpr (XR) {
            const f32x4 xg0 = *(const f32x4*)(gate + (size_t)mrs * NMOD + cx) * sc, xg1 = *(const f32x4*)(gate + (size_t)mrs * NMOD + cx + 4) * sc;
            f32x4 x0, x1;
            if constexpr (XF32) { const float* xp = XinS + (size_t)(ms - MP) * DM + cx; x0 = *(const f32x4*)xp; x1 = *(const f32x4*)(xp + 4); }
            else { const u32x4 xw = *(const u32x4*)((const bf16_t*)Xin + (size_t)ms * DM + cx); x0 = (f32x4){bf_lo(xw.x), bf_hi(xw.x), bf_lo(xw.y), bf_hi(xw.y)}; x1 = (f32x4){bf_lo(xw.z), bf_hi(xw.z), bf_lo(xw.w), bf_hi(xw.w)}; }
            const f32x4 a = x0 + xg0 * accx[0], b = x1 + xg1 * accx[1]; accx[0] = a; accx[1] = b;
            float ss = ((a[0] * a[0] + a[1] * a[1]) + (a[2] * a[2] + a[3] * a[3])) + ((b[0] * b[0] + b[1] * b[1]) + (b[2] * b[2] + b[3] * b[3]));
            ss += __shfl_xor(ss, 16); ss += __shfl_xor(ss, 32);
            if (fq == 0) atomicAdd(SSQ + ms, ss);
        }
        f32x4 gs[2][2], sh[2][2];
#pragma unroll
        for (int bj = 0; bj < 2; ++bj)
#pragma unroll
            for (int n = 0; n < 2; ++n) { gs[bj][n] = *(const f32x4*)(GS + (size_t)mr * DM + col0 + bj * HALF + n * 4); sh[bj][n] = *(const f32x4*)(SH + (size_t)mr * NMOD + col0 + bj * HALF + n * 4); }
        asm volatile("s_waitcnt vmcnt(0)" ::: "memory");
        __syncthreads();
        if (threadIdx.x == 0) { unsigned* c = cnt + 64 * u.pm;
            __hip_atomic_fetch_add(c, 1u, __ATOMIC_RELAXED, __HIP_MEMORY_SCOPE_AGENT);
            unsigned sp = 0; while (__hip_atomic_load(c, __ATOMIC_RELAXED, __HIP_MEMORY_SCOPE_AGENT) < 4u && ++sp < (1u << 22)) __builtin_amdgcn_s_sleep(1); }
        __syncthreads();
        float totq[8];
#pragma unroll
        for (int q = 0; q < 8; ++q) totq[q] = __hip_atomic_load(SSQ + rbase + (q >> 2) * HALF + (q & 3) * 16, __ATOMIC_RELAXED, __HIP_MEMORY_SCOPE_AGENT);
#pragma unroll
        for (int q = 0; q < 8; ++q) { const int ai = q >> 2, m = q & 3; const int r = rbase + ai * HALF + m * 16;
            const float rinv = 1.f / sqrtf(totq[q] * (1.f / DM) + EPS);
#pragma unroll
            for (int bj = 0; bj < 2; ++bj) { const f32x4 xa = acc[ai][bj][m][0], xb = acc[ai][bj][m][1];
                u32x4 wx; wx.x = cvt_pk_bf16(xa[0], xa[1]); wx.y = cvt_pk_bf16(xa[2], xa[3]); wx.z = cvt_pk_bf16(xb[0], xb[1]); wx.w = cvt_pk_bf16(xb[2], xb[3]);
                *(u32x4*)(X + (size_t)r * DM + col0 + bj * HALF) = wx;
                const f32x4 a = (xa * rinv) * gs[bj][0] + sh[bj][0], b = (xb * rinv) * gs[bj][1] + sh[bj][1];
                u32x4 w; w.x = cvt_pk_bf16(a[0], a[1]); w.y = cvt_pk_bf16(a[2], a[3]); w.z = cvt_pk_bf16(b[0], b[1]); w.w = cvt_pk_bf16(b[2], b[3]);
                *(u32x4*)(H + (size_t)r * DM + col0 + bj * HALF) = w; } }
        if constexpr (XR) {
            const float tot = __hip_atomic_load(SSQ + ms, __ATOMIC_RELAXED, __HIP_MEMORY_SCOPE_AGENT);
            const float rinv = 1.f / sqrtf(tot * (1.f / DM) + EPS);
            const f32x4 a = (accx[0] * rinv) * *(const f32x4*)(GS + (size_t)mrs * DM + cx) + *(const f32x4*)(SH + (size_t)mrs * NMOD + cx), b = (accx[1] * rinv) * *(const f32x4*)(GS + (size_t)mrs * DM + cx + 4) + *(const f32x4*)(SH + (size_t)mrs * NMOD + cx + 4);
            u32x4 w; w.x = cvt_pk_bf16(a[0], a[1]); w.y = cvt_pk_bf16(a[2], a[3]); w.z = cvt_pk_bf16(b[0], b[1]); w.w = cvt_pk_bf16(b[2], b[3]);
            *(u32x4*)(H + (size_t)ms * DM + cx) = w;
            u32x4 wx; wx.x = cvt_pk_bf16(accx[0][0], accx[0][1]); wx.y = cvt_pk_bf16(accx[0][2], accx[0][3]); wx.z = cvt_pk_bf16(accx[1][0], accx[1][1]); wx.w = cvt_pk_bf16(accx[1][2], accx[1][3]);
            *(u32x4*)(X + (size_t)ms * DM + cx) = wx; }
    }
};
template <bool FIRST> struct EpiGate {
    static constexpr bool CHAIN = false, PERM = true, AFTER_DRAIN = false;
    __device__ __forceinline__ void prefetch(const Unit&, int, int, int, int) const {}
    bf16_t* T; const bf16_t* G;
    __device__ __forceinline__ void operator()(const f32x4 (&acc)[2][2][4][2], const Unit& u, int wr, int wc, int fr, int fq) const {
        const int row0 = u.pm * BM + wr * 64 + fr, col0 = u.pn * BM + wc * 32 + 8 * fq;
        u32x4 gc[2], tc[2], gn[2], tn[2];
#pragma unroll
        for (int bj = 0; bj < 2; ++bj) { const size_t ro = (size_t)row0 * DM + col0 + bj * HALF; gc[bj] = *(const u32x4*)(G + ro); if (!FIRST) tc[bj] = *(const u32x4*)(T + ro); }
#pragma unroll
        for (int q = 0; q < 8; ++q) { const int ai = q >> 2, m = q & 3; const size_t ro = (size_t)(row0 + ai * HALF + m * 16) * DM + col0;
            if (q < 7) { const size_t rn = (size_t)(row0 + ((q + 1) >> 2) * HALF + ((q + 1) & 3) * 16) * DM + col0;
#pragma unroll
                for (int bj = 0; bj < 2; ++bj) { gn[bj] = *(const u32x4*)(G + rn + bj * HALF); if (!FIRST) tn[bj] = *(const u32x4*)(T + rn + bj * HALF); } }
#pragma unroll
            for (int bj = 0; bj < 2; ++bj) { const u32x4 gw = gc[bj];
                const f32x4 a0 = acc[ai][bj][m][0], a1 = acc[ai][bj][m][1];
                float o[8];
                o[0] = bf_lo(gw.x) * a0[0]; o[1] = bf_hi(gw.x) * a0[1]; o[2] = bf_lo(gw.y) * a0[2]; o[3] = bf_hi(gw.y) * a0[3];
                o[4] = bf_lo(gw.z) * a1[0]; o[5] = bf_hi(gw.z) * a1[1]; o[6] = bf_lo(gw.w) * a1[2]; o[7] = bf_hi(gw.w) * a1[3];
                if (!FIRST) { const u32x4 tw = tc[bj];
                    o[0] += bf_lo(tw.x); o[1] += bf_hi(tw.x); o[2] += bf_lo(tw.y); o[3] += bf_hi(tw.y); o[4] += bf_lo(tw.z); o[5] += bf_hi(tw.z); o[6] += bf_lo(tw.w); o[7] += bf_hi(tw.w); }
                u32x4 w; w.x = cvt_pk_bf16(o[0], o[1]); w.y = cvt_pk_bf16(o[2], o[3]); w.z = cvt_pk_bf16(o[4], o[5]); w.w = cvt_pk_bf16(o[6], o[7]);
                *(u32x4*)(T + ro + bj * HALF) = w; }
#pragma unroll
            for (int bj = 0; bj < 2; ++bj) { gc[bj] = gn[bj]; if (!FIRST) tc[bj] = tn[bj]; } }
    }
};
struct EpiGate2 {
    static constexpr bool CHAIN = true, PERM = true, AFTER_DRAIN = false;
    __device__ __forceinline__ void prefetch(const Unit&, int, int, int, int) const {}
    bf16_t* T; const bf16_t* G1; const bf16_t* G2;
    template <bool XR> __device__ __forceinline__ void chain(f32x4 (&acc)[2][2][4][2], f32x4 (&accx)[2], const Unit& u, int wr, int wc, int fr, int fq) const {
        if (u.kind != 0) { EpiGate<true> e{T, G2}; e(acc, u, wr, wc, fr, fq); }
        else {
        const int row0 = u.pm * BM + wr * 64 + fr, col0 = u.pn * BM + wc * 32 + 8 * fq;
#pragma unroll
        for (int q = 0; q < 8; ++q) { const int ai = q >> 2, m = q & 3; const size_t ro = (size_t)(row0 + ai * HALF + m * 16) * DM + col0;
#pragma unroll
            for (int bj = 0; bj < 2; ++bj) { const u32x4 a = *(const u32x4*)(G1 + ro + bj * HALF), b = *(const u32x4*)(G2 + ro + bj * HALF);
                f32x4 r0, r1;
                r0[0] = bf_lo(a.x) * __builtin_amdgcn_rcpf(fmaxf(bf_lo(b.x), 1e-30f)); r0[1] = bf_hi(a.x) * __builtin_amdgcn_rcpf(fmaxf(bf_hi(b.x), 1e-30f));
                r0[2] = bf_lo(a.y) * __builtin_amdgcn_rcpf(fmaxf(bf_lo(b.y), 1e-30f)); r0[3] = bf_hi(a.y) * __builtin_amdgcn_rcpf(fmaxf(bf_hi(b.y), 1e-30f));
                r1[0] = bf_lo(a.z) * __builtin_amdgcn_rcpf(fmaxf(bf_lo(b.z), 1e-30f)); r1[1] = bf_hi(a.z) * __builtin_amdgcn_rcpf(fmaxf(bf_hi(b.z), 1e-30f));
                r1[2] = bf_lo(a.w) * __builtin_amdgcn_rcpf(fmaxf(bf_lo(b.w), 1e-30f)); r1[3] = bf_hi(a.w) * __builtin_amdgcn_rcpf(fmaxf(bf_hi(b.w), 1e-30f));
                acc[ai][bj][m][0] = acc[ai][bj][m][0] * r0; acc[ai][bj][m][1] = acc[ai][bj][m][1] * r1; } }
        }
        __builtin_amdgcn_sched_barrier(0);
        if constexpr (XR) {
            const size_t xo = (size_t)(MP + 16 * u.pm + fr) * DM + u.pn * BM + wr * HALF + wc * 32 + 8 * fq;
            const u32x4 b = *(const u32x4*)(G2 + xo);
            const f32x4 g0 = {bf_lo(b.x), bf_hi(b.x), bf_lo(b.y), bf_hi(b.y)}, g1 = {bf_lo(b.z), bf_hi(b.z), bf_lo(b.w), bf_hi(b.w)};
            if (u.kind == 0) { const u32x4 a = *(const u32x4*)(G1 + xo);
                const f32x4 a0 = {bf_lo(a.x), bf_hi(a.x), bf_lo(a.y), bf_hi(a.y)}, a1 = {bf_lo(a.z), bf_hi(a.z), bf_lo(a.w), bf_hi(a.w)};
#pragma unroll
                for (int i = 0; i < 4; ++i) { accx[0][i] *= a0[i] * __builtin_amdgcn_rcpf(fmaxf(g0[i], 1e-30f)); accx[1][i] *= a1[i] * __builtin_amdgcn_rcpf(fmaxf(g1[i], 1e-30f)); } }
            else { const f32x4 o0 = accx[0] * g0, o1 = accx[1] * g1;
                u32x4 w; w.x = cvt_pk_bf16(o0[0], o0[1]); w.y = cvt_pk_bf16(o0[2], o0[3]); w.z = cvt_pk_bf16(o1[0], o1[1]); w.w = cvt_pk_bf16(o1[2], o1[3]);
                *(u32x4*)(T + xo) = w; } }
    }
};
struct EpiFinal {
    static constexpr bool CHAIN = false, PERM = true, AFTER_DRAIN = true;
    __device__ __forceinline__ void prefetch(const Unit&, int, int, int, int) const {}
    const bf16_t* Xin; float* Y; const float* gate; const float* gfin; float* SSF; unsigned* cnt;
    template <bool XR> __device__ __forceinline__ void fused(f32x4 (&acc)[2][2][4][2], f32x4 (&accx)[2], const Unit& u, int wr, int wc, int fr, int fq, PG8_LAS unsigned char*, int, int) const {
        const int col0 = u.pn * BM + wc * 32 + 8 * fq, mr = mod_row(u.pm * BM), rbase = u.pm * BM + wr * 64 + fr;
        f32x4 g4[2][2];
#pragma unroll
        for (int bj = 0; bj < 2; ++bj)
#pragma unroll
            for (int n = 0; n < 2; ++n) g4[bj][n] = *(const f32x4*)(gate + (size_t)mr * NMOD + col0 + bj * HALF + n * 4) * 0.5f;
        float ssr[8];
#pragma unroll
        for (int q = 0; q < 8; ++q) { const int ai = q >> 2, m = q & 3; const int r = rbase + ai * HALF + m * 16; float ss = 0.f;
#pragma unroll
            for (int bj = 0; bj < 2; ++bj) { const u32x4 xw = *(const u32x4*)(Xin + (size_t)r * DM + col0 + bj * HALF);
                const f32x4 x0 = (f32x4){bf_lo(xw.x), bf_hi(xw.x), bf_lo(xw.y), bf_hi(xw.y)}, x1 = (f32x4){bf_lo(xw.z), bf_hi(xw.z), bf_lo(xw.w), bf_hi(xw.w)};
                const f32x4 n0 = x0 + g4[bj][0] * acc[ai][bj][m][0], n1 = x1 + g4[bj][1] * acc[ai][bj][m][1]; acc[ai][bj][m][0] = n0; acc[ai][bj][m][1] = n1;
                ss += ((n0[0] * n0[0] + n0[1] * n0[1]) + (n0[2] * n0[2] + n0[3] * n0[3])) + ((n1[0] * n1[0] + n1[1] * n1[1]) + (n1[2] * n1[2] + n1[3] * n1[3])); }
            ss += __shfl_xor(ss, 16); ss += __shfl_xor(ss, 32); ssr[q] = ss; }
        if (fq == 0) {
#pragma unroll
            for (int q = 0; q < 8; ++q) atomicAdd(SSF + rbase + (q >> 2) * HALF + (q & 3) * 16, ssr[q]); }
        const int ms = MP + 16 * u.pm + fr, cx = u.pn * BM + wr * HALF + wc * 32 + 8 * fq;
        if constexpr (XR) { const int mrs = mod_row(ms);
            const f32x4 xg0 = *(const f32x4*)(gate + (size_t)mrs * NMOD + cx) * 0.5f, xg1 = *(const f32x4*)(gate + (size_t)mrs * NMOD + cx + 4) * 0.5f;
            const u32x4 xw = *(const u32x4*)(Xin + (size_t)ms * DM + cx);
            const f32x4 x0 = (f32x4){bf_lo(xw.x), bf_hi(xw.x), bf_lo(xw.y), bf_hi(xw.y)}, x1 = (f32x4){bf_lo(xw.z), bf_hi(xw.z), bf_lo(xw.w), bf_hi(xw.w)};
            const f32x4 a = x0 + xg0 * accx[0], b = x1 + xg1 * accx[1]; accx[0] = a; accx[1] = b;
            float ss = ((a[0] * a[0] + a[1] * a[1]) + (a[2] * a[2] + a[3] * a[3])) + ((b[0] * b[0] + b[1] * b[1]) + (b[2] * b[2] + b[3] * b[3]));
            ss += __shfl_xor(ss, 16); ss += __shfl_xor(ss, 32);
            if (fq == 0) atomicAdd(SSF + ms, ss); }
        asm volatile("s_waitcnt vmcnt(0)" ::: "memory");
        __syncthreads();
        if (threadIdx.x == 0) { unsigned* c = cnt + 64 * u.pm;
            __hip_atomic_fetch_add(c, 1u, __ATOMIC_RELAXED, __HIP_MEMORY_SCOPE_AGENT);
            unsigned sp = 0; while (__hip_atomic_load(c, __ATOMIC_RELAXED, __HIP_MEMORY_SCOPE_AGENT) < 4u && ++sp < (1u << 22)) __builtin_amdgcn_s_sleep(1); }
        __syncthreads();
        f32x4 gf[2][2];
#pragma unroll
        for (int bj = 0; bj < 2; ++bj)
#pragma unroll
            for (int n = 0; n < 2; ++n) gf[bj][n] = *(const f32x4*)(gfin + col0 + bj * HALF + n * 4);
        float totq[8];
#pragma unroll
        for (int q = 0; q < 8; ++q) totq[q] = __hip_atomic_load(SSF + rbase + (q >> 2) * HALF + (q & 3) * 16, __ATOMIC_RELAXED, __HIP_MEMORY_SCOPE_AGENT);
#pragma unroll
        for (int q = 0; q < 8; ++q) { const int ai = q >> 2, m = q & 3; const int r = rbase + ai * HALF + m * 16;
            const float rinv = 1.f / sqrtf(totq[q] * (1.f / DM) + EPS);
#pragma unroll
            for (int bj = 0; bj < 2; ++bj)
#pragma unroll
                for (int n = 0; n < 2; ++n) *(f32x4*)(Y + (size_t)r * DM + col0 + bj * HALF + n * 4) = (acc[ai][bj][m][n] * rinv) * gf[bj][n]; }
        if constexpr (XR) {
            const float tot = __hip_atomic_load(SSF + ms, __ATOMIC_RELAXED, __HIP_MEMORY_SCOPE_AGENT);
            const float rinv = 1.f / sqrtf(tot * (1.f / DM) + EPS);
            *(f32x4*)(Y + (size_t)ms * DM + cx) = (accx[0] * rinv) * *(const f32x4*)(gfin + cx); *(f32x4*)(Y + (size_t)ms * DM + cx + 4) = (accx[1] * rinv) * *(const f32x4*)(gfin + cx + 4); }
    }
};
}

constexpr size_t MiB = 1u << 20;
constexpr size_t WS_CTL = 0, CTL_ZERO_BYTES = 1 * MiB;
constexpr size_t WO_GU1 = 0, WO_D1 = WO_GU1 + (size_t)2 * DFF * DM, WO_IN = WO_D1 + (size_t)DFF * DM, WO_SSD = WO_IN + (size_t)DPROJ * DM,
                 WO_SC = WO_SSD + (size_t)DM * DM, WO_O = WO_SC + (size_t)DM * DM, WO_GU2 = WO_O + (size_t)DM * DM, WO_D2 = WO_GU2 + (size_t)2 * DFF * DM,
                 W_LAYER_ELEMS = WO_D2 + (size_t)DFF * DM;
constexpr size_t WS_WT = 1 * MiB;
constexpr size_t WS_MOD = 112 * MiB;
constexpr size_t WS_DT = 122 * MiB;
constexpr size_t WS_CA = 124 * MiB;
constexpr size_t WS_SHA = WS_CA + MiB / 2;
constexpr size_t WS_GS = WS_SHA + 3 * MiB;
constexpr size_t WS_SWDT = WS_GS + 3 * MiB + MiB / 4;
constexpr size_t WS_GN = WS_SWDT + 32768;
constexpr size_t WS_H = 131 * MiB;
constexpr size_t WS_S = 165 * MiB;
constexpr size_t WS_CD = WS_DT + (size_t)M * 16 * 4;
constexpr size_t WS_P = 229 * MiB;
constexpr size_t WS_SW = 501 * MiB;
constexpr size_t SW_LAYER = (size_t)NSEQ * (5632 + 8192 + 5632);
constexpr size_t WS_END = WS_SW + 2 * SW_LAYER * 2;
static_assert(WS_END <= 512 * MiB, "workspace budget");
static_assert(WS_WT + 2 * W_LAYER_ELEMS * 2 <= WS_MOD && WS_MOD + (size_t)2 * NSEQ * NMOD * 4 <= WS_DT && WS_CD + 8192 <= WS_CA && WS_SWDT + 2 * NSEQ * 16 * 4 <= WS_GN && WS_GN + 6 * DM * 4 <= WS_H && WS_H + (size_t)M * DM * 2 <= WS_S && WS_S + 64 * MiB <= WS_P && WS_P + (size_t)8 * M * DM * 2 <= WS_SW, "d_ws map");
constexpr size_t CTL_SS = 65536;
constexpr size_t CTL_FCNT = CTL_SS + (size_t)7 * M * 4;
static_assert(CTL_FCNT % 256 == 0 && CTL_FCNT + 7 * 80 * 256 <= CTL_ZERO_BYTES, "sumsq rows and counters inside the per-call memset");
constexpr size_t PT = (size_t)M * DM;
enum ProjT { PT_Z = 0, PT_XS = 1, PT_BC = 2, PT_SCB = 3, PT_SCC = 4, PT_SCH = 5, PT_GSSD = 6, PT_GSC = 7 };
constexpr int CW_BAR = 4096;

constexpr int NWAVES = 8;
constexpr int GRID = 256;
constexpr int RING_OFF = 0, RING_BYTES = 131072;
constexpr int SIDE_OFF = RING_BYTES;
constexpr int LDS_BYTES = 163840;
constexpr int LDSCTL_OFF = LDS_BYTES - 512, MISC_OFF = LDSCTL_OFF + 320;

#define GAS __attribute__((address_space(1)))
#define LAS __attribute__((address_space(3)))
typedef unsigned short bf16;
typedef unsigned v4u __attribute__((ext_vector_type(4)));
typedef float f32x4 __attribute__((ext_vector_type(4)));
typedef short bf16x8 __attribute__((ext_vector_type(8)));
typedef GAS unsigned gu32;
typedef GAS unsigned long long gu64;
#define RLX_AGENT __ATOMIC_RELAXED, __HIP_MEMORY_SCOPE_AGENT
#define LDS_WAIT() asm volatile("s_waitcnt lgkmcnt(0)" ::: "memory")
#define VM_WAIT() asm volatile("s_waitcnt vmcnt(0)" ::: "memory")
__device__ __forceinline__ unsigned long long rt() { return __builtin_amdgcn_s_memrealtime(); }
__device__ __forceinline__ unsigned f2bf(float f) { unsigned u = __builtin_bit_cast(unsigned, f); return (u + 0x7fffu + ((u >> 16) & 1u)) >> 16; }
__device__ __forceinline__ unsigned pk2(float lo, float hi) { return f2bf(lo) | (f2bf(hi) << 16); }

#define XB_TMO      128
#define XB_XCNT(j)  (256  + 64 * (j))
#define XB_XSUB(j)  (1280 + 64 * (j))
#define XB_XGEN(j)  (2304 + 64 * (j))
#define XB_TOP      3328
#define XB_TOPGEN   3392
#define XCD_BAR_WORDS 3456
#define XB_SPIN_CAP (1u << 18)

__device__ __forceinline__ unsigned xb_ld(unsigned* p)              { return __hip_atomic_load(p, __ATOMIC_RELAXED, __HIP_MEMORY_SCOPE_AGENT); }
__device__ __forceinline__ unsigned xb_add(unsigned* p, unsigned v) { return __hip_atomic_fetch_add(p, v, __ATOMIC_RELAXED, __HIP_MEMORY_SCOPE_AGENT); }
__device__ __forceinline__ unsigned xb_xcc_id() { return (unsigned)__builtin_amdgcn_s_getreg((3 << 11) | 20) & 0xFu; }
#define XB_SPIN(cond, bar) do { unsigned _sp = 0; while (cond) { __builtin_amdgcn_s_sleep(1); \
    if ((++_sp & 255u) == 0u) { if (xb_ld(&(bar)[XB_TMO])) break; if (_sp > XB_SPIN_CAP) { atomicAdd(&(bar)[XB_TMO], 1u); break; } } } } while (0)

struct XcdBarrier {
    unsigned* bar; unsigned x;
    volatile LAS unsigned* st;
};

__device__ __forceinline__ XcdBarrier xcd_barrier_post(unsigned* bar, volatile LAS unsigned* st) {
    XcdBarrier b; b.bar = bar; b.x = xb_xcc_id(); b.st = st;
    if (threadIdx.x == 0) (void)xb_add(&bar[XB_XCNT(b.x)], 1u);
    return b;
}
__device__ __forceinline__ void xcd_barrier_complete(unsigned* bar, unsigned x, unsigned& nloc, unsigned& nx) {
    const unsigned G = gridDim.x * gridDim.y * gridDim.z;
    unsigned sum, cnt, mine, sp = 0u;
    for (;;) {
        sum = 0u; cnt = 0u; mine = 0u;
#pragma unroll
        for (unsigned j = 0; j < 16; ++j) { const unsigned c = xb_ld(&bar[XB_XCNT(j)]); sum += c; cnt += (c > 0u) ? 1u : 0u; mine = (j == x) ? c : mine; }
        if (sum == G) break;
        __builtin_amdgcn_s_sleep(1);
        if ((++sp & 255u) == 0u) { if (xb_ld(&bar[XB_TMO])) break; if (sp > XB_SPIN_CAP) { atomicAdd(&bar[XB_TMO], 1u); break; } }
    }
    nloc = mine > 0u ? mine : 1u; nx = cnt > 0u ? cnt : 1u;
}

__device__ __forceinline__ void xcd_barrier(const XcdBarrier& b) {
    asm volatile("s_waitcnt vmcnt(0)" ::: "memory");
    __syncthreads();
    if (threadIdx.x == 0) {
        const unsigned myx = xb_xcc_id();
        unsigned* bar = b.bar; asm volatile("" : "+s"(bar));
        __builtin_amdgcn_s_waitcnt(0);
        unsigned nloc = b.st[0], nx = b.st[1];
        if (nloc == 0u) { xcd_barrier_complete(bar, myx, nloc, nx); b.st[0] = nloc; b.st[1] = nx; }
        const unsigned old = xb_add(&bar[XB_XSUB(myx)], 1u);
        const unsigned gen = old / nloc;
        if (old + 1u == (gen + 1u) * nloc) {
            __builtin_amdgcn_fence(__ATOMIC_RELEASE, "agent");
            asm volatile("s_waitcnt vmcnt(0)" ::: "memory");
            const unsigned og = xb_add(&bar[XB_TOP], 1u);
            const unsigned tg = og / nx;
            if (og + 1u == (tg + 1u) * nx) xb_add(&bar[XB_TOPGEN], 1u);
            else XB_SPIN(xb_ld(&bar[XB_TOPGEN]) == tg, bar);
            __builtin_amdgcn_fence(__ATOMIC_ACQUIRE, "agent");
            xb_add(&bar[XB_XGEN(myx)], 1u);
            asm volatile("s_waitcnt vmcnt(0)" ::: "memory");
        } else {
            XB_SPIN(xb_ld(&bar[XB_XGEN(myx)]) == gen, bar);
            __builtin_amdgcn_fence(__ATOMIC_ACQUIRE, "agent");
            asm volatile("s_waitcnt vmcnt(0)" ::: "memory");
        }
    }
    __syncthreads();
}

__device__ __forceinline__ void xcd_arrive(const XcdBarrier& b, unsigned* bar2) {
    asm volatile("s_waitcnt vmcnt(0)" ::: "memory");
    __syncthreads();
    if (threadIdx.x == 0) {
        const unsigned myx = xb_xcc_id();
        unsigned* bar = bar2; asm volatile("" : "+s"(bar));
        __builtin_amdgcn_s_waitcnt(0);
        unsigned nloc = b.st[0], nx = b.st[1];
        if (nloc == 0u) { unsigned* bm = b.bar; asm volatile("" : "+s"(bm)); xcd_barrier_complete(bm, myx, nloc, nx); b.st[0] = nloc; b.st[1] = nx; }
        const unsigned old = xb_add(&bar[XB_XSUB(myx)], 1u);
        if ((old + 1u) % nloc == 0u) {
            __builtin_amdgcn_fence(__ATOMIC_RELEASE, "agent");
            asm volatile("s_waitcnt vmcnt(0)" ::: "memory");
            xb_add(&bar[XB_TOP], 1u);
        }
    }
}
__device__ __forceinline__ void xcd_wait(const XcdBarrier& b, unsigned* bar2, unsigned gen) {
    if (threadIdx.x == 0) {
        unsigned* bar = bar2; asm volatile("" : "+s"(bar));
        const unsigned nx = b.st[1];
        XB_SPIN(xb_ld(&bar[XB_TOP]) < nx * gen, bar);
        __builtin_amdgcn_fence(__ATOMIC_ACQUIRE, "agent");
        asm volatile("s_waitcnt vmcnt(0)" ::: "memory");
    }
    __syncthreads();
}
__device__ __forceinline__ void xcd_barrier_flat(const XcdBarrier& b, unsigned* bar4, volatile LAS unsigned* genw) {
    xcd_arrive(b, bar4);
    if (threadIdx.x == 0) {
        unsigned* bar = bar4; asm volatile("" : "+s"(bar));
        const unsigned gen = genw[0] + 1u; genw[0] = gen;
        const unsigned nx = b.st[1];
        XB_SPIN(xb_ld(&bar[XB_TOP]) < nx * gen, bar);
        __builtin_amdgcn_fence(__ATOMIC_ACQUIRE, "agent");
        asm volatile("s_waitcnt vmcnt(0)" ::: "memory");
    }
    __syncthreads();
}
__device__ __forceinline__ void xcd_arrive3(unsigned* bar3w) {
    asm volatile("s_waitcnt vmcnt(0)" ::: "memory");
    __syncthreads();
    if (threadIdx.x == 0) {
        const unsigned myx = xb_xcc_id();
        unsigned* bar = bar3w; asm volatile("" : "+s"(bar));
        __builtin_amdgcn_s_waitcnt(0);
        __builtin_amdgcn_fence(__ATOMIC_RELEASE, "agent");
        asm volatile("s_waitcnt vmcnt(0)" ::: "memory");
        (void)__hip_atomic_fetch_add(&bar[XB_XSUB(myx)], 1u, __ATOMIC_RELAXED, __HIP_MEMORY_SCOPE_AGENT);
    }
}
__device__ __forceinline__ void xcd_wait3(unsigned* bar3w, unsigned target) {
    if (threadIdx.x == 0) {
        unsigned* bar = bar3w; asm volatile("" : "+s"(bar));
        unsigned sp = 0;
        for (;;) { unsigned s = 0;
#pragma unroll
            for (int j = 0; j < 16; ++j) s += xb_ld(&bar[XB_XSUB(j)]);
            if (s >= target) break;
            __builtin_amdgcn_s_sleep(1);
            if ((++sp & 255u) == 0u) { if (xb_ld(&bar[XB_TMO])) break; if (sp > XB_SPIN_CAP) { atomicAdd(&bar[XB_TMO], 1u); break; } } }
        __builtin_amdgcn_fence(__ATOMIC_ACQUIRE, "agent");
        asm volatile("s_waitcnt vmcnt(0)" ::: "memory");
    }
    __syncthreads();
}
__device__ __forceinline__ void xcd_barrier3(unsigned* bar3w, volatile LAS unsigned* genw, unsigned total) {
    xcd_arrive3(bar3w);
    unsigned gen = 0;
    if (threadIdx.x == 0) { gen = genw[0] + 1u; genw[0] = gen; }
    xcd_wait3(bar3w, gen * total);
}


struct Frame {
    LAS unsigned char* lds;
    volatile LAS unsigned* MISC;
    gu32* ctl;
    int tid, lane, wave;
    int vcu, bx;
    int dry;
    float* out;
    unsigned char* ws;
};
#define DRYP(p) (p)
typedef const unsigned char __attribute__((address_space(4)))* kptr_t;
__device__ __forceinline__ const float* in_ptr(int i) {
    kptr_t kp = (kptr_t)__builtin_amdgcn_kernarg_segment_ptr();
    asm volatile("" : "+s"(kp));
    return *(const float* const __attribute__((address_space(4)))*)(kp + 8 * i);
}
__device__ __forceinline__ bf16* wt_ptr(const Frame& F, int layer, size_t off) { return (bf16*)(F.ws + WS_WT) + (size_t)layer * W_LAYER_ELEMS + off; }
__device__ __forceinline__ bf16* proj_ptr(const Frame& F, int t) { return (bf16*)(F.ws + WS_P) + (size_t)t * PT; }
__device__ __forceinline__ float* ss_ptr(const Frame& F, int idx) { return (float*)(F.ws + WS_CTL + CTL_SS) + (size_t)idx * M; }
__device__ __forceinline__ unsigned* fcnt_ptr(const Frame& F, int idx) { return (unsigned*)(F.ws + WS_CTL + CTL_FCNT) + (size_t)idx * 80 * 64; }
__device__ __forceinline__ float* gs_ptr(const Frame& F, int idx) { return (float*)(F.ws + WS_GS) + (size_t)idx * NSEQ * DM; }
__device__ __forceinline__ bf16* sha_ptr(const Frame& F, int idx) { return (bf16*)(F.ws + WS_SHA) + (size_t)idx * 256 * DM; }
__device__ __forceinline__ bf16* sw_ptr(const Frame& F, int layer, int j) { return (bf16*)(F.ws + WS_SW) + (size_t)layer * SW_LAYER + (size_t)NSEQ * (j == 0 ? 0 : (j == 1 ? 5632 : 5632 + 8192)); }
__device__ __forceinline__ float* mod_ptr(const Frame& F, int layer, int chunk) { return (float*)(F.ws + WS_MOD) + (size_t)layer * NSEQ * NMOD + (size_t)chunk * DM; }

__device__ __forceinline__ void frame_refresh(Frame& F) {
    int t = threadIdx.x; asm volatile("" : "+v"(t));
    F.tid = t; F.lane = t & 63; F.wave = __builtin_amdgcn_readfirstlane(t >> 6);
    int bx = blockIdx.x; asm volatile("" : "+s"(bx));
    F.bx = bx; F.vcu = (bx & 7) * (GRID >> 3) + (bx >> 3);
    kptr_t kp = (kptr_t)__builtin_amdgcn_kernarg_segment_ptr(); asm volatile("" : "+s"(kp));
    F.out = *(float* const __attribute__((address_space(4)))*)(kp + 224); F.ws = *(unsigned char* const __attribute__((address_space(4)))*)(kp + 232);
}
template <int CTRL> __device__ __forceinline__ float dpp_mov(float v) { return __builtin_bit_cast(float, __builtin_amdgcn_update_dpp(0, __builtin_bit_cast(int, v), CTRL, 0xF, 0xF, true)); }
__device__ __forceinline__ float wave_sum(float v) {
    v += dpp_mov<0xB1>(v); v += dpp_mov<0x4E>(v); v += dpp_mov<0x141>(v); v += dpp_mov<0x140>(v);
    const int vi = __builtin_bit_cast(int, v);
    const float s0 = __builtin_bit_cast(float, __builtin_amdgcn_readlane(vi, 0)), s1 = __builtin_bit_cast(float, __builtin_amdgcn_readlane(vi, 16)),
                s2 = __builtin_bit_cast(float, __builtin_amdgcn_readlane(vi, 32)), s3 = __builtin_bit_cast(float, __builtin_amdgcn_readlane(vi, 48));
    return (s0 + s1) + (s2 + s3);
}
__device__ __forceinline__ float bf2f(bf16 b) { return __uint_as_float((unsigned)b << 16); }

template <int MAP> __device__ __forceinline__ int dest_row(int c) {
    if (MAP == 1) { return c < DFF ? (((c >> 7) << 8) + (c & 127)) : ((((c - DFF) >> 7) << 8) + 128 + ((c - DFF) & 127)); }
    if (MAP == 2) { const int d = c < 3072 ? c : (c < 3088 ? 8192 + (c - 3072) : c - 16);
        if (d >= 4096 && d < 6144) { const int j = d < 5120 ? d - 4096 : d - 5120; return 4096 + ((j >> 7) << 8) + (d < 5120 ? 0 : 128) + (j & 127); }
        return d; }
    return c;
}
template <int MAP> __device__ __forceinline__ void p0_item_load(const float* W, int N, int item, int nblk, int lane, f32x4 (&v)[16]) {
    const int kb = item / nblk, nb = item % nblk, k0 = 64 * kb, n0 = 64 * nb;
    const int n4 = (lane & 15) * 4, kr = lane >> 4;
    const bool nok = n0 + n4 < N;
    const float* p = W + (size_t)(k0 + kr) * N + (nok ? n0 + n4 : 0);
#pragma unroll
    for (int i = 0; i < 16; ++i) v[i] = *(const f32x4*)(p + (size_t)(4 * i) * N);
    if (!nok) {
#pragma unroll
        for (int i = 0; i < 16; ++i) v[i] = v[i] * 0.f; }
}
template <int MAP> __device__ __forceinline__ void p0_item_store(int K, int N, bf16* WT, LAS float* scr, int item, int nblk, int lane, const f32x4 (&v)[16]) {
    const int kb = item / nblk, nb = item % nblk, k0 = 64 * kb, n0 = 64 * nb;
    const int n4 = (lane & 15) * 4, kr = lane >> 4;
#pragma unroll
    for (int i = 0; i < 16; ++i) { LAS float* s = scr + (4 * i + kr) * 65 + n4; s[0] = v[i].x; s[1] = v[i].y; s[2] = v[i].z; s[3] = v[i].w; }
    LDS_WAIT(); asm volatile("" ::: "memory");
    const int c = lane & 7;
#pragma unroll
    for (int j = 0; j < 8; ++j) { const int nl = (lane >> 3) + 8 * j; const LAS float* s = scr + (8 * c) * 65 + nl;
        v4u o; o.x = pk2(s[0 * 65], s[1 * 65]); o.y = pk2(s[2 * 65], s[3 * 65]); o.z = pk2(s[4 * 65], s[5 * 65]); o.w = pk2(s[6 * 65], s[7 * 65]);
        if (n0 + nl < N) *(GAS v4u*)(WT + (size_t)dest_row<MAP>(n0 + nl) * K + k0 + 8 * c) = o; }
    LDS_WAIT(); asm volatile("" ::: "memory");
}
template <int MAP> __device__ __forceinline__ void p0_transpose(Frame& F, const float* W, int K, int N, bf16* WT, int& rot, int wg0 = 0) {
    const int nblk = (N + 63) / 64, nitems = (K / 64) * nblk;
    if (F.vcu < wg0) { rot = (rot + nitems) % 65536; return; }
    LAS float* scr = (LAS float*)(F.lds + RING_OFF + F.wave * 16896);
    const int NGW = (GRID - wg0) * NWAVES; const int gw = ((F.vcu - wg0) * NWAVES + F.wave + NGW - rot % NGW) % NGW;
    f32x4 v[16], vn[16];
    if (gw < nitems) p0_item_load<MAP>(W, N, gw, nblk, F.lane, v);
    for (int it = gw; it < nitems; it += NGW) {
        const bool more = it + NGW < nitems;
        if (more) p0_item_load<MAP>(W, N, it + NGW, nblk, F.lane, vn);
        p0_item_store<MAP>(K, N, WT, scr, it, nblk, F.lane, v);
        if (more) {
#pragma unroll
            for (int i = 0; i < 16; ++i) v[i] = vn[i]; }
    }
    rot = (rot + nitems) % 65536;
}
__device__ __forceinline__ void p0a_prologue(Frame& F) {
    frame_refresh(F);
    int rot = 0;
    for (int l = 0; l < DEPTH; ++l) p0_transpose<0>(F, in_ptr(7) + (size_t)l * DM * NMOD, DM, NMOD, (bf16*)(F.ws + WS_P) + (size_t)l * NMOD * DM, rot);
    const int gt = F.vcu * (NWAVES * 64) + F.tid, NT = GRID * NWAVES * 64;
    { float* gn = (float*)(F.ws + WS_GN);
      for (int i = gt; i < 6 * DM; i += NT) { const int l = i / (3 * DM), j = (i / DM) % 3, c = i & (DM - 1); const float* s9 = in_ptr(9); const float* s10 = in_ptr(10); const float* s11 = in_ptr(11);
          const float v0 = s9[l * DM + c], v1 = s10[l * DM + c], v2 = s11[l * DM + c]; gn[i] = j == 0 ? v0 : (j == 1 ? v1 : v2); } }
    { bf16* ca = (bf16*)(F.ws + WS_CA);
      for (int i = gt; i < 256 * DM; i += NT) { const int r = i >> 10, c = i & 1023; float v = 0.f;
          if (r < NB_P) v = in_ptr(2)[r * DM + c]; else if (r < NSEQ) v = in_ptr(3)[(r - NB_P) * DM + c];
          ca[i] = (bf16)f2bf(r < NSEQ ? v / (1.f + __expf(-v)) : 0.f); } }
}
#ifndef FILLW_ON
#define FILLW_ON 1
#endif
constexpr bool FILLW = FILLW_ON;
#ifndef P0B_LAST_ALL
#define P0B_LAST_ALL 0
#endif
#ifndef P0B_WIN_ALL
#define P0B_WIN_ALL 0
#endif
__device__ __forceinline__ void p0_fill(Frame& F, int k) {
    frame_refresh(F);
    constexpr int l = 1; int rot = 0;
    if (k == 0) { p0_transpose<1>(F, in_ptr(12) + (size_t)l * DM * 2 * DFF, DM, 2 * DFF, wt_ptr(F, l, WO_GU1), rot); }
    if (k == 1) { p0_transpose<0>(F, in_ptr(13) + (size_t)l * DFF * DM, DFF, DM, wt_ptr(F, l, WO_D1), rot);
                  p0_transpose<0>(F, in_ptr(23) + (size_t)l * DM * DM, DM, DM, wt_ptr(F, l, WO_SSD), rot);
                  p0_transpose<0>(F, in_ptr(25) + (size_t)l * DM * DM, DM, DM, wt_ptr(F, l, WO_SC), rot);
                  p0_transpose<0>(F, in_ptr(26) + (size_t)l * DM * DM, DM, DM, wt_ptr(F, l, WO_O), rot); }
    if (k == 2) { p0_transpose<2>(F, in_ptr(16) + (size_t)l * DM * DPROJ, DM, DPROJ, wt_ptr(F, l, WO_IN), rot); }
    if (k == 3) { p0_transpose<1>(F, in_ptr(14) + (size_t)l * DM * 2 * DFF, DM, 2 * DFF, wt_ptr(F, l, WO_GU2), rot);
                  p0_transpose<0>(F, in_ptr(15) + (size_t)l * DFF * DM, DFF, DM, wt_ptr(F, l, WO_D2), rot); }
}
__device__ __forceinline__ void p0b_prologue(Frame& F, int wg0) {
    frame_refresh(F);
    int rot = 0;
    for (int l = 0; l < (FILLW ? 1 : DEPTH); ++l) {
        const int w0 = l == 0 ? wg0 : 0;
        p0_transpose<1>(F, in_ptr(12) + (size_t)l * DM * 2 * DFF, DM, 2 * DFF, wt_ptr(F, l, WO_GU1), rot, w0);
        p0_transpose<0>(F, in_ptr(13) + (size_t)l * DFF * DM, DFF, DM, wt_ptr(F, l, WO_D1), rot, w0);
        p0_transpose<0>(F, in_ptr(23) + (size_t)l * DM * DM, DM, DM, wt_ptr(F, l, WO_SSD), rot, w0);
        p0_transpose<0>(F, in_ptr(25) + (size_t)l * DM * DM, DM, DM, wt_ptr(F, l, WO_SC), rot, w0);
        p0_transpose<0>(F, in_ptr(26) + (size_t)l * DM * DM, DM, DM, wt_ptr(F, l, WO_O), rot, w0);
        p0_transpose<2>(F, in_ptr(16) + (size_t)l * DM * DPROJ, DM, DPROJ, wt_ptr(F, l, WO_IN), rot, P0B_WIN_ALL ? 0 : w0);
        p0_transpose<1>(F, in_ptr(14) + (size_t)l * DM * 2 * DFF, DM, 2 * DFF, wt_ptr(F, l, WO_GU2), rot, P0B_LAST_ALL ? 0 : w0);
        p0_transpose<0>(F, in_ptr(15) + (size_t)l * DFF * DM, DFF, DM, wt_ptr(F, l, WO_D2), rot, P0B_LAST_ALL ? 0 : w0);
    }
}

__device__ __forceinline__ void norm0_phase(Frame& F) {
    frame_refresh(F);
    const int gw = F.vcu * NWAVES + F.wave, NGW = GRID * NWAVES;
    const float* Xp = in_ptr(0); const float* Xs = in_ptr(1); bf16* H = (bf16*)(F.ws + WS_H); const float* GS = gs_ptr(F, 0); const float* SH = mod_ptr(F, 0, 0);
    f32x4 v[4], gv[4], sv[4], vn[4], gn[4], sn[4];
    if (gw < M) { const int mr = mod_row(gw); const f32x4* xr = (const f32x4*)(gw < MP ? Xp + (size_t)gw * DM : Xs + (size_t)(gw - MP) * DM) + F.lane;
        const f32x4* gr = (const f32x4*)(GS + (size_t)mr * DM) + F.lane; const f32x4* sr = (const f32x4*)(SH + (size_t)mr * NMOD) + F.lane;
#pragma unroll
        for (int j = 0; j < 4; ++j) { v[j] = xr[64 * j]; gv[j] = gr[64 * j]; sv[j] = sr[64 * j]; } }
    for (int m = gw; m < M; m += NGW) {
        const int mn = m + NGW;
        if (mn < M) { const int mr = mod_row(mn); const f32x4* xr = (const f32x4*)(mn < MP ? Xp + (size_t)mn * DM : Xs + (size_t)(mn - MP) * DM) + F.lane;
            const f32x4* gr = (const f32x4*)(GS + (size_t)mr * DM) + F.lane; const f32x4* sr = (const f32x4*)(SH + (size_t)mr * NMOD) + F.lane;
#pragma unroll
            for (int j = 0; j < 4; ++j) { vn[j] = xr[64 * j]; gn[j] = gr[64 * j]; sn[j] = sr[64 * j]; } }
        float s = 0.f;
#pragma unroll
        for (int j = 0; j < 4; ++j) s += (v[j].x * v[j].x + v[j].y * v[j].y) + (v[j].z * v[j].z + v[j].w * v[j].w);
        const float r = 1.f / sqrtf(wave_sum(s) * (1.f / DM) + EPS);
        unsigned long long* o8 = (unsigned long long*)(H + (size_t)m * DM) + F.lane;
#pragma unroll
        for (int j = 0; j < 4; ++j) { const f32x4 h = (v[j] * r) * gv[j] + sv[j]; o8[64 * j] = (unsigned long long)pk2(h.x, h.y) | ((unsigned long long)pk2(h.z, h.w) << 32); }
#pragma unroll
        for (int j = 0; j < 4; ++j) { v[j] = vn[j]; gv[j] = gn[j]; sv[j] = sn[j]; }
    }
}
__device__ __forceinline__ void final_norm_phase(Frame& F) {
    frame_refresh(F);
    const int gw = F.vcu * NWAVES + F.wave, NGW = GRID * NWAVES;
    f32x4 gv[4];
#pragma unroll
    for (int j = 0; j < 4; ++j) gv[j] = ((const f32x4*)in_ptr(27))[F.lane + 64 * j];
    f32x4 v[4], vn[4];
    if (gw < M) { const f32x4* xr = (const f32x4*)(F.out + (size_t)gw * DM) + F.lane;
#pragma unroll
        for (int j = 0; j < 4; ++j) v[j] = xr[64 * j]; }
    for (int m = gw; m < M; m += NGW) {
        const int mn = m + NGW;
        if (mn < M) { const f32x4* xr = (const f32x4*)(F.out + (size_t)mn * DM) + F.lane;
#pragma unroll
            for (int j = 0; j < 4; ++j) vn[j] = xr[64 * j]; }
        f32x4* xo = (f32x4*)(F.out + (size_t)m * DM) + F.lane;
        float s = 0.f;
#pragma unroll
        for (int j = 0; j < 4; ++j) s += (v[j].x * v[j].x + v[j].y * v[j].y) + (v[j].z * v[j].z + v[j].w * v[j].w);
        const float r = 1.f / sqrtf(wave_sum(s) * (1.f / DM) + EPS);
#pragma unroll
        for (int j = 0; j < 4; ++j) xo[64 * j] = (v[j] * r) * gv[j];
#pragma unroll
        for (int j = 0; j < 4; ++j) v[j] = vn[j];
    }
}

__device__ __forceinline__ void dt_phase(Frame& F, int layer) {
    frame_refresh(F);
    if (F.bx < (GRID >> 1)) return;
    const int gw = (F.bx - (GRID >> 1)) * NWAVES + F.wave, NGW = (GRID >> 1) * NWAVES;
    const bf16* H = (const bf16*)(F.ws + WS_H); const bf16* Wd = wt_ptr(F, layer, WO_IN) + (size_t)8192 * DM;
    float* DT = (float*)(F.ws + WS_DT);
    const int fr = F.lane & 15, fq = F.lane >> 4;
    const float bias = in_ptr(19)[layer * 16 + fr];
    for (int it = gw; it < M / 16; it += NGW) {
        const bf16* ap = H + (size_t)(it * 16 + fr) * DM + 8 * fq; const bf16* bp = Wd + (size_t)fr * DM + 8 * fq;
        f32x4 acc = {0.f, 0.f, 0.f, 0.f};
#pragma unroll 8
        for (int kk = 0; kk < DM / 32; ++kk) { const bf16x8 a = *(const bf16x8*)(ap + kk * 32), b = *(const bf16x8*)(bp + kk * 32);
            acc = __builtin_amdgcn_mfma_f32_16x16x32_bf16(a, b, acc, 0, 0, 0); }
#pragma unroll
        for (int r = 0; r < 4; ++r) { const int row = it * 16 + 4 * fq + r;
            const float x = acc[r] + bias; const float e = __expf(-fabsf(x)); const float l1p = e < 1e-3f ? e * (1.f - 0.5f * e) : __logf(1.f + e);
            const float sp = fmaxf(x, 0.f) + l1p; DT[(size_t)row * 16 + fr] = sp; }
    }
}

struct SCRows { v4u p0, bb, p1, p2; };
__device__ __forceinline__ void sc_load(const bf16* SB, const bf16* SP, int idx, SCRows& R) {
    const int m = idx >> 7, j0 = (idx & 127) * 8;
    const int t = m < MP ? (m & (SEQ_P - 1)) : ((m - MP) & (SEQ_S - 1));
    const size_t ro = (size_t)m * DM + j0, r1 = ro - (t >= 1 ? DM : 0), r2 = ro - (t >= 2 ? 2 * DM : 0);
    R.p0 = *(const v4u*)(SP + ro); R.bb = *(const v4u*)(SB + ro); R.p1 = *(const v4u*)(SP + r1); R.p2 = *(const v4u*)(SP + r2);
}
__device__ __forceinline__ void sc_unpk(const v4u& c, float (&p)[8]) {
    p[0] = bf_lo(c.x); p[1] = bf_hi(c.x); p[2] = bf_lo(c.y); p[3] = bf_hi(c.y); p[4] = bf_lo(c.z); p[5] = bf_hi(c.z); p[6] = bf_lo(c.w); p[7] = bf_hi(c.w);
}
__device__ __forceinline__ void shortconv_phase(Frame& F, int layer) {
    frame_refresh(F);
    const int gt = F.vcu * (NWAVES * 64) + F.tid, NT = GRID * NWAVES * 64;
    bf16* SB = proj_ptr(F, PT_SCB); const bf16* SP = proj_ptr(F, PT_SCC);
    const float* cw = in_ptr(24) + (size_t)layer * 3 * DM;
    const float* st = in_ptr(6) + (size_t)layer * NB_S * 2 * DM;
    float* o_p = F.out + (size_t)M * DM + (size_t)DEPTH * NB_P * 16 * 64 * 128 + (size_t)DEPTH * NB_P * 3 * DXBC + (size_t)layer * NB_P * 2 * DM;
    float* o_s = F.out + (size_t)M * DM + (size_t)DEPTH * NB_P * 16 * 64 * 128 + (size_t)DEPTH * NB_P * 3 * DXBC + (size_t)DEPTH * NB_P * 2 * DM
                 + (size_t)DEPTH * NB_S * 16 * 64 * 128 + (size_t)DEPTH * NB_S * 3 * DXBC + (size_t)layer * NB_S * 2 * DM;
    constexpr int NIT = M * (DM / 8);
    SCRows R, Rn;
    if (gt < NIT) sc_load(SB, SP, gt, R);
    for (int idx = gt; idx < NIT; idx += NT) {
        if (idx + NT < NIT) sc_load(SB, SP, idx + NT, Rn);
        const int m = idx >> 7, j0 = (idx & 127) * 8;
        const bool prm = m < MP; const int t = prm ? (m & (SEQ_P - 1)) : ((m - MP) & (SEQ_S - 1)); const int sq = prm ? (m >> 11) : ((m - MP) >> 3); const int L = prm ? SEQ_P : SEQ_S;
        const size_t ro = (size_t)m * DM + j0;
        float cur[8], p1[8], p2[8], bv[8];
        sc_unpk(R.p0, cur); sc_unpk(R.p1, p1); sc_unpk(R.p2, p2); sc_unpk(R.bb, bv);
        if (t < 2) {
#pragma unroll
            for (int i = 0; i < 8; ++i) { if (t < 1) p1[i] = prm ? 0.f : st[((size_t)sq * 2 + 1) * DM + j0 + i]; p2[i] = prm ? 0.f : st[((size_t)sq * 2 + t) * DM + j0 + i]; } }
        float o[8];
#pragma unroll
        for (int i = 0; i < 8; ++i) o[i] = bv[i] * (cw[j0 + i] * p2[i] + cw[DM + j0 + i] * p1[i] + cw[2 * DM + j0 + i] * cur[i]);
        v4u w; w.x = pk2(o[0], o[1]); w.y = pk2(o[2], o[3]); w.z = pk2(o[4], o[5]); w.w = pk2(o[6], o[7]);
        *(v4u*)(SB + ro) = w;
        if (t >= L - 2) { float* op = (prm ? o_p : o_s) + ((size_t)sq * 2 + (t - (L - 2))) * DM + j0;
            *(f32x4*)op = (f32x4){cur[0], cur[1], cur[2], cur[3]}; *(f32x4*)(op + 4) = (f32x4){cur[4], cur[5], cur[6], cur[7]}; }
        R = Rn;
    }
}

__device__ __forceinline__ void ssd_unit(Frame& F, int layer, int seq, int g) {
    frame_refresh(F);
    const int tid = F.tid, lane = F.lane, wave = F.wave;
    constexpr bool prm = false; const int L = SEQ_S; const int sq = seq - NB_P;
    const size_t mbase = prm ? (size_t)seq * SEQ_P : (size_t)MP + (size_t)sq * SEQ_S;
    LAS float* cv = (LAS float*)(F.lds); LAS float* ybuf = (LAS float*)(F.lds + 16384); LAS float* dts = (LAS float*)(F.lds + 24576); LAS float* dAs = (LAS float*)(F.lds + 24704);
    const bf16* src; int col, chan;
    if (tid < 256) { src = proj_ptr(F, PT_XS); col = g * 256 + tid; chan = col; }
    else if (tid < 384) { src = proj_ptr(F, PT_BC); col = g * 128 + (tid - 256); chan = 1024 + col; }
    else { src = proj_ptr(F, PT_BC); col = 512 + g * 128 + (tid - 384); chan = 1024 + col; }
    const float* cwp = in_ptr(17) + (size_t)layer * 4 * DXBC + chan;
    const float cw0 = cwp[0], cw1 = cwp[DXBC], cw2 = cwp[2 * DXBC], cw3 = cwp[3 * DXBC], cb = in_ptr(18)[(size_t)layer * DXBC + chan];
    float w0, w1, w2;
    { const float* cs = in_ptr(5) + ((size_t)layer * NB_S + sq) * 3 * DXBC + chan; w0 = cs[0]; w1 = cs[DXBC]; w2 = cs[2 * DXBC]; }
    const int hh = tid >> 7, i7 = tid & 127, nseg = i7 & 7, pg = i7 >> 3, head = g * 4 + hh;
    float s[4][16];
    float* nst = F.out + (size_t)M * DM + (prm ? (size_t)0 : (size_t)DEPTH * NB_P * 16 * 8192 + (size_t)DEPTH * NB_P * 3 * DXBC + (size_t)DEPTH * NB_P * 2 * DM)
                 + (((size_t)layer * (prm ? NB_P : NB_S) + sq) * 16 + head) * 8192;
    if (prm) {
#pragma unroll
        for (int r = 0; r < 4; ++r)
#pragma unroll
            for (int i = 0; i < 16; ++i) s[r][i] = 0.f;
    } else { const float* sp = in_ptr(4) + (((size_t)layer * NB_S + sq) * 16 + head) * 8192;
#pragma unroll
        for (int r = 0; r < 4; ++r)
#pragma unroll
            for (int q = 0; q < 4; ++q) { const f32x4 v = *(const f32x4*)(sp + (size_t)(pg + 16 * r) * 128 + 16 * nseg + 4 * q); s[r][4 * q] = v.x; s[r][4 * q + 1] = v.y; s[r][4 * q + 2] = v.z; s[r][4 * q + 3] = v.w; } }
    const float* DT = (const float*)(F.ws + WS_DT);
    bf16* Z = proj_ptr(F, PT_Z);
    const int ech = lane * 4;
    const float Dh = in_ptr(21)[layer * 16 + g * 4 + (ech >> 6)];
    const f32x4 nw = *(const f32x4*)(in_ptr(22) + (size_t)layer * DM + g * 256 + ech);
    float a_neg = 0.f;
    if (tid < 32) a_neg = -__expf(in_ptr(20)[layer * 16 + g * 4 + (tid & 3)]);
    float pre[8];
#pragma unroll
    for (int j = 0; j < 8; ++j) pre[j] = bf2f(src[(mbase + j) * DM + col]);
    for (int t0 = 0; t0 < L; t0 += 8) {
        const unsigned long long zw = *(const unsigned long long*)(Z + (mbase + t0 + wave) * DM + g * 256 + ech);
        float dtv_l = 0.f; if (tid < 32) dtv_l = DT[(mbase + t0 + (tid >> 2)) * 16 + g * 4 + (tid & 3)];
#pragma unroll
        for (int j = 0; j < 8; ++j) { const float v = cw0 * w0 + cw1 * w1 + cw2 * w2 + cw3 * pre[j] + cb; w0 = w1; w1 = w2; w2 = pre[j]; cv[j * 512 + tid] = fast_silu(v); }
        if (t0 + 8 < L) {
#pragma unroll
            for (int j = 0; j < 8; ++j) pre[j] = bf2f(src[(mbase + t0 + 8 + j) * DM + col]); }
        if (tid < 32) { dts[tid] = dtv_l; dAs[tid] = __expf(dtv_l * a_neg); }
        __syncthreads();
#pragma unroll 1
        for (int j = 0; j < 8; ++j) {
            const float dtv = dts[j * 4 + hh], dA = dAs[j * 4 + hh];
            float Bv[16], Cv[16];
#pragma unroll
            for (int q = 0; q < 4; ++q) { const f32x4 b4 = *(const LAS f32x4*)(cv + j * 512 + 256 + 16 * nseg + 4 * q), c4 = *(const LAS f32x4*)(cv + j * 512 + 384 + 16 * nseg + 4 * q);
                Bv[4 * q] = b4.x; Bv[4 * q + 1] = b4.y; Bv[4 * q + 2] = b4.z; Bv[4 * q + 3] = b4.w; Cv[4 * q] = c4.x; Cv[4 * q + 1] = c4.y; Cv[4 * q + 2] = c4.z; Cv[4 * q + 3] = c4.w; }
#pragma unroll
            for (int r = 0; r < 4; ++r) { const float xv = cv[j * 512 + hh * 64 + pg + 16 * r]; const float coef = dtv * xv; float acc = 0.f;
#pragma unroll
                for (int i = 0; i < 16; ++i) { s[r][i] = dA * s[r][i] + coef * Bv[i]; acc += Cv[i] * s[r][i]; }
                acc += __shfl_xor(acc, 1); acc += __shfl_xor(acc, 2); acc += __shfl_xor(acc, 4);
                if (nseg == 0) ybuf[j * 256 + hh * 64 + pg + 16 * r] = acc; }
        }
        __syncthreads();
        {
            const f32x4 y4 = *(const LAS f32x4*)(ybuf + wave * 256 + ech), x4 = *(const LAS f32x4*)(cv + wave * 512 + ech);
            const unsigned zl = (unsigned)zw, zh = (unsigned)(zw >> 32);
            f32x4 y;
            y.x = (y4.x + x4.x * Dh) * fast_silu(bf_lo(zl)); y.y = (y4.y + x4.y * Dh) * fast_silu(bf_hi(zl));
            y.z = (y4.z + x4.z * Dh) * fast_silu(bf_lo(zh)); y.w = (y4.w + x4.w * Dh) * fast_silu(bf_hi(zh));
            const float ss = wave_sum((y.x * y.x + y.y * y.y) + (y.z * y.z + y.w * y.w));
            const float r = 1.f / sqrtf(ss * (1.f / 256.f) + EPS);
            const f32x4 o = (y * r) * nw;
            *(unsigned long long*)DRYP(Z + (mbase + t0 + wave) * DM + g * 256 + ech) = (unsigned long long)pk2(o.x, o.y) | ((unsigned long long)pk2(o.z, o.w) << 32);
        }
        __syncthreads();
    }
#pragma unroll
    for (int r = 0; r < 4; ++r)
#pragma unroll
        for (int q = 0; q < 4; ++q) *(f32x4*)(nst + (size_t)(pg + 16 * r) * 128 + 16 * nseg + 4 * q) = (f32x4){s[r][4 * q], s[r][4 * q + 1], s[r][4 * q + 2], s[r][4 * q + 3]};
    { float* oc = F.out + (size_t)M * DM + (size_t)DEPTH * NB_P * 16 * 8192
                  + (prm ? (size_t)0 : (size_t)DEPTH * NB_P * 3 * DXBC + (size_t)DEPTH * NB_P * 2 * DM + (size_t)DEPTH * NB_S * 16 * 8192)
                  + ((size_t)layer * (prm ? NB_P : NB_S) + sq) * 3 * DXBC + chan;
      oc[0] = w0; oc[DXBC] = w1; oc[2 * DXBC] = w2; }
}

constexpr int XT_OFF = 0, SPITCH = 272, BM_OFF = 256 * SPITCH, CM_OFF = BM_OFF + 128 * SPITCH, ACUM_OFF = CM_OFF + 128 * SPITCH,
              DTV_OFF = ACUM_OFF + 2048, SCL_OFF = DTV_OFF + 2048, RED_OFF = SCL_OFF + 2048, SSD_LDS_END = RED_OFF + 2048;
static_assert(SSD_LDS_END <= LDSCTL_OFF, "ssd LDS image");
typedef float f32x16 __attribute__((ext_vector_type(16)));
typedef short s16x4 __attribute__((ext_vector_type(4)));
typedef float f32x2_t __attribute__((ext_vector_type(2))); typedef __bf16 bf16x2_t __attribute__((ext_vector_type(2)));
__device__ __forceinline__ unsigned cvtpk(float lo, float hi) { f32x2_t v = {lo, hi}; bf16x2_t b = __builtin_convertvector(v, bf16x2_t); return __builtin_bit_cast(unsigned, b); }
__device__ __forceinline__ bf16x8 pack8(float a0, float a1, float a2, float a3, float a4, float a5, float a6, float a7) {
    v4u w; w.x = cvtpk(a0, a1); w.y = cvtpk(a2, a3); w.z = cvtpk(a4, a5); w.w = cvtpk(a6, a7); return __builtin_bit_cast(bf16x8, w); }
__device__ __forceinline__ int crow(int reg, int h) { return (reg & 3) + 8 * (reg >> 2) + 4 * h; }
#define MFMA32(a, b, c) __builtin_amdgcn_mfma_f32_32x32x16_bf16((a), (b), (c), 0, 0, 0)

template <bool S1> __device__ __forceinline__ void ssd_stage(Frame& F, int layer, int b, int c, int g) {
    const int tid = F.tid, lane = F.lane, wave = F.wave;
    const size_t m0 = (size_t)b * SEQ_P + (size_t)c * 128;
    LAS float* acum = (LAS float*)(F.lds + ACUM_OFF); LAS float* dtv = (LAS float*)(F.lds + DTV_OFF); LAS float* scl = (LAS float*)(F.lds + SCL_OFF);
    const float* DT = (const float*)(F.ws + WS_DT);
    float d0 = 0.f, d1 = 0.f, a_dt = 0.f;
    if (wave < 4) { a_dt = -__expf(in_ptr(20)[layer * 16 + g * 4 + wave]); d0 = DT[(m0 + 2 * lane) * 16 + g * 4 + wave]; d1 = DT[(m0 + 2 * lane + 1) * 16 + g * 4 + wave]; }
    {
        const bool xrole = wave < 4;
        int cgl, seg; bool active = true;
        if (xrole) { cgl = lane & 31; seg = 2 * wave + (lane >> 5); }
        else if (S1) { cgl = lane & 15; seg = 4 * (wave - 4) + (lane >> 4); active = wave < 6; }
        else { cgl = lane & 31; seg = 2 * (wave - 4) + (lane >> 5); }
        const int bccol = (cgl < 16 ? g * 128 + 8 * cgl : 512 + g * 128 + 8 * (cgl - 16));
        const unsigned char* sbase = (const unsigned char*)proj_ptr(F, xrole ? PT_XS : PT_BC);
        const int chan = xrole ? g * 256 + 8 * cgl : 1024 + bccol;
        const unsigned soff = (unsigned)(((int)m0 + 16 * seg - 3) * DM + (xrole ? g * 256 + 8 * cgl : bccol)) * 2u;
        const bool seq_start = (c == 0 && seg == 0); const unsigned halo_msk = seq_start ? 0u : 0xffffffffu; const int halo_skip = seq_start ? 3 : 0;
        v4u P[19]; float cwf[4][8], cbf[8];
        if (active) {
#pragma unroll
            for (int i = 0; i < 19; ++i) P[i] = *(const v4u*)(sbase + (soff + (unsigned)(i < 3 ? i + halo_skip : i) * 2048u));
#pragma unroll
            for (int i = 0; i < 3; ++i) { P[i].x &= halo_msk; P[i].y &= halo_msk; P[i].z &= halo_msk; P[i].w &= halo_msk; }
            { const float* cwp = in_ptr(17) + (size_t)layer * 4 * DXBC + chan;
#pragma unroll
              for (int k = 0; k < 4; ++k) { const f32x4 a = *(const f32x4*)(cwp + (size_t)k * DXBC), bq = *(const f32x4*)(cwp + (size_t)k * DXBC + 4);
                  cwf[k][0] = a.x; cwf[k][1] = a.y; cwf[k][2] = a.z; cwf[k][3] = a.w; cwf[k][4] = bq.x; cwf[k][5] = bq.y; cwf[k][6] = bq.z; cwf[k][7] = bq.w; }
              const float* cbp = in_ptr(18) + (size_t)layer * DXBC + chan; const f32x4 a = *(const f32x4*)cbp, bq = *(const f32x4*)(cbp + 4);
              cbf[0] = a.x; cbf[1] = a.y; cbf[2] = a.z; cbf[3] = a.w; cbf[4] = bq.x; cbf[5] = bq.y; cbf[6] = bq.z; cbf[7] = bq.w; }
        }
        if (wave < 4) {
            const int hh = wave; const float a = a_dt;
            const float v0 = d0 * a, v1 = d1 * a; const float s = v0 + v1; float sc = s;
#pragma unroll
            for (int o = 1; o < 64; o <<= 1) { const float u = __shfl_up(sc, o); if (lane >= o) sc += u; }
            const float ex = sc - s, a0 = ex + v0, a1 = ex + s, tot = __shfl(sc, 63);
            dtv[hh * 128 + 2 * lane] = d0; dtv[hh * 128 + 2 * lane + 1] = d1;
            acum[hh * 128 + 2 * lane] = a0; acum[hh * 128 + 2 * lane + 1] = a1;
            if (S1) { scl[hh * 128 + 2 * lane] = d0 * __expf(tot - a0); scl[hh * 128 + 2 * lane + 1] = d1 * __expf(tot - a1);
                if (lane == 0) ((float*)(F.ws + WS_CD))[(b * 16 + c) * 16 + g * 4 + hh] = __expf(tot); } }
        if (S1) __syncthreads();
        if (active) {
#define XV(i, e) ((((e) & 1) ? bf_hi(P[(i)][(e) >> 1]) : bf_lo(P[(i)][(e) >> 1])))
#define CONV(tt, e) fast_silu(cwf[0][e] * XV(tt, e) + cwf[1][e] * XV((tt) + 1, e) + cwf[2][e] * XV((tt) + 2, e) + cwf[3][e] * XV((tt) + 3, e) + cbf[e])
            if (xrole || S1) {
                LAS unsigned char* dst = F.lds + (xrole ? XT_OFF : BM_OFF) + (8 * cgl) * SPITCH + 32 * seg;
                float sc[16];
                if (S1 && xrole) { const LAS float* sp4 = scl + (cgl >> 3) * 128 + 16 * seg;
#pragma unroll
                    for (int q = 0; q < 4; ++q) { const f32x4 t4 = *(const LAS f32x4*)(sp4 + 4 * q); sc[4 * q] = t4.x; sc[4 * q + 1] = t4.y; sc[4 * q + 2] = t4.z; sc[4 * q + 3] = t4.w; } }
#pragma unroll
                for (int e = 0; e < 8; ++e) { float o[16];
#pragma unroll
                    for (int tt = 0; tt < 16; ++tt) { o[tt] = CONV(tt, e); if (S1 && xrole) o[tt] *= sc[tt]; }
                    *(LAS bf16x8*)(dst + e * SPITCH) = pack8(o[0], o[1], o[2], o[3], o[4], o[5], o[6], o[7]);
                    *(LAS bf16x8*)(dst + e * SPITCH + 16) = pack8(o[8], o[9], o[10], o[11], o[12], o[13], o[14], o[15]); }
            } else {
                LAS unsigned char* dst = F.lds + (cgl < 16 ? BM_OFF + 16 * cgl : CM_OFF + 16 * (cgl - 16)) + (16 * seg) * SPITCH;
#pragma unroll
                for (int tt = 0; tt < 16; ++tt) { float o[8];
#pragma unroll
                    for (int e = 0; e < 8; ++e) o[e] = CONV(tt, e);
                    *(LAS bf16x8*)(dst + tt * SPITCH) = pack8(o[0], o[1], o[2], o[3], o[4], o[5], o[6], o[7]); }
            }
            if (!S1 && c == 15 && seg == 7) {
                float* oc = F.out + (size_t)M * DM + (size_t)DEPTH * NB_P * 16 * 8192 + ((size_t)layer * NB_P + b) * 3 * DXBC + chan;
#pragma unroll
                for (int k = 0; k < 3; ++k) { const v4u w = P[16 + k];
                    *(f32x4*)(oc + (size_t)k * DXBC) = (f32x4){bf_lo(w.x), bf_hi(w.x), bf_lo(w.y), bf_hi(w.y)}; *(f32x4*)(oc + (size_t)k * DXBC + 4) = (f32x4){bf_lo(w.z), bf_hi(w.z), bf_lo(w.w), bf_hi(w.w)}; }
            }
#undef XV
#undef CONV
        }
    }
    __syncthreads();
}

__device__ __forceinline__ void ssd_s1_unit(Frame& F, int layer, int b, int c, int g) {
    frame_refresh(F);
    ssd_stage<true>(F, layer, b, c, g);
    const int lane = F.lane, wave = F.wave, hh = wave >> 1, ph = wave & 1, r = lane & 31, h = lane >> 5;
    f32x16 acc[4];
#pragma unroll
    for (int nt = 0; nt < 4; ++nt)
#pragma unroll
        for (int i = 0; i < 16; ++i) acc[nt][i] = 0.f;
    const LAS unsigned char* ap = F.lds + XT_OFF + (hh * 64 + ph * 32 + r) * SPITCH + h * 16;
    const LAS unsigned char* bp = F.lds + BM_OFF + r * SPITCH + h * 16;
#pragma unroll
    for (int ks = 0; ks < 8; ++ks) { const bf16x8 a = *(const LAS bf16x8*)(ap + ks * 32);
#pragma unroll
        for (int nt = 0; nt < 4; ++nt) { const bf16x8 bb = *(const LAS bf16x8*)(bp + nt * 32 * SPITCH + ks * 32); acc[nt] = MFMA32(a, bb, acc[nt]); } }
    __syncthreads();
    {   LAS float* simg = (LAS float*)(F.lds) + wave * (32 * 132);
#pragma unroll
        for (int nt = 0; nt < 4; ++nt)
#pragma unroll
            for (int i = 0; i < 16; ++i) simg[crow(i, h) * 132 + nt * 32 + r] = acc[nt][i];
        v4u* st = (v4u*)((bf16*)(F.ws + WS_S) + ((size_t)(b * 16 + c) * 16 + g * 4 + hh) * 8192 + (size_t)(ph * 32) * 128);
#pragma unroll
        for (int i = 0; i < 8; ++i) { const int idx = i * 64 + lane; const LAS float* sp = simg + (idx >> 4) * 132 + (idx & 15) * 8; const f32x4 v0 = *(const LAS f32x4*)sp, v1 = *(const LAS f32x4*)(sp + 4);
            v4u w; w.x = cvtpk(v0.x, v0.y); w.y = cvtpk(v0.z, v0.w); w.z = cvtpk(v1.x, v1.y); w.w = cvtpk(v1.z, v1.w); st[idx] = w; } }
    __syncthreads();
}

__device__ __forceinline__ void ssd_s2_phase(Frame& F, int layer) {
    frame_refresh(F);
    const int it = F.vcu * (NWAVES * 64) + F.tid;
    const v4u* ST = (const v4u*)(F.ws + WS_S); const float* CD = (const float*)(F.ws + WS_CD); v4u* SB16 = (v4u*)(F.ws + WS_H);
    f32x4* o = (f32x4*)(F.out + (size_t)M * DM + (size_t)layer * NB_P * 16 * 8192);
    static_assert(NB_P * 16 * 1024 == GRID * NWAVES * 64, "one item per thread");
    const int q = it & 1023, head = (it >> 10) & 15, b = it >> 14;
    v4u v[16];
#pragma unroll
    for (int c = 0; c < 16; ++c) v[c] = ST[((size_t)(b * 16 + c) * 16 + head) * 1024 + q];
    float z0 = 0.f; asm volatile("" : "+v"(z0));
    f32x4 c0 = {z0, z0, z0, z0}, c1 = {z0, z0, z0, z0};
#pragma unroll
    for (int c = 0; c < 16; ++c) { const float d = CD[(b * 16 + c) * 16 + head];
        v4u w; w.x = pk2(c0.x, c0.y); w.y = pk2(c0.z, c0.w); w.z = pk2(c1.x, c1.y); w.w = pk2(c1.z, c1.w);
        SB16[((size_t)(b * 16 + c) * 16 + head) * 1024 + q] = w;
        c0 = c0 * d + (f32x4){bf_lo(v[c].x), bf_hi(v[c].x), bf_lo(v[c].y), bf_hi(v[c].y)}; c1 = c1 * d + (f32x4){bf_lo(v[c].z), bf_hi(v[c].z), bf_lo(v[c].w), bf_hi(v[c].w)}; }
    o[((size_t)b * 16 + head) * 2048 + 2 * q] = c0; o[((size_t)b * 16 + head) * 2048 + 2 * q + 1] = c1;
}

__device__ __forceinline__ void ssd_s3_unit(Frame& F, int layer, int b, int c, int g, bool first, const XcdBarrier& bar, unsigned* bar2, unsigned gen) {
    frame_refresh(F);
#ifdef DUP_STG
    ssd_stage<false>(F, layer, b, c, g);
#endif
    ssd_stage<false>(F, layer, b, c, g);
    if (first) xcd_wait(bar, bar2, gen);
    bf16x8 sfr[8][2];
    {   const int hh_ = F.wave >> 1, r_ = F.lane & 31, h_ = F.lane >> 5;
        const bf16* sb = (const bf16*)(F.ws + WS_H) + ((size_t)(b * 16 + c) * 16 + g * 4 + hh_) * 8192 + (size_t)r_ * 128 + 8 * h_;
#pragma unroll
        for (int ks = 0; ks < 8; ++ks)
#pragma unroll
            for (int pt = 0; pt < 2; ++pt) sfr[ks][pt] = *(const bf16x8*)(sb + pt * 32 * 128 + 16 * ks); }
    const int lane = F.lane, wave = F.wave, hh = wave >> 1, lh = wave & 1, r = lane & 31, h = lane >> 5, head = g * 4 + hh;
    const int LT0 = lh, LT1 = 3 - lh;
#define LTILE(lt) ((lt) == 0 ? LT0 : LT1)
    const size_t m0 = (size_t)b * SEQ_P + (size_t)c * 128;
    const LAS float* ac = (const LAS float*)(F.lds + ACUM_OFF) + hh * 128; const LAS float* dv = (const LAS float*)(F.lds + DTV_OFF) + hh * 128;
    f32x16 y[2][2];
#pragma unroll
    for (int lt = 0; lt < 2; ++lt)
#pragma unroll
        for (int pt = 0; pt < 2; ++pt)
#pragma unroll
            for (int i = 0; i < 16; ++i) y[lt][pt][i] = 0.f;
    unsigned long long zw[16];
    const unsigned char* zbase = (const unsigned char*)proj_ptr(F, PT_Z);
    const unsigned zoff0 = (unsigned)(((int)m0 + wave) * DM + g * 256 + lane * 4) * 2u;
    {
#pragma unroll
        for (int k = 0; k < 16; ++k) zw[k] = *(const unsigned long long*)(zbase + (zoff0 + (unsigned)k * (8u * DM * 2u))); }
    {
#pragma unroll
        for (int ks = 0; ks < 8; ++ks) {
#pragma unroll
            for (int lt = 0; lt < 2; ++lt) { const bf16x8 a = *(const LAS bf16x8*)(F.lds + CM_OFF + (32 * LTILE(lt) + r) * SPITCH + 32 * ks + 16 * h);
#pragma unroll
                for (int pt = 0; pt < 2; ++pt) y[lt][pt] = MFMA32(a, sfr[ks][pt], y[lt][pt]); }
        }
#pragma unroll
        for (int lt = 0; lt < 2; ++lt)
#pragma unroll
            for (int i = 0; i < 16; ++i) { const float e = __expf(ac[32 * LTILE(lt) + crow(i, h)]); y[lt][0][i] *= e; y[lt][1][i] *= e; }
    }
#pragma unroll
    for (int lt = 0; lt < 2; ++lt) { const int L = LTILE(lt); const float al = ac[32 * L + r];
#pragma unroll 1
        for (int S = 0; S <= L; ++S) {
            f32x16 xt;
#pragma unroll
            for (int i = 0; i < 16; ++i) xt[i] = 0.f;
#pragma unroll
            for (int ks = 0; ks < 8; ++ks) { const bf16x8 a = *(const LAS bf16x8*)(F.lds + BM_OFF + (32 * S + r) * SPITCH + 32 * ks + 16 * h);
                const bf16x8 bb = *(const LAS bf16x8*)(F.lds + CM_OFF + (32 * L + r) * SPITCH + 32 * ks + 16 * h); xt = MFMA32(a, bb, xt); }
#pragma unroll
            for (int gq = 0; gq < 4; ++gq) { const f32x4 as4 = *(const LAS f32x4*)(ac + 32 * S + 8 * gq + 4 * h), ds4 = *(const LAS f32x4*)(dv + 32 * S + 8 * gq + 4 * h);
#pragma unroll
                for (int i = 0; i < 4; ++i) { const float arg = fminf(al - as4[i], 0.f); float val = xt[4 * gq + i] * __expf(arg) * ds4[i];
                    if (S == L && (8 * gq + 4 * h + i) > r) val = 0.f; xt[4 * gq + i] = val; } }
#pragma unroll
            for (int k2 = 0; k2 < 2; ++k2) { const bf16x8 aop = pack8(xt[8 * k2], xt[8 * k2 + 1], xt[8 * k2 + 2], xt[8 * k2 + 3], xt[8 * k2 + 4], xt[8 * k2 + 5], xt[8 * k2 + 6], xt[8 * k2 + 7]);
#pragma unroll
                for (int pt = 0; pt < 2; ++pt) { const LAS unsigned char* xp = F.lds + XT_OFF + (hh * 64 + 32 * pt + r) * SPITCH + (32 * S + 16 * k2 + 4 * h) * 2;
                    const s16x4 lo = *(const LAS s16x4*)xp, hi = *(const LAS s16x4*)(xp + 16);
                    const bf16x8 bop = __builtin_shufflevector(lo, hi, 0, 1, 2, 3, 4, 5, 6, 7);
                    y[lt][pt] = MFMA32(aop, bop, y[lt][pt]); } }
        }
    }
    {   const float Dh = in_ptr(21)[layer * 16 + head];
#pragma unroll
        for (int lt = 0; lt < 2; ++lt)
#pragma unroll
            for (int gq = 0; gq < 4; ++gq)
#pragma unroll
                for (int pt = 0; pt < 2; ++pt) { const s16x4 xv = *(const LAS s16x4*)(F.lds + XT_OFF + (hh * 64 + 32 * pt + r) * SPITCH + (32 * LTILE(lt) + 8 * gq + 4 * h) * 2);
#pragma unroll
                    for (int i = 0; i < 4; ++i) y[lt][pt][4 * gq + i] += bf2f((bf16)xv[i]) * Dh; }
    }
    __syncthreads();
    constexpr int YPITCH = 1040;
#pragma unroll
    for (int lt = 0; lt < 2; ++lt)
#pragma unroll
        for (int pt = 0; pt < 2; ++pt)
#pragma unroll
            for (int i = 0; i < 16; ++i) *(LAS float*)(F.lds + (32 * LTILE(lt) + crow(i, h)) * YPITCH + (hh * 64 + 32 * pt + r) * 4) = y[lt][pt][i];
    __syncthreads();
    {   const int ech = lane * 4; const f32x4 nw = *(const f32x4*)(in_ptr(22) + (size_t)layer * DM + g * 256 + ech);
        unsigned zo = zoff0; asm volatile("" : "+v"(zo));
#pragma unroll
        for (int k = 0; k < 16; ++k) { const int l = wave + 8 * k;
            const f32x4 y4 = *(const LAS f32x4*)(F.lds + l * YPITCH + ech * 4);
            const unsigned zl = (unsigned)zw[k], zh = (unsigned)(zw[k] >> 32);
            f32x4 yv;
            yv.x = y4.x * fast_silu(bf_lo(zl)); yv.y = y4.y * fast_silu(bf_hi(zl)); yv.z = y4.z * fast_silu(bf_lo(zh)); yv.w = y4.w * fast_silu(bf_hi(zh));
            const float ss = wave_sum((yv.x * yv.x + yv.y * yv.y) + (yv.z * yv.z + yv.w * yv.w));
            const float rr = 1.f / sqrtf(ss * (1.f / 256.f) + EPS);
            const f32x4 o = (yv * rr) * nw;
            *(unsigned long long*)((unsigned char*)zbase + (zo + (unsigned)k * (8u * DM * 2u))) = (unsigned long long)pk2(o.x, o.y) | ((unsigned long long)pk2(o.z, o.w) << 32); }
    }
    __syncthreads();
#undef LTILE
}
__device__ __forceinline__ void ssd_sample_unit(Frame& F, int layer, int sq, int g) {
    frame_refresh(F);
    const int tid = F.tid, lane = F.lane, wave = F.wave;
    const size_t mbase = (size_t)MP + (size_t)sq * SEQ_S;
    LAS float* cv = (LAS float*)(F.lds); LAS float* ybuf = (LAS float*)(F.lds + 16384); LAS float* dts = (LAS float*)(F.lds + 24576); LAS float* acs = (LAS float*)(F.lds + 24704);
    const bf16* src; int col, chan;
    if (tid < 256) { src = proj_ptr(F, PT_XS); col = g * 256 + tid; chan = col; }
    else if (tid < 384) { src = proj_ptr(F, PT_BC); col = g * 128 + (tid - 256); chan = 1024 + col; }
    else { src = proj_ptr(F, PT_BC); col = 512 + g * 128 + (tid - 384); chan = 1024 + col; }
    float pre[8];
#pragma unroll
    for (int j = 0; j < 8; ++j) pre[j] = bf2f(src[(mbase + j) * DM + col]);
    const float* cwp = in_ptr(17) + (size_t)layer * 4 * DXBC + chan;
    const float cw0 = cwp[0], cw1 = cwp[DXBC], cw2 = cwp[2 * DXBC], cw3 = cwp[3 * DXBC], cb = in_ptr(18)[(size_t)layer * DXBC + chan];
    float w0, w1, w2;
    { const float* cs = in_ptr(5) + ((size_t)layer * NB_S + sq) * 3 * DXBC + chan; w0 = cs[0]; w1 = cs[DXBC]; w2 = cs[2 * DXBC]; }
    bf16* Z = proj_ptr(F, PT_Z);
    const int ech = lane * 4;
    const unsigned long long zw = *(const unsigned long long*)(Z + (mbase + wave) * DM + g * 256 + ech);
    f32x4 sv[16];
    { const f32x4* sp = (const f32x4*)(in_ptr(4) + (((size_t)layer * NB_S + sq) * 16 + g * 4 + (wave >> 1)) * 8192 + (size_t)(32 * (wave & 1)) * 128);
#pragma unroll
      for (int i = 0; i < 16; ++i) sv[i] = sp[i * 64 + lane]; }
    if (tid < 32) {
        const float d = ((const float*)(F.ws + WS_DT))[(mbase + (tid >> 2)) * 16 + g * 4 + (tid & 3)]; const float an = -__expf(in_ptr(20)[layer * 16 + g * 4 + (tid & 3)]);
        float v = d * an;
#pragma unroll
        for (int o = 4; o < 32; o <<= 1) { const float u = __shfl_up(v, o); if (lane >= o) v += u; }
        dts[tid] = d; acs[tid] = v; }
#pragma unroll
    for (int j = 0; j < 8; ++j) { const float v = cw0 * w0 + cw1 * w1 + cw2 * w2 + cw3 * pre[j] + cb; w0 = w1; w1 = w2; w2 = pre[j]; cv[j * 512 + tid] = fast_silu(v); }
    {
        float* oc = F.out + (size_t)M * DM + (size_t)DEPTH * NB_P * 16 * 8192 + (size_t)DEPTH * NB_P * 3 * DXBC + (size_t)DEPTH * NB_P * 2 * DM + (size_t)DEPTH * NB_S * 16 * 8192
                    + ((size_t)layer * NB_S + sq) * 3 * DXBC + chan;
        oc[0] = w0; oc[DXBC] = w1; oc[2 * DXBC] = w2; }
    __syncthreads();
    {
        const int hh = wave >> 1, ph = wave & 1, r = lane & 31, h = lane >> 5, head = g * 4 + hh;
        float* SN = F.out + (size_t)M * DM + (size_t)DEPTH * NB_P * 16 * 8192 + (size_t)DEPTH * NB_P * 3 * DXBC + (size_t)DEPTH * NB_P * 2 * DM + (((size_t)layer * NB_S + sq) * 16 + head) * 8192 + (size_t)(32 * ph) * 128;
        const float ac8 = acs[7 * 4 + hh], A8 = __expf(ac8);
        LAS float* simg = (LAS float*)(F.lds + 25088) + wave * (32 * 132);
#pragma unroll
        for (int i = 0; i < 16; ++i) { const int idx = i * 64 + lane; *(LAS f32x4*)(simg + (idx >> 5) * 132 + (idx & 31) * 4) = sv[i]; }
        f32x16 acc[4];
#pragma unroll
        for (int nt = 0; nt < 4; ++nt)
#pragma unroll
            for (int q = 0; q < 16; ++q) acc[nt][q] = simg[crow(q, h) * 132 + 32 * nt + r];
        bf16x8 cfr[8];
#pragma unroll
        for (int ks = 0; ks < 8; ++ks) { const LAS float* cp = cv + (r & 7) * 512 + 384 + 16 * ks + 8 * h; const f32x4 c0 = *(const LAS f32x4*)cp, c1 = *(const LAS f32x4*)(cp + 4);
            const float mk = r < 8 ? 1.f : 0.f; cfr[ks] = pack8(c0.x * mk, c0.y * mk, c0.z * mk, c0.w * mk, c1.x * mk, c1.y * mk, c1.z * mk, c1.w * mk); }
        f32x16 yo;
#pragma unroll
        for (int q = 0; q < 16; ++q) yo[q] = 0.f;
#pragma unroll
        for (int ks = 0; ks < 8; ++ks) { const LAS float* sp = simg + r * 132 + 16 * ks + 8 * h; const f32x4 v0 = *(const LAS f32x4*)sp, v1 = *(const LAS f32x4*)(sp + 4);
            yo = MFMA32(cfr[ks], pack8(v0.x, v0.y, v0.z, v0.w, v1.x, v1.y, v1.z, v1.w), yo); }
#pragma unroll
        for (int q = 0; q < 4; ++q) yo[q] *= __expf(acs[(4 * h + q) * 4 + hh]);
        {
            float xa[8];
#pragma unroll
            for (int j = 0; j < 8; ++j) xa[j] = h == 0 ? cv[j * 512 + hh * 64 + 32 * ph + r] * dts[j * 4 + hh] * __expf(ac8 - acs[j * 4 + hh]) : 0.f;
            const bf16x8 xop = pack8(xa[0], xa[1], xa[2], xa[3], xa[4], xa[5], xa[6], xa[7]);
#pragma unroll
            for (int nt = 0; nt < 4; ++nt) { float bv[8];
#pragma unroll
                for (int j = 0; j < 8; ++j) bv[j] = h == 0 ? cv[j * 512 + 256 + 32 * nt + r] : 0.f;
#pragma unroll
                for (int q = 0; q < 16; ++q) acc[nt][q] *= A8;
                acc[nt] = MFMA32(xop, pack8(bv[0], bv[1], bv[2], bv[3], bv[4], bv[5], bv[6], bv[7]), acc[nt]);
#pragma unroll
                for (int q = 0; q < 16; ++q) simg[crow(q, h) * 132 + 32 * nt + r] = acc[nt][q]; }
#pragma unroll
            for (int i = 0; i < 16; ++i) { const int idx = i * 64 + lane; ((f32x4*)SN)[idx] = *(const LAS f32x4*)(simg + (idx >> 5) * 132 + (idx & 31) * 4); }
        }
        {
            f32x16 xt;
#pragma unroll
            for (int q = 0; q < 16; ++q) xt[q] = 0.f;
#pragma unroll
            for (int ks = 0; ks < 8; ++ks) { const LAS float* bp = cv + (r & 7) * 512 + 256 + 16 * ks + 8 * h; const f32x4 b0 = *(const LAS f32x4*)bp, b1 = *(const LAS f32x4*)(bp + 4);
                const float mk = r < 8 ? 1.f : 0.f; xt = MFMA32(pack8(b0.x * mk, b0.y * mk, b0.z * mk, b0.w * mk, b1.x * mk, b1.y * mk, b1.z * mk, b1.w * mk), cfr[ks], xt); }
            const int t = r & 7; const float at = acs[t * 4 + hh];
            float mv[4];
#pragma unroll
            for (int q = 0; q < 4; ++q) { const int sidx = 4 * h + q; const float arg = fminf(at - acs[sidx * 4 + hh], 0.f); mv[q] = (sidx <= t && r < 8) ? xt[q] * __expf(arg) * dts[sidx * 4 + hh] : 0.f; }
            const bf16x8 aop = pack8(mv[0], mv[1], mv[2], mv[3], 0.f, 0.f, 0.f, 0.f);
            float xs[4];
#pragma unroll
            for (int q = 0; q < 4; ++q) xs[q] = cv[(4 * h + q) * 512 + hh * 64 + 32 * ph + r];
            yo = MFMA32(aop, pack8(xs[0], xs[1], xs[2], xs[3], 0.f, 0.f, 0.f, 0.f), yo);
        }
#pragma unroll
        for (int q = 0; q < 4; ++q) ybuf[(4 * h + q) * 256 + hh * 64 + 32 * ph + r] = yo[q];
    }
    __syncthreads();
    {
        const float Dh = in_ptr(21)[layer * 16 + g * 4 + (ech >> 6)];
        const f32x4 nw = *(const f32x4*)(in_ptr(22) + (size_t)layer * DM + g * 256 + ech);
        const f32x4 y4 = *(const LAS f32x4*)(ybuf + wave * 256 + ech), x4 = *(const LAS f32x4*)(cv + wave * 512 + ech);
        const unsigned zl = (unsigned)zw, zh = (unsigned)(zw >> 32);
        f32x4 y;
        y.x = (y4.x + x4.x * Dh) * fast_silu(bf_lo(zl)); y.y = (y4.y + x4.y * Dh) * fast_silu(bf_hi(zl));
        y.z = (y4.z + x4.z * Dh) * fast_silu(bf_lo(zh)); y.w = (y4.w + x4.w * Dh) * fast_silu(bf_hi(zh));
        const float ss = wave_sum((y.x * y.x + y.y * y.y) + (y.z * y.z + y.w * y.w));
        const float rr = 1.f / sqrtf(ss * (1.f / 256.f) + EPS);
        const f32x4 o = (y * rr) * nw;
        *(unsigned long long*)(Z + (mbase + wave) * DM + g * 256 + ech) = (unsigned long long)pk2(o.x, o.y) | ((unsigned long long)pk2(o.z, o.w) << 32);
    }
    __syncthreads();
}
__device__ __forceinline__ void ssd_s1_phase(Frame& F, int layer, const XcdBarrier& bar, unsigned* bar2, unsigned gen) {
    frame_refresh(F);
#ifdef DUP_S1P
    for (int u = F.vcu; u < 512; u += GRID) ssd_s1_unit(F, layer, u >> 6, (u >> 2) & 15, u & 3);
#endif
  {
    for (int u = F.vcu; u < 512; u += GRID) ssd_s1_unit(F, layer, u >> 6, (u >> 2) & 15, u & 3);
    xcd_arrive(bar, bar2);
    for (int u = F.vcu; u < NB_S * 4; u += GRID) ssd_sample_unit(F, layer, u >> 2, u & 3);
    xcd_wait(bar, bar2, gen);
  }
}
__device__ __forceinline__ void ssd_s3_phase(Frame& F, int layer, const XcdBarrier& bar, unsigned* bar2, unsigned gen) {
    frame_refresh(F);
  {
    for (int u = F.vcu; u < 512; u += GRID) ssd_s3_unit(F, layer, u >> 6, (u >> 2) & 15, u & 3, u < GRID, bar, bar2, gen);
  }
}

template <class Epi> __device__ __forceinline__ void sgemm64(Frame& F, const bf16* A  , const bf16* Bt, int K, const Epi& E) {
    constexpr int KC = 256, PITCH = 528, HBUF = 64 * PITCH, BUF = 2 * HBUF;
    static_assert(2 * BUF <= LDSCTL_OFF && 8 * 16384 <= 2 * BUF, "sgemm64 LDS");
    const int tid = F.tid, lane = F.lane, wave = F.wave, r = lane & 31, h = lane >> 5;
    const int tile = F.vcu & 255, rb = tile >> 4, cb = tile & 15;
    const int nch = K / KC, lrow = tid >> 5, lseg = tid & 31;
    const bf16* ag = A + (size_t)(rb * 64 + lrow) * K + lseg * 8; const bf16* bg = Bt + (size_t)(cb * 64 + lrow) * K + lseg * 8;
    LAS unsigned char* lw = F.lds + lrow * PITCH + lseg * 16;
    const LAS unsigned char* lr = F.lds + r * PITCH + (2 * wave) * 32 + 16 * h;
    v4u ra[4], rbv[4];
#pragma unroll
    for (int i = 0; i < 4; ++i) { ra[i] = *(const v4u*)(ag + (size_t)(16 * i) * K); rbv[i] = *(const v4u*)(bg + (size_t)(16 * i) * K); }
#pragma unroll
    for (int i = 0; i < 4; ++i) { *(LAS v4u*)(lw + 16 * i * PITCH) = ra[i]; *(LAS v4u*)(lw + HBUF + 16 * i * PITCH) = rbv[i]; }
    __syncthreads();
    f32x16 acc[2][2];
#pragma unroll
    for (int i = 0; i < 2; ++i)
#pragma unroll
        for (int j = 0; j < 2; ++j)
#pragma unroll
            for (int q = 0; q < 16; ++q) acc[i][j][q] = 0.f;
#pragma unroll 1
    for (int ch = 0; ch < nch; ++ch) {
        const bool more = ch + 1 < nch;
        if (more) {
#pragma unroll
            for (int i = 0; i < 4; ++i) { ra[i] = *(const v4u*)(ag + (size_t)(16 * i) * K + (ch + 1) * KC); rbv[i] = *(const v4u*)(bg + (size_t)(16 * i) * K + (ch + 1) * KC); } }
        const LAS unsigned char* cur = lr + (ch & 1) * BUF;
#pragma unroll
        for (int q = 0; q < 2; ++q) {
            const bf16x8 a0 = *(const LAS bf16x8*)(cur + q * 32), a1 = *(const LAS bf16x8*)(cur + 32 * PITCH + q * 32);
            const bf16x8 b0 = *(const LAS bf16x8*)(cur + HBUF + q * 32), b1 = *(const LAS bf16x8*)(cur + HBUF + 32 * PITCH + q * 32);
            acc[0][0] = MFMA32(a0, b0, acc[0][0]); acc[0][1] = MFMA32(a0, b1, acc[0][1]);
            acc[1][0] = MFMA32(a1, b0, acc[1][0]); acc[1][1] = MFMA32(a1, b1, acc[1][1]); }
        if (more) { LAS unsigned char* nx = lw + ((ch + 1) & 1) * BUF;
#pragma unroll
            for (int i = 0; i < 4; ++i) { *(LAS v4u*)(nx + 16 * i * PITCH) = ra[i]; *(LAS v4u*)(nx + HBUF + 16 * i * PITCH) = rbv[i]; } }
        __syncthreads();
    }
    {   LAS float* part = (LAS float*)(F.lds) + wave * 4096;
#pragma unroll
        for (int i = 0; i < 2; ++i)
#pragma unroll
            for (int j = 0; j < 2; ++j)
#pragma unroll
                for (int q = 0; q < 16; ++q) part[(32 * i + crow(q, h)) * 64 + 32 * j + r] = acc[i][j][q];
    }
    __syncthreads();
    {   const int row = tid >> 3, c8 = (tid & 7) * 8;
        float v[8];
#pragma unroll
        for (int q = 0; q < 8; ++q) v[q] = 0.f;
#pragma unroll
        for (int w = 0; w < 8; ++w) { const LAS float* p = (const LAS float*)(F.lds) + w * 4096 + row * 64 + c8; const f32x4 x0 = *(const LAS f32x4*)p, x1 = *(const LAS f32x4*)(p + 4);
            v[0] += x0.x; v[1] += x0.y; v[2] += x0.z; v[3] += x0.w; v[4] += x1.x; v[5] += x1.y; v[6] += x1.z; v[7] += x1.w; }
        E(MP + rb * 64 + row, cb * 64 + c8, v);
    }
    __syncthreads();
}
template <bool XF32> struct SEpiResidLN {
    const void* Xin; bf16* X; const float* gate; float sc;
    bf16* H; const float* GS; const float* SH; float* SSQ; unsigned* cnt;
    __device__ __forceinline__ void operator()(int m, int c, const float (&v)[8]) const {
        const int mr = mod_row(m);
        const float* gp = gate + (size_t)mr * NMOD + c;
        f32x4 x0, x1;
        if constexpr (XF32) { const float* xi = (const float*)Xin + (size_t)(m - MP) * DM + c; x0 = *(const f32x4*)xi; x1 = *(const f32x4*)(xi + 4); }
        else { const v4u xw = *(const v4u*)((const bf16*)Xin + (size_t)m * DM + c); x0 = (f32x4){bf_lo(xw.x), bf_hi(xw.x), bf_lo(xw.y), bf_hi(xw.y)}; x1 = (f32x4){bf_lo(xw.z), bf_hi(xw.z), bf_lo(xw.w), bf_hi(xw.w)}; }
        const f32x4 g0 = *(const f32x4*)gp, g1 = *(const f32x4*)(gp + 4);
        const f32x4 s0 = *(const f32x4*)(GS + (size_t)mr * DM + c), s1 = *(const f32x4*)(GS + (size_t)mr * DM + c + 4), h0 = *(const f32x4*)(SH + (size_t)mr * NMOD + c), h1 = *(const f32x4*)(SH + (size_t)mr * NMOD + c + 4);
        const f32x4 n0 = x0 + (g0 * sc) * (f32x4){v[0], v[1], v[2], v[3]}, n1 = x1 + (g1 * sc) * (f32x4){v[4], v[5], v[6], v[7]};
        { v4u w; w.x = pk2(n0.x, n0.y); w.y = pk2(n0.z, n0.w); w.z = pk2(n1.x, n1.y); w.w = pk2(n1.z, n1.w); *(v4u*)(X + (size_t)m * DM + c) = w; }
        float ss = ((n0.x * n0.x + n0.y * n0.y) + (n0.z * n0.z + n0.w * n0.w)) + ((n1.x * n1.x + n1.y * n1.y) + (n1.z * n1.z + n1.w * n1.w));
        ss += __shfl_xor(ss, 1); ss += __shfl_xor(ss, 2); ss += __shfl_xor(ss, 4);
        if ((threadIdx.x & 7) == 0) atomicAdd(SSQ + m, ss);
        asm volatile("s_waitcnt vmcnt(0)" ::: "memory");
        __syncthreads();
        if (threadIdx.x == 0) { unsigned* cp = cnt + 64 * ((m - MP) >> 6);
            __hip_atomic_fetch_add(cp, 1u, __ATOMIC_RELAXED, __HIP_MEMORY_SCOPE_AGENT);
            unsigned sp = 0; while (__hip_atomic_load(cp, __ATOMIC_RELAXED, __HIP_MEMORY_SCOPE_AGENT) < 16u && ++sp < (1u << 22)) __builtin_amdgcn_s_sleep(1); }
        __syncthreads();
        const float tot = __hip_atomic_load(SSQ + m, __ATOMIC_RELAXED, __HIP_MEMORY_SCOPE_AGENT);
        const float rinv = 1.f / sqrtf(tot * (1.f / DM) + EPS);
        const f32x4 a = (n0 * rinv) * s0 + h0, b = (n1 * rinv) * s1 + h1;
        v4u w; w.x = pk2(a.x, a.y); w.y = pk2(a.z, a.w); w.z = pk2(b.x, b.y); w.w = pk2(b.z, b.w); *(v4u*)(H + (size_t)m * DM + c) = w;
    }
};
template <bool FIRST> struct SEpiGate {
    bf16* T; const bf16* G;
    __device__ __forceinline__ void operator()(int m, int c, const float (&v)[8]) const {
        const size_t o = (size_t)m * DM + c; const v4u gw = *(const v4u*)(G + o);
        float r[8];
        r[0] = bf_lo(gw.x) * v[0]; r[1] = bf_hi(gw.x) * v[1]; r[2] = bf_lo(gw.y) * v[2]; r[3] = bf_hi(gw.y) * v[3];
        r[4] = bf_lo(gw.z) * v[4]; r[5] = bf_hi(gw.z) * v[5]; r[6] = bf_lo(gw.w) * v[6]; r[7] = bf_hi(gw.w) * v[7];
        if (!FIRST) { const v4u tw = *(const v4u*)(T + o);
            r[0] += bf_lo(tw.x); r[1] += bf_hi(tw.x); r[2] += bf_lo(tw.y); r[3] += bf_hi(tw.y); r[4] += bf_lo(tw.z); r[5] += bf_hi(tw.z); r[6] += bf_lo(tw.w); r[7] += bf_hi(tw.w); }
        v4u w; w.x = pk2(r[0], r[1]); w.y = pk2(r[2], r[3]); w.z = pk2(r[4], r[5]); w.w = pk2(r[6], r[7]);
        *(v4u*)(T + o) = w;
    }
};

struct SEpiFinal {
    const bf16* Xin; float* Y; const float* gate; const float* gfin; float* SSF; unsigned* cnt;
    __device__ __forceinline__ void operator()(int m, int c, const float (&v)[8]) const {
        const int mr = mod_row(m);
        const float* gp = gate + (size_t)mr * NMOD + c; const v4u xw = *(const v4u*)(Xin + (size_t)m * DM + c);
        const f32x4 g0 = *(const f32x4*)gp, g1 = *(const f32x4*)(gp + 4), x0 = (f32x4){bf_lo(xw.x), bf_hi(xw.x), bf_lo(xw.y), bf_hi(xw.y)}, x1 = (f32x4){bf_lo(xw.z), bf_hi(xw.z), bf_lo(xw.w), bf_hi(xw.w)};
        const f32x4 n0 = x0 + (g0 * 0.5f) * (f32x4){v[0], v[1], v[2], v[3]}, n1 = x1 + (g1 * 0.5f) * (f32x4){v[4], v[5], v[6], v[7]};
        float ss = ((n0.x * n0.x + n0.y * n0.y) + (n0.z * n0.z + n0.w * n0.w)) + ((n1.x * n1.x + n1.y * n1.y) + (n1.z * n1.z + n1.w * n1.w));
        ss += __shfl_xor(ss, 1); ss += __shfl_xor(ss, 2); ss += __shfl_xor(ss, 4);
        if ((threadIdx.x & 7) == 0) atomicAdd(SSF + m, ss);
        asm volatile("s_waitcnt vmcnt(0)" ::: "memory");
        __syncthreads();
        if (threadIdx.x == 0) { unsigned* cp = cnt + 64 * ((m - MP) >> 6);
            __hip_atomic_fetch_add(cp, 1u, __ATOMIC_RELAXED, __HIP_MEMORY_SCOPE_AGENT);
            unsigned sp = 0; while (__hip_atomic_load(cp, __ATOMIC_RELAXED, __HIP_MEMORY_SCOPE_AGENT) < 16u && ++sp < (1u << 22)) __builtin_amdgcn_s_sleep(1); }
        __syncthreads();
        const float tot = __hip_atomic_load(SSF + m, __ATOMIC_RELAXED, __HIP_MEMORY_SCOPE_AGENT);
        const float rinv = 1.f / sqrtf(tot * (1.f / DM) + EPS);
        const f32x4 f0 = *(const f32x4*)(gfin + c), f1 = *(const f32x4*)(gfin + c + 4);
        float* yp = Y + (size_t)m * DM + c;
        *(f32x4*)yp = (n0 * rinv) * f0; *(f32x4*)(yp + 4) = (n1 * rinv) * f1;
    }
};
#ifdef DUP_BAR
#define GRID_BAR() do { xcd_barrier(bar); xcd_barrier(bar); } while (0)
#else
#if defined(BAR3V)
#define GRID_BAR() xcd_barrier3((unsigned*)(F.ctl + 180224), F.MISC + 10, (unsigned)GRID)
#elif !defined(NO_FLATBAR)
#define GRID_BAR() xcd_barrier_flat(bar, (unsigned*)(F.ctl + 180224), F.MISC + 10)
#else
#define GRID_BAR() xcd_barrier(bar)
#endif
#endif
#ifndef PH_MASK
#define PH_MASK 0xffff
#endif
#define PH(k) (((PH_MASK) >> (k)) & 1)
#ifndef XR_ON_
#define XR_ON_ 1
#endif
constexpr bool XR_ON = XR_ON_;
#define BAR2 ((unsigned*)(F.ctl + CW_BAR + 4096))
#define BAR3 ((unsigned*)(F.ctl + CW_BAR + 8192))
#define FILL_BAR(k, gen) do { if constexpr (FILLW && l == 0) { xcd_arrive(bar, BAR2); p0_fill(F, k); xcd_wait(bar, BAR2, gen); } else GRID_BAR(); } while (0)
#define Hb ((bf16*)(F.ws + WS_H))
#define Tb ((bf16*)(F.ws + WS_S))
#define ACT ((bf16*)(F.ws + WS_P))
#define XB (proj_ptr(F, PT_SCH))

template <int LAYER> __device__ __forceinline__ void layer_fwd(Frame& F, const XcdBarrier& bar) {
    constexpr int l = LAYER;
        if (PH(3)) { frame_refresh(F); pg8::Gemm g{Hb, wt_ptr(F, l, WO_GU1), M, 2 * DFF, DM}; pg8::StaticOrder S; S.init(M, 2 * DFF, GRID, F.bx);
          pg8::EpiSwiglu E{ACT}; pg8::gemm_phase<pg8::EpiSwiglu, pg8::StaticOrder, true, true>(F.lds + RING_OFF, g, S, E);
#ifdef DUP_G1
          GRID_BAR(); pg8::gemm_phase<pg8::EpiSwiglu, pg8::StaticOrder, true, true>(F.lds + RING_OFF, g, S, E);
#endif
        }
        FILL_BAR(0, 2u);
#ifdef DUP_D1
        { frame_refresh(F); pg8::Gemm g{ACT, wt_ptr(F, l, WO_D1), MP, DM, DFF}; pg8::StaticOrder S; S.init(MP, DM, GRID, F.bx);
          pg8::EpiGate<true> E{Tb, Hb}; pg8::gemm_phase<pg8::EpiGate<true>, pg8::StaticOrder, true, true>(F.lds + RING_OFF, g, S, E); }
#endif
#ifdef DUP_K1
        { frame_refresh(F); pg8::Gemm g{Hb, wt_ptr(F, l, WO_SSD), MP, DM, DM}; pg8::StaticOrder S; S.init(MP, DM, GRID, F.bx);
          pg8::EpiGate<true> E{Tb, Hb}; pg8::gemm_phase<pg8::EpiGate<true>, pg8::StaticOrder, true, true>(F.lds + RING_OFF, g, S, E); }
#endif
#ifdef DUP_SGD
        { frame_refresh(F); SEpiGate<true> SE{Tb, Hb}; sgemm64(F, ACT + (size_t)MP * DFF, wt_ptr(F, l, WO_D1), DFF, SE); }
#endif
        if (PH(4)) { frame_refresh(F); pg8::Gemm g{ACT, wt_ptr(F, l, WO_D1), MP, DM, DFF}; pg8::StaticOrder S; S.init(MP, DM, GRID, F.bx);
          pg8::EpiResidLN<true, l == 0> E{l == 0 ? (const void*)in_ptr(0) : (const void*)XB, XB, mod_ptr(F, l, 2), in_ptr(1), Hb, gs_ptr(F, l * 3 + 1), mod_ptr(F, l, 3), ss_ptr(F, l * 3 + 1), fcnt_ptr(F, l * 3 + 1)}; pg8::gemm_phase<pg8::EpiResidLN<true, l == 0>, pg8::StaticOrder, true, true, XR_ON, MP>(F.lds + RING_OFF, g, S, E);
          if constexpr (!XR_ON) {frame_refresh(F); SEpiResidLN<l == 0> SE{l == 0 ? (const void*)in_ptr(1) : (const void*)XB, XB, mod_ptr(F, l, 2), 0.5f, Hb, gs_ptr(F, l * 3 + 1), mod_ptr(F, l, 3), ss_ptr(F, l * 3 + 1), fcnt_ptr(F, l * 3 + 1) + 64 * 64};
            sgemm64(F, ACT + (size_t)MP * DFF, wt_ptr(F, l, WO_D1), DFF, SE); } }
        FILL_BAR(1, 3u);
        if (PH(5)) dt_phase(F, l);
        if (PH(6)) { frame_refresh(F); pg8::Gemm g{Hb, wt_ptr(F, l, WO_IN), M, 6144, DM}; pg8::StaticOrder S; S.init(M, 6144, GRID, F.bx);
          pg8::EpiProj E{(bf16*)(F.ws + WS_P), 0}; pg8::gemm_phase<pg8::EpiProj, pg8::StaticOrder, true, true>(F.lds + RING_OFF, g, S, E); }
        xcd_arrive(bar, BAR2);
        if (PH(6)) { frame_refresh(F); pg8::Gemm g{Hb, wt_ptr(F, l, WO_IN) + (size_t)6144 * DM, M, 2048, DM}; pg8::StaticOrder S; S.init(M, 2048, GRID, (F.bx + GRID - 96) % GRID);
          pg8::EpiProj E{(bf16*)(F.ws + WS_P), 24}; pg8::gemm_phase<pg8::EpiProj, pg8::StaticOrder, true, true>(F.lds + RING_OFF, g, S, E); }
        xcd_wait(bar, BAR2, 4u + 7u * l);
#ifdef DUP_SC
        F.dry = 1; shortconv_phase(F, l); F.dry = 0;
#endif
        if (PH(7)) shortconv_phase(F, l);
        __syncthreads();
        if (PH(8)) ssd_s1_phase(F, l, bar, BAR2, 5u + 7u * l);
#ifdef DUP_S2
        ssd_s2_phase(F, l);
#endif
        if (PH(8)) ssd_s2_phase(F, l);
        xcd_arrive(bar, BAR2);
        if (PH(8)) ssd_s3_phase(F, l, bar, BAR2, 6u + 7u * l);
        xcd_arrive(bar, BAR2);
        if (PH(9)) { frame_refresh(F); pg8::Gemm g{proj_ptr(F, PT_SCB), wt_ptr(F, l, WO_SC), MP, DM, DM, proj_ptr(F, PT_Z), wt_ptr(F, l, WO_SSD)}; pg8::PairOrderW S; S.init(MP, DM, GRID, F.bx);
          S.top = BAR2 + XB_TOP; S.target = bar.st[1] * (7u + 7u * l);
          pg8::EpiGate2 E{Tb, proj_ptr(F, PT_GSC), proj_ptr(F, PT_GSSD)}; pg8::gemm_phase<pg8::EpiGate2, pg8::PairOrderW, true, true, XR_ON, MP>(F.lds + RING_OFF, g, S, E);
          if constexpr (!XR_ON) { frame_refresh(F); SEpiGate<true> SE{Tb, proj_ptr(F, PT_GSSD)};
          sgemm64(F, proj_ptr(F, PT_Z) + (size_t)MP * DM, wt_ptr(F, l, WO_SSD), DM, SE);
          frame_refresh(F); SEpiGate<false> SE2{Tb, proj_ptr(F, PT_GSC)};
          sgemm64(F, proj_ptr(F, PT_SCB) + (size_t)MP * DM, wt_ptr(F, l, WO_SC), DM, SE2); } }
        xcd_arrive(bar, BAR2);
        if (PH(11)) { frame_refresh(F); pg8::Gemm g{Tb, wt_ptr(F, l, WO_O), MP, DM, DM}; pg8::RotWaitOrder S; S.init(MP, DM, GRID, F.bx); S.top = BAR2 + XB_TOP; S.target = bar.st[1] * (8u + 7u * l);
          pg8::EpiResidLN<false, false> E{XB, XB, mod_ptr(F, l, 5), nullptr, Hb, gs_ptr(F, l * 3 + 2), mod_ptr(F, l, 6), ss_ptr(F, l * 3 + 2), fcnt_ptr(F, l * 3 + 2)}; pg8::gemm_phase<pg8::EpiResidLN<false, false>, pg8::RotWaitOrder, true, true, XR_ON, MP>(F.lds + RING_OFF, g, S, E);
          if constexpr (!XR_ON) {frame_refresh(F); SEpiResidLN<false> SE{XB, XB, mod_ptr(F, l, 5), 1.0f, Hb, gs_ptr(F, l * 3 + 2), mod_ptr(F, l, 6), ss_ptr(F, l * 3 + 2), fcnt_ptr(F, l * 3 + 2) + 64 * 64};
            sgemm64(F, Tb + (size_t)MP * DM, wt_ptr(F, l, WO_O), DM, SE); } }
        FILL_BAR(2, 9u);
        if (PH(3)) { frame_refresh(F); pg8::Gemm g{Hb, wt_ptr(F, l, WO_GU2), M, 2 * DFF, DM}; pg8::StaticOrder S; S.init(M, 2 * DFF, GRID, F.bx);
          pg8::EpiSwiglu E{ACT}; pg8::gemm_phase<pg8::EpiSwiglu, pg8::StaticOrder, true, true>(F.lds + RING_OFF, g, S, E);
#ifdef DUP_G1
          GRID_BAR(); pg8::gemm_phase<pg8::EpiSwiglu, pg8::StaticOrder, true, true>(F.lds + RING_OFF, g, S, E);
#endif
        }
        FILL_BAR(3, 10u);
        if (PH(4)) { frame_refresh(F); pg8::Gemm g{ACT, wt_ptr(F, l, WO_D2), MP, DM, DFF}; pg8::StaticOrder S; S.init(MP, DM, GRID, F.bx);
          if constexpr (l + 1 < DEPTH) { pg8::EpiResidLN<true, false> E{XB, XB, mod_ptr(F, l, 8), nullptr, Hb, gs_ptr(F, (l + 1) * 3), mod_ptr(F, l + 1, 0), ss_ptr(F, (l + 1) * 3), fcnt_ptr(F, (l + 1) * 3)}; pg8::gemm_phase<pg8::EpiResidLN<true, false>, pg8::StaticOrder, true, true, XR_ON, MP>(F.lds + RING_OFF, g, S, E);
          if constexpr (!XR_ON) {frame_refresh(F); SEpiResidLN<false> SE{XB, XB, mod_ptr(F, l, 8), 0.5f, Hb, gs_ptr(F, (l + 1) * 3), mod_ptr(F, l + 1, 0), ss_ptr(F, (l + 1) * 3), fcnt_ptr(F, (l + 1) * 3) + 64 * 64};
            sgemm64(F, ACT + (size_t)MP * DFF, wt_ptr(F, l, WO_D2), DFF, SE); } }
          else {
            unsigned* fc = fcnt_ptr(F, 6);
            pg8::EpiFinal E{XB, F.out, mod_ptr(F, l, 8), in_ptr(27), ss_ptr(F, 6), fc}; pg8::gemm_phase<pg8::EpiFinal, pg8::StaticOrder, true, true, XR_ON, MP>(F.lds + RING_OFF, g, S, E);
          if constexpr (!XR_ON) {frame_refresh(F); SEpiFinal SE{XB, F.out, mod_ptr(F, l, 8), in_ptr(27), ss_ptr(F, 6), fcnt_ptr(F, 6) + 64 * 64};
            sgemm64(F, ACT + (size_t)MP * DFF, wt_ptr(F, l, WO_D2), DFF, SE); } } }
        if constexpr (l + 1 < DEPTH) GRID_BAR();
    }

struct Args { const float* in[28]; float* out; unsigned char* ws; };
__global__ void __launch_bounds__(NWAVES * 64, 2) mega_fwd(Args args) {
    extern __shared__ __attribute__((aligned(16))) unsigned char lds[];
    Frame F;
    F.lds = (LAS unsigned char*)lds;
    F.MISC = (volatile LAS unsigned*)(F.lds + MISC_OFF);
    F.tid = threadIdx.x; F.lane = F.tid & 63; F.wave = __builtin_amdgcn_readfirstlane(F.tid >> 6);
    { const int bx = blockIdx.x; F.bx = bx; F.vcu = (bx & 7) * (GRID >> 3) + (bx >> 3); }
    F.out = args.out; F.ws = args.ws; F.dry = 0;
    F.ctl = (gu32*)(F.ws + WS_CTL);
    for (int u = F.tid; u < (LDS_BYTES - LDSCTL_OFF) / 4; u += NWAVES * 64) ((LAS unsigned*)(F.lds + LDSCTL_OFF))[u] = 0u;
    __syncthreads();
    XcdBarrier bar = xcd_barrier_post((unsigned*)(F.ctl + CW_BAR), F.MISC + 8);

    if (PH(0)) p0a_prologue(F);
#ifdef DUP_P0A
    p0a_prologue(F);
#endif
    xcd_arrive(bar, BAR2);
    if (F.vcu < 72) xcd_wait(bar, BAR2, 1u);
    if (PH(1)) for (int l = 0; l < DEPTH; ++l) {
        frame_refresh(F);
        pg8::Gemm g{(const bf16*)(F.ws + WS_CA), (const bf16*)(F.ws + WS_P) + (size_t)l * NMOD * DM, 256, NMOD, DM};
        pg8::StaticOrder S; S.init(256, NMOD, GRID, (F.vcu + GRID - 36 * l) % GRID);
        pg8::EpiMod E{(float*)(F.ws + WS_MOD) + (size_t)l * NSEQ * NMOD, in_ptr(8) + (size_t)l * NMOD, gs_ptr(F, l * 3), (const float*)(F.ws + WS_GN) + (size_t)l * 3 * DM};
        pg8::gemm_phase<pg8::EpiMod, pg8::StaticOrder, true, true>(F.lds + RING_OFF, g, S, E);
    }
    xcd_arrive(bar, BAR3);
    if (PH(0)) p0b_prologue(F, 72);
#ifdef DUP_P0B
    p0b_prologue(F, 0);
#endif
    xcd_wait(bar, BAR3, 1u);
    norm0_phase(F);
#ifdef DUP_XG0
    norm0_phase(F);
#endif
    GRID_BAR();
    layer_fwd<0>(F, bar);
    layer_fwd<1>(F, bar);
#undef GRID_BAR
}

extern "C" void kernel_launch(void* const* d_in, const int* in_sizes, int n_in, void* d_out, int out_size, void* d_ws, size_t ws_size, hipStream_t stream) {
    static int grid = 0;
    if (grid == 0) {
        if (n_in != 28 || ws_size < WS_END) { fprintf(stderr, "kernel_launch: built for 28 inputs and >= %zu bytes of workspace; got n_in %d, ws %zu; nothing launched\n", (size_t)WS_END, n_in, ws_size); grid = -1; return; }
        int dev = 0, cus = 0, per_cu = 0;
        if (hipGetDevice(&dev) != hipSuccess || hipDeviceGetAttribute(&cus, hipDeviceAttributeMultiprocessorCount, dev) != hipSuccess) { grid = -1; return; }
        if (hipFuncSetAttribute((const void*)mega_fwd, hipFuncAttributeMaxDynamicSharedMemorySize, LDS_BYTES) != hipSuccess) { fprintf(stderr, "kernel_launch: hipFuncSetAttribute failed\n"); grid = -1; return; }
        if (hipOccupancyMaxActiveBlocksPerMultiprocessor(&per_cu, (const void*)mega_fwd, NWAVES * 64, LDS_BYTES) != hipSuccess || per_cu < 1)
            fprintf(stderr, "kernel_launch: note: occupancy query reports %d workgroups per CU\n", per_cu);
        (void)hipGetLastError();
        if (cus < GRID) { fprintf(stderr, "kernel_launch: built for a %d-CU device, found %d CUs; nothing launched\n", GRID, cus); grid = -1; return; }
        grid = GRID;
    }
    if (grid < 0) return;
    if (hipMemsetAsync((char*)d_ws + WS_CTL, 0, CTL_ZERO_BYTES, stream) != hipSuccess) { fprintf(stderr, "kernel_launch: hipMemsetAsync failed\n"); return; }
    Args a{};
    for (int i = 0; i < 28; ++i) a.in[i] = (const float*)d_in[i];
    a.out = (float*)d_out; a.ws = (unsigned char*)d_ws;
    hipLaunchKernelGGL(mega_fwd, dim3(grid), dim3(NWAVES * 64), LDS_BYTES, stream, a);
}
```
